# Optimizing an MI355X kernel written in HIP

```python
import jax, jax.numpy as jnp
from jax import lax
import numpy as np

D_MODEL = 2048
BATCH = 16
SEQ = 256
DEPTH = 4
DEC_BATCH = 2
DEC_SEQ = 4096
PAST_LEN = 512

GRID_W = 64
HEAD_DIM = 128
ROPE_THETA = 10000.0
EPS = 1e-6
Q_BLOCK = 128
A_HEADS = 8
A_KV_HEADS = 2
B_HEADS = 4
B_QK_DIM = 128
B_V_DIM = 256
B_CHUNK = 128
C_HEADS = 8
C_Q_RANK = 512
C_KV_RANK = 256
C_NOPE_DIM = 128
C_ROPE_DIM = 64
C_V_DIM = 128
D_FF = 4 * D_MODEL
N_BRANCH = 3
A_Q_W = A_HEADS * HEAD_DIM
A_KV_W = A_KV_HEADS * HEAD_DIM
B_QK_W = B_HEADS * B_QK_DIM
B_V_W = B_HEADS * B_V_DIM
GATE_W = N_BRANCH * D_MODEL
IN_WIDTH = A_Q_W + 2 * A_KV_W + 2 * B_QK_W + 2 * B_V_W + C_Q_RANK + C_KV_RANK + C_ROPE_DIM + GATE_W

kernel_name = "hybrid_diffusion_gqa_retention_mla_step"


def rms_norm(x, g):
    xf = x.astype(jnp.float32)
    y = xf * lax.rsqrt(jnp.mean(xf * xf, axis=-1, keepdims=True) + EPS)
    return (y * g.astype(jnp.float32)).astype(x.dtype)


def grid_positions(n_tokens):
    rows = n_tokens // GRID_W
    row = jnp.repeat(jnp.arange(rows, dtype=jnp.int32), GRID_W)
    col = jnp.tile(jnp.arange(GRID_W, dtype=jnp.int32), rows)
    return row, col


def rope_1d(x, pos):
    half = x.shape[-1] // 2
    inv = ROPE_THETA ** (-jnp.arange(half, dtype=jnp.float32) / half)
    ang = pos.astype(jnp.float32)[:, None] * inv[None, :]
    cos = jnp.cos(ang)[None, :, None, :]
    sin = jnp.sin(ang)[None, :, None, :]
    x1 = x[..., :half].astype(jnp.float32)
    x2 = x[..., half:].astype(jnp.float32)
    return jnp.concatenate([x1 * cos - x2 * sin, x2 * cos + x1 * sin], axis=-1).astype(x.dtype)


def rope_2d(x, row, col):
    h = x.shape[-1] // 2
    return jnp.concatenate([rope_1d(x[..., :h], row), rope_1d(x[..., h:], col)], axis=-1)


def block_attention(q, k, v, scale):
    b, nq, hq, dq = q.shape
    g = k.shape[2]
    rep = hq // g
    nblk = nq // Q_BLOCK
    qb = q.reshape(b, nblk, Q_BLOCK, g, rep, dq).transpose(1, 0, 2, 3, 4, 5)

    def one_block(qblk):
        s = jnp.einsum('bqgrd,bkgd->bgrqk', qblk, k, preferred_element_type=jnp.float32) * scale
        p = jax.nn.softmax(s, axis=-1).astype(v.dtype)
        return jnp.einsum('bgrqk,bkge->bqgre', p, v)

    o = lax.map(one_block, qb)
    return o.transpose(1, 0, 2, 3, 4, 5).reshape(b, nq, hq, v.shape[-1])


def retention_scan(q, k, v, log_gamma, s0):
    b, n, h, dk = q.shape
    dv = v.shape[-1]
    nc = n // B_CHUNK
    qc = q.reshape(b, nc, B_CHUNK, h, dk).astype(jnp.float32)
    kc = k.reshape(b, nc, B_CHUNK, h, dk).astype(jnp.float32) * (dk ** -0.5)
    vc = v.reshape(b, nc, B_CHUNK, h, dv).astype(jnp.float32)
    lg = log_gamma.astype(jnp.float32)
    idx = jnp.arange(B_CHUNK, dtype=jnp.float32)
    diff = idx[:, None] - idx[None, :]
    decay_in = jnp.where(diff[None] >= 0, jnp.exp(jnp.maximum(diff, 0.0)[None] * lg[:, None, None]), 0.0)
    q_decay = jnp.exp((idx + 1.0)[None, :] * lg[:, None])
    k_decay = jnp.exp((B_CHUNK - 1.0 - idx)[None, :] * lg[:, None])
    chunk_decay = jnp.exp(B_CHUNK * lg)
    scores = jnp.einsum('bnihd,bnjhd->bnhij', qc, kc) * decay_in
    o_inner = jnp.einsum('bnhij,bnjhe->bnihe', scores, vc)
    kv = jnp.einsum('bnjhd,hj,bnjhe->bnhde', kc, k_decay, vc)

    def step(s, kv_n):
        return chunk_decay[None, :, None, None] * s + kv_n, s

    s_final, s_prev = lax.scan(step, s0.astype(jnp.float32), jnp.moveaxis(kv, 1, 0))
    s_prev = jnp.moveaxis(s_prev, 0, 1)
    o_cross = jnp.einsum('bnihd,bnhde->bnihe', qc, s_prev) * q_decay.T[None, None, :, :, None]
    o = (o_inner + o_cross).reshape(b, n, h, dv).astype(v.dtype)
    return o, s_final


def bidir_retention(q, k, v, lg_f, lg_b, s0_f, s0_b):
    o_f, s_f = retention_scan(q, k, v, lg_f, s0_f)
    o_b, s_b = retention_scan(q[:, ::-1], k[:, ::-1], v[:, ::-1], lg_b, s0_b)
    return o_f + o_b[:, ::-1], s_f, s_b


def mixer(h, p, pos, ctx):
    b, n, _ = h.shape
    widths = [A_Q_W, A_KV_W, A_KV_W, B_QK_W, B_QK_W, B_V_W, B_V_W, C_Q_RANK, C_KV_RANK, C_ROPE_DIM]
    offsets = []
    acc = 0
    for w in widths:
        acc += w
        offsets.append(acc)
    proj = h @ p['w_in']
    a_q, a_k, a_v, b_q, b_k, b_v, b_g, c_ql, c_kvl, c_kr, gates = jnp.split(proj, offsets, axis=-1)

    a_q = rms_norm(a_q.reshape(b, n, A_HEADS, HEAD_DIM), p['attn_q_norm'])
    a_k = rms_norm(a_k.reshape(b, n, A_KV_HEADS, HEAD_DIM), p['attn_k_norm'])
    a_v = a_v.reshape(b, n, A_KV_HEADS, HEAD_DIM)
    b_q = b_q.reshape(b, n, B_HEADS, B_QK_DIM)
    b_k = b_k.reshape(b, n, B_HEADS, B_QK_DIM)
    b_v = b_v.reshape(b, n, B_HEADS, B_V_DIM)
    lg_f = jax.nn.log_sigmoid(p['ret_decay_fwd'].astype(jnp.float32))
    lg_b = jax.nn.log_sigmoid(p['ret_decay_bwd'].astype(jnp.float32))
    cq = rms_norm(c_ql, p['mla_q_norm']) @ p['w_mla_uq']
    cq = cq.reshape(b, n, C_HEADS, C_NOPE_DIM + C_ROPE_DIM)
    q_nope, q_rope = cq[..., :C_NOPE_DIM], cq[..., C_NOPE_DIM:]
    ckv = rms_norm(c_kvl, p['mla_kv_norm'])
    krope = c_kr

    if pos is None:
        keys_a, vals_a = a_k, a_v
        s0_f = jnp.zeros((b, B_HEADS, B_QK_DIM, B_V_DIM), jnp.float32)
        s0_b = s0_f
        ckv_all, krope_all = ckv, krope
    else:
        row, col = pos
        ctx_k, ctx_v, s0_f, s0_b, ctx_ckv, ctx_krope = ctx
        a_q = rope_2d(a_q, row, col)
        keys_a = jnp.concatenate([rope_2d(a_k, row, col), ctx_k.astype(a_k.dtype)], axis=1)
        vals_a = jnp.concatenate([a_v, ctx_v.astype(a_v.dtype)], axis=1)
        b_q = rope_2d(b_q, row, col)
        b_k = rope_2d(b_k, row, col)
        q_rope = rope_2d(q_rope, row, col)
        krope_lat = rope_2d(krope[:, :, None, :], row, col)[:, :, 0, :]
        ckv_all = jnp.concatenate([ckv, ctx_ckv.astype(ckv.dtype)], axis=1)
        krope_all = jnp.concatenate([krope_lat, ctx_krope.astype(krope.dtype)], axis=1)

    o_a = block_attention(a_q, keys_a, vals_a, HEAD_DIM ** -0.5).reshape(b, n, A_Q_W)

    o_b, s_f, s_b = bidir_retention(b_q, b_k, b_v, lg_f, lg_b, s0_f, s0_b)
    o_b = rms_norm(o_b, p['ret_gn'].reshape(B_HEADS, B_V_DIM)).reshape(b, n, B_V_W)
    o_b = jax.nn.silu(b_g) * o_b

    nk = ckv_all.shape[1]
    kv_up = (ckv_all @ p['w_mla_ukv']).reshape(b, nk, C_HEADS, C_NOPE_DIM + C_V_DIM)
    k_nope, v_c = kv_up[..., :C_NOPE_DIM], kv_up[..., C_NOPE_DIM:]
    k_c = jnp.concatenate([k_nope, jnp.broadcast_to(krope_all[:, :, None, :], (b, nk, C_HEADS, C_ROPE_DIM))], axis=-1)
    q_c = jnp.concatenate([q_nope, q_rope], axis=-1)
    o_c = block_attention(q_c, k_c, v_c, (C_NOPE_DIM + C_ROPE_DIM) ** -0.5).reshape(b, n, C_HEADS * C_V_DIM)

    g = jax.nn.sigmoid(gates.reshape(b, n, N_BRANCH, D_MODEL))
    merged = (g[:, :, 0] * (o_a @ p['w_branch_a'])
              + g[:, :, 1] * (o_b @ p['w_branch_b'])
              + g[:, :, 2] * (o_c @ p['w_branch_c']))
    out = merged @ p['w_out']
    if pos is None:
        return out, (a_k, a_v, s_f, s_b, ckv, krope)
    return out, None


def layer(x, mod, p, pos, ctx):
    shift1, scale1, gate1, shift2, scale2, gate2 = jnp.split(mod[:, None, :].astype(x.dtype), 6, axis=-1)
    h = rms_norm(x, p['g_pre_mix']) * (1.0 + scale1) + shift1
    m, new_ctx = mixer(h, p, pos, ctx)
    x = x + gate1 * rms_norm(m, p['g_post_mix'])
    h = rms_norm(x, p['g_pre_mlp']) * (1.0 + scale2) + shift2
    f = jnp.square(jax.nn.relu(h @ p['w_mlp_up'])) @ p['w_mlp_down']
    x = x + gate2 * rms_norm(f, p['g_post_mlp'])
    return x, new_ctx


def _normal(k, shape, scale):
    return jax.random.normal(k, shape, jnp.float32) * scale


def setup_inputs(seed: int = 0) -> dict:
    key = jax.random.key(seed)
    ks = jax.random.split(key, 40)
    D = D_MODEL
    base_decay = jnp.log(2.0 ** (5.0 + jnp.arange(B_HEADS, dtype=jnp.float32)) - 1.0)
    return {
        'x_prompt': _normal(ks[0], (BATCH, SEQ, D), 1.0),
        'x_sample': _normal(ks[1], (DEC_BATCH, DEC_SEQ, D), 1.0),
        'c': _normal(ks[2], (DEC_BATCH, D), 1.0),
        'cache_attn_k': _normal(ks[3], (DEC_BATCH, DEPTH, PAST_LEN, A_KV_HEADS, HEAD_DIM), 1.0),
        'cache_attn_v': _normal(ks[4], (DEC_BATCH, DEPTH, PAST_LEN, A_KV_HEADS, HEAD_DIM), 1.0),
        'state_ret_fwd': _normal(ks[5], (DEC_BATCH, DEPTH, B_HEADS, B_QK_DIM, B_V_DIM), 0.3),
        'state_ret_bwd': _normal(ks[6], (DEC_BATCH, DEPTH, B_HEADS, B_QK_DIM, B_V_DIM), 0.3),
        'cache_mla_ckv': _normal(ks[7], (DEC_BATCH, DEPTH, PAST_LEN, C_KV_RANK), 1.0),
        'cache_mla_krope': _normal(ks[8], (DEC_BATCH, DEPTH, PAST_LEN, C_ROPE_DIM), 1.0),
        'c_ctx': _normal(ks[9], (D,), 1.0),
        'w_mod': _normal(ks[10], (DEPTH, D, 6 * D), 0.5 * D ** -0.5),
        'b_mod': _normal(ks[11], (DEPTH, 6 * D), 0.02),
        'g_pre_mix': 1.0 + _normal(ks[12], (DEPTH, D), 0.02),
        'g_post_mix': 1.0 + _normal(ks[13], (DEPTH, D), 0.02),
        'g_pre_mlp': 1.0 + _normal(ks[14], (DEPTH, D), 0.02),
        'g_post_mlp': 1.0 + _normal(ks[15], (DEPTH, D), 0.02),
        'w_in': _normal(ks[16], (DEPTH, D, IN_WIDTH), D ** -0.5),
        'attn_q_norm': 1.0 + _normal(ks[17], (DEPTH, HEAD_DIM), 0.02),
        'attn_k_norm': 1.0 + _normal(ks[18], (DEPTH, HEAD_DIM), 0.02),
        'ret_decay_fwd': base_decay[None, :] + _normal(ks[19], (DEPTH, B_HEADS), 0.1),
        'ret_decay_bwd': base_decay[None, :] + _normal(ks[20], (DEPTH, B_HEADS), 0.1),
        'ret_gn': 1.0 + _normal(ks[21], (DEPTH, B_V_W), 0.02),
        'mla_q_norm': 1.0 + _normal(ks[22], (DEPTH, C_Q_RANK), 0.02),
        'mla_kv_norm': 1.0 + _normal(ks[23], (DEPTH, C_KV_RANK), 0.02),
        'w_mla_uq': _normal(ks[24], (DEPTH, C_Q_RANK, C_HEADS * (C_NOPE_DIM + C_ROPE_DIM)), C_Q_RANK ** -0.5),
        'w_mla_ukv': _normal(ks[25], (DEPTH, C_KV_RANK, C_HEADS * (C_NOPE_DIM + C_V_DIM)), C_KV_RANK ** -0.5),
        'w_branch_a': _normal(ks[26], (DEPTH, A_Q_W, D), A_Q_W ** -0.5),
        'w_branch_b': _normal(ks[27], (DEPTH, B_V_W, D), B_V_W ** -0.5),
        'w_branch_c': _normal(ks[28], (DEPTH, C_HEADS * C_V_DIM, D), (C_HEADS * C_V_DIM) ** -0.5),
        'w_out': _normal(ks[29], (DEPTH, D, D), D ** -0.5),
        'w_mlp_up': _normal(ks[30], (DEPTH, D, D_FF), D ** -0.5),
        'w_mlp_down': _normal(ks[31], (DEPTH, D_FF, D), D_FF ** -0.5),
    }


def reference(x_prompt, x_sample, c, cache_attn_k, cache_attn_v, state_ret_fwd, state_ret_bwd,
              cache_mla_ckv, cache_mla_krope, c_ctx, w_mod, b_mod, g_pre_mix, g_post_mix,
              g_pre_mlp, g_post_mlp, w_in, attn_q_norm, attn_k_norm, ret_decay_fwd, ret_decay_bwd,
              ret_gn, mla_q_norm, mla_kv_norm, w_mla_uq, w_mla_ukv, w_branch_a, w_branch_b,
              w_branch_c, w_out, w_mlp_up, w_mlp_down):
    row, col = grid_positions(x_sample.shape[1])
    y_p = x_prompt
    y_s = x_sample
    ak_l, av_l, sf_l, sb_l, ckv_l, kr_l = [], [], [], [], [], []
    for l in range(DEPTH):
        p = {
            'g_pre_mix': g_pre_mix[l], 'g_post_mix': g_post_mix[l],
            'g_pre_mlp': g_pre_mlp[l], 'g_post_mlp': g_post_mlp[l],
            'w_in': w_in[l], 'attn_q_norm': attn_q_norm[l], 'attn_k_norm': attn_k_norm[l],
            'ret_decay_fwd': ret_decay_fwd[l], 'ret_decay_bwd': ret_decay_bwd[l], 'ret_gn': ret_gn[l],
            'mla_q_norm': mla_q_norm[l], 'mla_kv_norm': mla_kv_norm[l],
            'w_mla_uq': w_mla_uq[l], 'w_mla_ukv': w_mla_ukv[l],
            'w_branch_a': w_branch_a[l], 'w_branch_b': w_branch_b[l], 'w_branch_c': w_branch_c[l],
            'w_out': w_out[l], 'w_mlp_up': w_mlp_up[l], 'w_mlp_down': w_mlp_down[l],
        }
        mod_ctx = (jax.nn.silu(c_ctx) @ w_mod[l] + b_mod[l])[None, :]
        y_p, (ak, av, sf, sb, ckv, kr) = layer(y_p, mod_ctx, p, None, None)
        ak_l.append(ak); av_l.append(av); sf_l.append(sf); sb_l.append(sb); ckv_l.append(ckv); kr_l.append(kr)
        mod_lat = jax.nn.silu(c) @ w_mod[l] + b_mod[l]
        ctx = (cache_attn_k[:, l], cache_attn_v[:, l], state_ret_fwd[:, l], state_ret_bwd[:, l],
               cache_mla_ckv[:, l], cache_mla_krope[:, l])
        y_s, _ = layer(y_s, mod_lat, p, (row, col), ctx)
    new_attn_k = jnp.stack(ak_l, axis=1)
    new_attn_v = jnp.stack(av_l, axis=1)
    new_ret_fwd = jnp.stack(sf_l, axis=1)
    new_ret_bwd = jnp.stack(sb_l, axis=1)
    new_mla_ckv = jnp.stack(ckv_l, axis=1)
    new_mla_krope = jnp.stack(kr_l, axis=1)
    return (y_p, y_s, new_attn_k, new_attn_v, new_ret_fwd, new_ret_bwd, new_mla_ckv, new_mla_krope)
```

```cpp
#include <hip/hip_runtime.h>
#include <cstdio>
#include <cstdint>

#define LAS __attribute__((address_space(3)))
#define GAS __attribute__((address_space(1)))
typedef unsigned short bf16_t;
typedef short bf16x8 __attribute__((ext_vector_type(8)));
typedef short s16x4 __attribute__((ext_vector_type(4)));
typedef float f32x4 __attribute__((ext_vector_type(4)));
typedef float f32x2 __attribute__((ext_vector_type(2)));
typedef float f32x16 __attribute__((ext_vector_type(16)));
typedef unsigned u32x4 __attribute__((ext_vector_type(4)));
typedef unsigned u32x2 __attribute__((ext_vector_type(2)));

constexpr int DM = 2048, NCTX = 4096, NLAT = 8192, NTOK = 12288, DEPTH = 4, DFF = 8192;
constexpr int NPROJ = 11776;
constexpr int C_AQ = 0, C_AK = 1024, C_AV = 1280, C_BQ = 1536, C_BK = 2048, C_BV = 2560, C_BG = 3584, C_CQL = 4608, C_CKV = 5120, C_CKR = 5376, C_GATE = 5632;
constexpr int NALL = 13312;
constexpr int KVL = 4608;
constexpr float EPS = 1e-6f;
constexpr int NWAVES = 8, NTHR = 512;

constexpr size_t WS_CTL = 0, CTL_BYTES = 1u << 20;
constexpr size_t WS_MOD = CTL_BYTES;
constexpr size_t WS_WIN = 2u << 20;
constexpr size_t SZ_WIN = (size_t)NPROJ * DM * 2;
constexpr size_t WS_WUQ = WS_WIN + 4 * SZ_WIN;
constexpr size_t SZ_WUQ = (size_t)1536 * 512 * 2;
constexpr size_t WS_WUKV = WS_WUQ + 4 * SZ_WUQ;
constexpr size_t SZ_WUKV = (size_t)2048 * 256 * 2;
constexpr size_t WS_WBR = WS_WUKV + 4 * SZ_WUKV;
constexpr size_t SZ_WBR1 = (size_t)2048 * 1024 * 2;
constexpr size_t WS_WOUT = WS_WBR + 12 * SZ_WBR1;
constexpr size_t SZ_WOUT = (size_t)2048 * 2048 * 2;
constexpr size_t WS_WUP = WS_WOUT + 4 * SZ_WOUT;
constexpr size_t SZ_WUP = (size_t)8192 * 2048 * 2;
constexpr size_t WS_WDN = WS_WUP + 4 * SZ_WUP;
constexpr size_t WS_H = WS_WDN + 4 * SZ_WUP;
constexpr size_t WS_PROJ = WS_H + (size_t)NTOK * DM * 2;
constexpr size_t WS_KA = WS_PROJ + (size_t)NTOK * NPROJ * 2;
constexpr size_t WS_VA = WS_KA + (size_t)NALL * 256 * 2;
constexpr size_t WS_CKV = WS_VA + (size_t)NALL * 256 * 2;
constexpr size_t WS_KROPE = WS_CKV + (size_t)NALL * 256 * 2;
constexpr size_t WS_CQ = WS_KROPE + (size_t)NALL * 64 * 2;
constexpr size_t WS_KVUP = WS_CQ + (size_t)NTOK * 1536 * 2;
constexpr size_t WS_OABC = WS_KVUP + (size_t)NALL * 2048 * 2;
constexpr size_t SZ_O1 = (size_t)NTOK * 1024 * 2;
constexpr size_t WS_MERGED = WS_OABC + 3 * SZ_O1;
constexpr size_t WS_PART = WS_MERGED + (size_t)NTOK * DM * 2;
constexpr size_t SZ_PART1 = (size_t)NTOK * DM * 4;
constexpr size_t WS_END = WS_PART + 2 * SZ_PART1;
constexpr size_t RET_ST = 32768;
constexpr size_t WS_RKV = WS_PART;
constexpr size_t WS_RS = WS_PART + (size_t)96 * 4 * 2 * RET_ST * 4;
static_assert(WS_RS + (size_t)96 * 4 * 2 * RET_ST * 2 <= WS_END, "ws map");

constexpr int LDS_BYTES = 147456;
constexpr int LDSCTL_OFF = 131072;
constexpr int LDS_RS_OFF = 131072 + 1024;

__device__ __forceinline__ unsigned cvt_pk_bf16(float lo, float hi) { unsigned r; asm volatile("v_cvt_pk_bf16_f32 %0, %1, %2" : "=v"(r) : "v"(lo), "v"(hi)); return r; }
__device__ __forceinline__ float bf_lo(unsigned u) { return __uint_as_float(u << 16); }
__device__ __forceinline__ float bf_hi(unsigned u) { return __uint_as_float(u & 0xffff0000u); }
template <int X> __device__ __forceinline__ float swz_xor(float v) { return __int_as_float(__builtin_amdgcn_ds_swizzle(__float_as_int(v), 0x1f | (X << 10))); }
__device__ __forceinline__ float wave_sum(float v) {
    v += swz_xor<1>(v); v += swz_xor<2>(v); v += swz_xor<4>(v); v += swz_xor<8>(v); v += swz_xor<16>(v);
    auto rr = __builtin_amdgcn_permlane32_swap(__float_as_uint(v), __float_as_uint(v), false, false);
    return __uint_as_float(rr[0]) + __uint_as_float(rr[1]);
}
__device__ __forceinline__ float fast_exp(float x) { return __builtin_amdgcn_exp2f(x * 1.4426950408889634f); }
__device__ __forceinline__ float sigmoidf_(float x) { return __builtin_amdgcn_rcpf(1.0f + fast_exp(-x)); }
__device__ __forceinline__ float siluf_(float x) { return x * sigmoidf_(x); }
#define LDS_WAIT() asm volatile("s_waitcnt lgkmcnt(0)" ::: "memory")
#define VM_WAIT() asm volatile("s_waitcnt vmcnt(0)" ::: "memory")

#define XB_TMO      128
#define XB_XCNT(j)  (256  + 64 * (j))
#define XB_XSUB(j)  (1280 + 64 * (j))
#define XB_XGEN(j)  (2304 + 64 * (j))
#define XB_TOP      3328
#define XB_TOPGEN   3392
#define XCD_BAR_WORDS 3456
#define XB_SPIN_CAP (1u << 22)
__device__ __forceinline__ unsigned xb_ld(unsigned* p)              { return __hip_atomic_load(p, __ATOMIC_RELAXED, __HIP_MEMORY_SCOPE_AGENT); }
__device__ __forceinline__ unsigned xb_add(unsigned* p, unsigned v) { return __hip_atomic_fetch_add(p, v, __ATOMIC_RELAXED, __HIP_MEMORY_SCOPE_AGENT); }
__device__ __forceinline__ unsigned xb_xcc_id() { return (unsigned)__builtin_amdgcn_s_getreg((3 << 11) | 20) & 0xFu; }
#define XB_SPIN(cond, bar) do { unsigned _sp = 0; while (cond) { __builtin_amdgcn_s_sleep(1); \
    if ((++_sp & 255u) == 0u) { if (xb_ld(&(bar)[XB_TMO])) break; if (_sp > XB_SPIN_CAP) { atomicAdd(&(bar)[XB_TMO], 1u); break; } } } } while (0)
struct XcdBarrier { unsigned* bar; unsigned x; volatile LAS unsigned* st; };
__device__ __forceinline__ XcdBarrier xcd_barrier_post(unsigned* bar, volatile LAS unsigned* st) {
    XcdBarrier b; b.bar = bar; b.x = xb_xcc_id(); b.st = st;
    if (threadIdx.x == 0) (void)xb_add(&bar[XB_XCNT(b.x)], 1u);
    return b;
}
__device__ __forceinline__ void xcd_barrier_complete(unsigned* bar, unsigned x, unsigned& nloc, unsigned& nx) {
    const unsigned G = gridDim.x * gridDim.y * gridDim.z;
    unsigned sum, cnt, mine, sp = 0u;
    for (;;) {
        sum = 0u; cnt = 0u; mine = 0u;
#pragma unroll
        for (unsigned j = 0; j < 16; ++j) { const unsigned c = xb_ld(&bar[XB_XCNT(j)]); sum += c; cnt += (c > 0u) ? 1u : 0u; mine = (j == x) ? c : mine; }
        if (sum == G) break;
        __builtin_amdgcn_s_sleep(1);
        if ((++sp & 255u) == 0u) { if (xb_ld(&bar[XB_TMO])) break; if (sp > XB_SPIN_CAP) { atomicAdd(&bar[XB_TMO], 1u); break; } }
    }
    nloc = mine > 0u ? mine : 1u; nx = cnt > 0u ? cnt : 1u;
}
__device__ __forceinline__ void xcd_barrier(const XcdBarrier& b, const bool leader) {
    asm volatile("s_waitcnt vmcnt(0)" ::: "memory");
    __syncthreads();
    if (leader) {
        unsigned* bar = b.bar;
        __builtin_amdgcn_s_waitcnt(0);
        unsigned nloc = b.st[0], nx = b.st[1];
        if (nloc == 0u) { xcd_barrier_complete(bar, b.x, nloc, nx); b.st[0] = nloc; b.st[1] = nx; }
        const unsigned old = xb_add(&bar[XB_XSUB(b.x)], 1u);
        const unsigned gen = old / nloc;
        if (old + 1u == (gen + 1u) * nloc) {
            __builtin_amdgcn_fence(__ATOMIC_RELEASE, "agent");
            asm volatile("s_waitcnt vmcnt(0)" ::: "memory");
            const unsigned og = xb_add(&bar[XB_TOP], 1u);
            const unsigned tg = og / nx;
            if (og + 1u == (tg + 1u) * nx) xb_add(&bar[XB_TOPGEN], 1u);
            else XB_SPIN(xb_ld(&bar[XB_TOPGEN]) == tg, bar);
            __builtin_amdgcn_fence(__ATOMIC_ACQUIRE, "agent");
            xb_add(&bar[XB_XGEN(b.x)], 1u);
            asm volatile("s_waitcnt vmcnt(0)" ::: "memory");
        } else {
            XB_SPIN(xb_ld(&bar[XB_XGEN(b.x)]) == gen, bar);
            __builtin_amdgcn_fence(__ATOMIC_ACQUIRE, "agent");
            asm volatile("s_waitcnt vmcnt(0)" ::: "memory");
        }
    }
    __syncthreads();
}

namespace pg8 {
constexpr int BM = 256, BK = 64, HALF = 128, HTB = HALF * BK * 2, STAGE_BYTES = 8 * HTB, NXCD = 8, WGM = 8;
__host__ __device__ __forceinline__ int lds_byte(int r, int c) { const int st = (r >> 4) * 2 + (c >> 5), rr = r & 15, cc = c & 31, ob = rr * 64 + cc * 2; return st * 1024 + (ob ^ (((ob >> 9) & 1) << 5)); }
__host__ __device__ __forceinline__ void stage_rc(int b, int& R, int& C) { const int st = b / 1024, sb = b % 1024, swz = sb ^ (((sb >> 9) & 1) << 5); R = (st >> 1) * 16 + swz / 64; C = (st & 1) * 32 + (swz % 64) / 2; }
__host__ __device__ __forceinline__ int perm32(int rho) { const int n = rho >> 4, i = rho & 15; return 8 * (i >> 2) + 4 * n + (i & 3); }

struct Unit { int pm, pn, z; };
template <int M, int N, int NZ, bool ZINNER>
__device__ __forceinline__ bool next_unit(int k, int G, int c, Unit& u) {
    constexpr int nM = M / BM, nN = N / BM, nNx = ZINNER ? nN : nN * NZ, nwg = nM * nNx;
    int i, z;
    if (ZINNER) { i = k / NZ; z = k - i * NZ; } else { i = k; z = 0; }
    const int L = i * G + c; if (L >= nwg) return false;
    int wgid = L; { constexpr int q = nwg / NXCD, r = nwg % NXCD; const int xcd = wgid % NXCD, off = wgid / NXCD; wgid = (xcd < r ? xcd * (q + 1) : r * (q + 1) + (xcd - r) * q) + off; }
    constexpr int nig = WGM * nNx; const int gid = wgid / nig, fm = gid * WGM, gsz = (nM - fm) < WGM ? (nM - fm) : WGM;
    u.pm = fm + ((wgid % nig) % gsz); const int pnx = (wgid % nig) / gsz;
    if (ZINNER) { u.pn = pnx; u.z = z; } else { u.z = pnx / nN; u.pn = pnx - u.z * nN; }
    return true;
}

template <int ACT  > struct EpiBf16 {
    static constexpr bool PERM = true;
    bf16_t* O; int ldc;
    __device__ __forceinline__ void operator()(const f32x4 (&acc)[2][2][4][2], const Unit& u, int wr, int wc, int fr, int fq) const {
        const int row0 = u.pm * BM + wr * 64 + fr; const int col0 = u.pn * BM + wc * 32 + 8 * fq;
#pragma unroll
        for (int ai = 0; ai < 2; ++ai)
#pragma unroll
            for (int m = 0; m < 4; ++m) { bf16_t* rowp = O + (size_t)(row0 + ai * HALF + m * 16) * ldc + col0;
#pragma unroll
                for (int bj = 0; bj < 2; ++bj) { f32x4 v0 = acc[ai][bj][m][0], v1 = acc[ai][bj][m][1];
                    if (ACT == 1) {
#pragma unroll
                        for (int j = 0; j < 4; ++j) { const float a = fmaxf(v0[j], 0.f), b = fmaxf(v1[j], 0.f); v0[j] = a * a; v1[j] = b * b; } }
                    u32x4 w; w.x = cvt_pk_bf16(v0[0], v0[1]); w.y = cvt_pk_bf16(v0[2], v0[3]); w.z = cvt_pk_bf16(v1[0], v1[1]); w.w = cvt_pk_bf16(v1[2], v1[3]);
                    *(u32x4*)(rowp + bj * HALF) = w; } }
    }
};
struct EpiF32Z {
    static constexpr bool PERM = false;
    float* C; int ldc; size_t zstride;
    __device__ __forceinline__ void operator()(const f32x4 (&acc)[2][2][4][2], const Unit& u, int wr, int wc, int fr, int fq) const {
        const int row0 = u.pm * BM + wr * 64 + fr, col0 = u.pn * BM + wc * 32 + 4 * fq; float* Cz = C + (size_t)u.z * zstride;
#pragma unroll
        for (int ai = 0; ai < 2; ++ai)
#pragma unroll
            for (int m = 0; m < 4; ++m) { float* rowp = Cz + (size_t)(row0 + ai * HALF + m * 16) * ldc + col0;
#pragma unroll
                for (int bj = 0; bj < 2; ++bj)
#pragma unroll
                    for (int n = 0; n < 2; ++n) *(f32x4*)(rowp + bj * HALF + n * 16) = acc[ai][bj][m][n]; }
    }
};
struct EpiBranch {
    static constexpr bool PERM = true;
    const bf16_t* gates; int ldg;
    float* scr; bf16_t* O;
    __device__ __forceinline__ void operator()(const f32x4 (&acc)[2][2][4][2], const Unit& u, int wr, int wc, int fr, int fq) const {
        const int row0 = u.pm * BM + wr * 64 + fr; const int col0 = u.pn * BM + wc * 32 + 8 * fq;
#pragma unroll
        for (int ai = 0; ai < 2; ++ai)
#pragma unroll
            for (int m = 0; m < 4; ++m) { const size_t row = (size_t)(row0 + ai * HALF + m * 16);
#pragma unroll
                for (int bj = 0; bj < 2; ++bj) { const int col = col0 + bj * HALF;
                    const u32x4 g = *(const u32x4*)(gates + row * ldg + (size_t)u.z * 2048 + col);
                    f32x4 v0 = acc[ai][bj][m][0], v1 = acc[ai][bj][m][1];
                    v0[0] *= sigmoidf_(bf_lo(g.x)); v0[1] *= sigmoidf_(bf_hi(g.x)); v0[2] *= sigmoidf_(bf_lo(g.y)); v0[3] *= sigmoidf_(bf_hi(g.y));
                    v1[0] *= sigmoidf_(bf_lo(g.z)); v1[1] *= sigmoidf_(bf_hi(g.z)); v1[2] *= sigmoidf_(bf_lo(g.w)); v1[3] *= sigmoidf_(bf_hi(g.w));
                    float* sp = scr + row * 2048 + col;
                    if (u.z != 0) { v0 += *(const f32x4*)sp; v1 += *(const f32x4*)(sp + 4); }
                    if (u.z != 2) { *(f32x4*)sp = v0; *(f32x4*)(sp + 4) = v1; }
                    else { u32x4 w; w.x = cvt_pk_bf16(v0[0], v0[1]); w.y = cvt_pk_bf16(v0[2], v0[3]); w.z = cvt_pk_bf16(v1[0], v1[1]); w.w = cvt_pk_bf16(v1[2], v1[3]);
                        *(u32x4*)(O + row * 2048 + col) = w; } } }
    }
};

template <class Epi, int M, int N, int LDA, int LDB, int KU, int NZ, bool ZINNER, size_t AZS, size_t BZS, bool ALIGN_EPI = true>
__device__ __forceinline__ void gemm_phase(LAS unsigned char* lds, const int tid, const void* Aptr, const void* Bptr, int G, int c, const Epi& E) {
    const char* const Abase = (const char*)Aptr; const char* const Bbase = (const char*)Bptr;
    const int wid = __builtin_amdgcn_readfirstlane(tid >> 6), lane = tid & 63, wr = wid >> 2, wc = wid & 3, fr = lane & 15, fq = lane >> 4;
    constexpr int nt = KU / BK;
    unsigned voffA[2], voffB[2];
#pragma unroll
    for (int i = 0; i < 2; ++i) { int R, C; stage_rc(tid * 16 + i * 8192, R, C); const int Rb = Epi::PERM ? ((R & ~31) + perm32(R & 31)) : R;
        voffA[i] = (unsigned)(R * LDA + C) * 2u; voffB[i] = (unsigned)(Rb * LDB + C) * 2u; }
    constexpr size_t kstep = (size_t)(BK * 2);
    constexpr size_t hstepA = (size_t)HALF * LDA * 2, hstepB = (size_t)HALF * LDB * 2;
    constexpr size_t tstepA = 2 * hstepA, tstepB = 2 * hstepB;
    const unsigned ldsw = (unsigned)wid * 1024u;
    const int aoff = lds_byte(wr * 64 + fr, fq * 8), boff = lds_byte(wc * 32 + fr, fq * 8);
#define PG8_SA(b, h) (((b) * 2 + (h)) * HTB)
#define PG8_SB(b, h) ((4 + (b) * 2 + (h)) * HTB)
#define PG8_STAGE(bufoff, gbase, voff) do { _Pragma("unroll") for (int _i = 0; _i < 2; ++_i) \
        __builtin_amdgcn_global_load_lds((const unsigned*)((const char*)(gbase) + (voff)[_i]), (LAS unsigned*)(lds + (bufoff) + ldsw + _i * 8192), 16, 0, 0); } while (0)
#define PG8_LDA(dst, b, h) do { _Pragma("unroll") for (int m = 0; m < 4; ++m) _Pragma("unroll") for (int k = 0; k < 2; ++k) dst[m][k] = *(const LAS bf16x8*)(lds + PG8_SA(b, h) + aoff + m * 2048 + k * 1024); } while (0)
#define PG8_LDB(dst, b, h) do { _Pragma("unroll") for (int n = 0; n < 2; ++n) _Pragma("unroll") for (int k = 0; k < 2; ++k) dst[n][k] = *(const LAS bf16x8*)(lds + PG8_SB(b, h) + boff + n * 2048 + k * 1024); } while (0)
#define PG8_MMA(ai, bj, At, Bt) do { __builtin_amdgcn_s_setprio(1); _Pragma("unroll") for (int m = 0; m < 4; ++m) _Pragma("unroll") for (int n = 0; n < 2; ++n) _Pragma("unroll") for (int k = 0; k < 2; ++k) \
        acc[ai][bj][m][n] = __builtin_amdgcn_mfma_f32_16x16x32_bf16(Bt[n][k], At[m][k], acc[ai][bj][m][n], 0, 0, 0); __builtin_amdgcn_s_setprio(0); } while (0)
#define PG8_WAIT_V(n) asm volatile("s_waitcnt vmcnt(" #n ")" ::: "memory")
#define PG8_WAIT_L(n) asm volatile("s_waitcnt lgkmcnt(" #n ")" ::: "memory")
#define PG8_BAR __builtin_amdgcn_s_barrier()
#define PG8_SCHED __builtin_amdgcn_sched_barrier(0)
    Unit cur, nxt; int ui = 0;
    if (!next_unit<M, N, NZ, ZINNER>(0, G, c, cur)) return;
    f32x4 acc[2][2][4][2];
#pragma unroll
    for (int a = 0; a < 2; ++a)
#pragma unroll
        for (int b = 0; b < 2; ++b)
#pragma unroll
            for (int m = 0; m < 4; ++m)
#pragma unroll
                for (int n = 0; n < 2; ++n) acc[a][b][m][n] = (f32x4){0.f, 0.f, 0.f, 0.f};
    bf16x8 At[4][2], B0[2][2], B1[2][2];
    const char* cA = Abase + (size_t)cur.z * AZS + (size_t)cur.pm * tstepA; const char* cB = Bbase + (size_t)cur.z * BZS + (size_t)cur.pn * tstepB;
    PG8_STAGE(PG8_SB(0, 0), cB, voffB); PG8_STAGE(PG8_SB(0, 1), cB + hstepB, voffB); PG8_STAGE(PG8_SA(0, 0), cA, voffA); PG8_STAGE(PG8_SA(0, 1), cA + hstepA, voffA);
    if (wr == 1) PG8_BAR;
    PG8_WAIT_V(2); PG8_BAR;
    PG8_STAGE(PG8_SB(1, 0), cB + kstep, voffB); PG8_STAGE(PG8_SA(1, 0), cA + kstep, voffA); PG8_STAGE(PG8_SB(1, 1), cB + hstepB + kstep, voffB);
    PG8_WAIT_V(6); PG8_BAR;
    for (;;) {
        const bool has_next = next_unit<M, N, NZ, ZINNER>(ui + 1, G, c, nxt);
        const char* nA = has_next ? Abase + (size_t)nxt.z * AZS + (size_t)nxt.pm * tstepA : cA; const char* nB = has_next ? Bbase + (size_t)nxt.z * BZS + (size_t)nxt.pn * tstepB : cB;
#pragma nounroll
        for (int t = 0; t < nt; t += 2) {
            const bool last = (t == nt - 2);
            const char* a1 = cA + (size_t)(t + 1) * kstep;
            const char* a2 = last ? nA : cA + (size_t)(t + 2) * kstep; const char* b2 = last ? nB : cB + (size_t)(t + 2) * kstep;
            const char* a3 = a2 + kstep; const char* b3 = b2 + kstep;
            PG8_LDB(B0, 0, 0); PG8_LDB(B1, 0, 1); PG8_SCHED; PG8_LDA(At, 0, 0); PG8_STAGE(PG8_SA(1, 1), a1 + hstepA, voffA);
            PG8_WAIT_V(8); PG8_WAIT_L(0); PG8_BAR; PG8_MMA(0, 0, At, B0); PG8_MMA(0, 1, At, B1); PG8_BAR; PG8_SCHED;
            PG8_LDA(At, 0, 1); PG8_STAGE(PG8_SB(0, 0), b2, voffB); PG8_STAGE(PG8_SB(0, 1), b2 + hstepB, voffB); PG8_STAGE(PG8_SA(0, 0), a2, voffA);
            PG8_WAIT_V(8); PG8_WAIT_L(0); PG8_BAR; PG8_MMA(1, 0, At, B0); PG8_MMA(1, 1, At, B1); PG8_BAR; PG8_SCHED;
            PG8_LDB(B0, 1, 0); PG8_LDB(B1, 1, 1); PG8_SCHED; PG8_LDA(At, 1, 0); PG8_STAGE(PG8_SA(0, 1), a2 + hstepA, voffA);
            PG8_WAIT_V(8); PG8_WAIT_L(0); PG8_BAR; PG8_MMA(0, 0, At, B0); PG8_MMA(0, 1, At, B1); PG8_BAR; PG8_SCHED;
            PG8_LDA(At, 1, 1); PG8_STAGE(PG8_SB(1, 0), b3, voffB); PG8_STAGE(PG8_SB(1, 1), b3 + hstepB, voffB); PG8_STAGE(PG8_SA(1, 0), a3, voffA);
            PG8_WAIT_V(8); PG8_WAIT_L(0); PG8_BAR; PG8_MMA(1, 0, At, B0); PG8_MMA(1, 1, At, B1); PG8_BAR; PG8_SCHED;
        }
        if constexpr (ALIGN_EPI) { if (wr == 0) PG8_BAR; }
        E(acc, cur, wr, wc, fr, fq);
        if (!has_next) break;
#pragma unroll
        for (int a = 0; a < 2; ++a)
#pragma unroll
            for (int b = 0; b < 2; ++b)
#pragma unroll
                for (int m = 0; m < 4; ++m)
#pragma unroll
                    for (int n = 0; n < 2; ++n) acc[a][b][m][n] = (f32x4){0.f, 0.f, 0.f, 0.f};
        cur = nxt; cA = nA; cB = nB; ++ui;
        if constexpr (ALIGN_EPI) { if (wr == 1) PG8_BAR; }
    }
    PG8_WAIT_V(0);
    if constexpr (!ALIGN_EPI) { if (wr == 0) PG8_BAR; }
    PG8_BAR;
#undef PG8_SA
#undef PG8_SB
#undef PG8_STAGE
#undef PG8_LDA
#undef PG8_LDB
#undef PG8_MMA
#undef PG8_WAIT_V
#undef PG8_WAIT_L
#undef PG8_BAR
#undef PG8_SCHED
}
}

namespace att {
constexpr int NW = 8, QBLK = 32, KVBLK = 64;
constexpr int SHM_T = KVBLK * 128 * 2;
#define KSWZ(row, colB) ((row) * 256 + ((colB) ^ (((row) & 7) << 4)))
#define SBAR() __builtin_amdgcn_sched_barrier(0)
__device__ __forceinline__ int crow(int r, int hi) { return (r & 3) + 8 * (r >> 2) + 4 * hi; }
__device__ __forceinline__ int v_st(int k, int c) { const int kk = (k & ~0xC) | ((k & 4) << 1) | ((k & 8) >> 1); return ((kk >> 3) * 4 + (c >> 5)) * 512 + ((kk & 7) * 32 + (c & 31)) * 2; }
__device__ __forceinline__ int v_rd_base(int lane) { return ((lane & 3) << 3) | (((lane >> 2) & 3) << 6) | (((lane >> 4) & 1) << 5) | (((lane >> 5) & 1) << 8); }
constexpr int v_rd_off(int d0, int ks, int half) { return d0 * 512 + ks * 4096 + half * 2048; }
template <int OFF> __device__ __forceinline__ s16x4 tr_read(int vb) {
    s16x4 r; asm volatile("ds_read_b64_tr_b16 %0, %1 offset:%2" : "=&v"(r) : "v"(vb), "i"(OFF) : "memory"); return r;
}
#define PKLH(L, H) (bf16x8){L[0], L[1], L[2], L[3], H[0], H[1], H[2], H[3]}
template <int D0> __device__ __forceinline__ void pv_one(f32x16& od, int vb, bf16x8 pa0, bf16x8 pa1, bf16x8 pa2, bf16x8 pa3) {
    const s16x4 l0 = tr_read<v_rd_off(D0, 0, 0)>(vb), h0 = tr_read<v_rd_off(D0, 0, 1)>(vb), l1 = tr_read<v_rd_off(D0, 1, 0)>(vb), h1 = tr_read<v_rd_off(D0, 1, 1)>(vb);
    const s16x4 l2 = tr_read<v_rd_off(D0, 2, 0)>(vb), h2 = tr_read<v_rd_off(D0, 2, 1)>(vb), l3 = tr_read<v_rd_off(D0, 3, 0)>(vb), h3 = tr_read<v_rd_off(D0, 3, 1)>(vb);
    asm volatile("s_waitcnt lgkmcnt(0)" ::: "memory"); SBAR();
    od = __builtin_amdgcn_mfma_f32_32x32x16_bf16(pa0, PKLH(l0, h0), od, 0, 0, 0);
    od = __builtin_amdgcn_mfma_f32_32x32x16_bf16(pa1, PKLH(l1, h1), od, 0, 0, 0);
    od = __builtin_amdgcn_mfma_f32_32x32x16_bf16(pa2, PKLH(l2, h2), od, 0, 0, 0);
    od = __builtin_amdgcn_mfma_f32_32x32x16_bf16(pa3, PKLH(l3, h3), od, 0, 0, 0);
}
__device__ __forceinline__ void pv_d0(f32x16* o, int vb, bf16x8 pa0, bf16x8 pa1, bf16x8 pa2, bf16x8 pa3) {
    pv_one<0>(o[0], vb, pa0, pa1, pa2, pa3); pv_one<1>(o[1], vb, pa0, pa1, pa2, pa3); pv_one<2>(o[2], vb, pa0, pa1, pa2, pa3); pv_one<3>(o[3], vb, pa0, pa1, pa2, pa3);
}
__device__ __forceinline__ void p_to_frags(const f32x16& p0, const f32x16& p1, bf16x8& pa0, bf16x8& pa1, bf16x8& pa2, bf16x8& pa3) {
#define PK4(P, BASE, OUT) do { unsigned a0 = cvt_pk_bf16(P[BASE + 0], P[BASE + 1]), a1 = cvt_pk_bf16(P[BASE + 2], P[BASE + 3]);   \
    unsigned b0 = cvt_pk_bf16(P[BASE + 4], P[BASE + 5]), b1 = cvt_pk_bf16(P[BASE + 6], P[BASE + 7]);                              \
    auto r0 = __builtin_amdgcn_permlane32_swap(a0, b0, false, false); auto r1 = __builtin_amdgcn_permlane32_swap(a1, b1, false, false); \
    u32x4 w = {r0[0], r1[0], r0[1], r1[1]}; OUT = *reinterpret_cast<bf16x8*>(&w); } while (0)
    PK4(p0, 0, pa0); PK4(p0, 8, pa1); PK4(p1, 0, pa2); PK4(p1, 8, pa3);
#undef PK4
}
template <int DQK> struct Cfg { static constexpr float SCALE = DQK == 128 ? 0.088388347648318440f : 0.072168783648703220f; static constexpr float THR = 8.f; };
template <int DQK>
__device__ __forceinline__ void partialSM(f32x16& p0, f32x16& p1, float& m_reg, float& mn, float& alpha) {
    constexpr float SCALE = Cfg<DQK>::SCALE, THR = Cfg<DQK>::THR;
    constexpr float C = SCALE * 1.4426950408889634f;
    float pmax = p0[0];
#pragma unroll
    for (int r = 1; r < 16; ++r) pmax = fmaxf(pmax, p0[r]);
#pragma unroll
    for (int r = 0; r < 16; ++r) pmax = fmaxf(pmax, p1[r]);
    { auto rr = __builtin_amdgcn_permlane32_swap(__float_as_uint(pmax), __float_as_uint(pmax), false, false);
      pmax = fmaxf(__uint_as_float(rr[0]), __uint_as_float(rr[1])); }
    if (__builtin_expect(__all(pmax - m_reg <= THR / SCALE), 1)) { mn = m_reg; alpha = 1.f; }
    else { mn = fmaxf(m_reg, pmax); alpha = __builtin_amdgcn_exp2f((m_reg - mn) * C); m_reg = mn; }
    float mnC = -mn * C;
#pragma unroll
    for (int r = 0; r < 16; ++r) p0[r] = fmaf(p0[r], C, mnC);
#pragma unroll
    for (int r = 0; r < 16; ++r) p1[r] = fmaf(p1[r], C, mnC);
#pragma unroll
    for (int r = 0; r < 16; ++r) p0[r] = __builtin_amdgcn_exp2f(p0[r]);
}
__device__ __forceinline__ void finishSM(f32x16& p0, f32x16& p1, float alpha, float& l_reg, bf16x8& pa0, bf16x8& pa1, bf16x8& pa2, bf16x8& pa3) {
#pragma unroll
    for (int r = 0; r < 16; ++r) p1[r] = __builtin_amdgcn_exp2f(p1[r]);
    float ps = 0;
#pragma unroll
    for (int r = 0; r < 16; ++r) ps += p0[r];
#pragma unroll
    for (int r = 0; r < 16; ++r) ps += p1[r];
    { auto rr = __builtin_amdgcn_permlane32_swap(__float_as_uint(ps), __float_as_uint(ps), false, false);
      ps = __uint_as_float(rr[0]) + __uint_as_float(rr[1]); }
    l_reg = l_reg * alpha + ps;
    p_to_frags(p0, p1, pa0, pa1, pa2, pa3);
}
template <int DQK>
__device__ __forceinline__ void qkt(f32x16& p0, f32x16& p1, const LAS char* Ks, const LAS char* Rs, const bf16x8* qr, int r32, int hi) {
    p0 = f32x16{}; p1 = f32x16{};
#pragma unroll
    for (int d0 = 0; d0 < 8; ++d0) { const int cb = (d0 * 16 + hi * 8) * 2;
        const bf16x8 b0 = *reinterpret_cast<const LAS bf16x8*>(Ks + KSWZ(r32, cb));
        const bf16x8 b1 = *reinterpret_cast<const LAS bf16x8*>(Ks + KSWZ(32 + r32, cb));
        p0 = __builtin_amdgcn_mfma_f32_32x32x16_bf16(b0, qr[d0], p0, 0, 0, 0);
        p1 = __builtin_amdgcn_mfma_f32_32x32x16_bf16(b1, qr[d0], p1, 0, 0, 0); }
    if constexpr (DQK == 192) {
#pragma unroll
        for (int d0 = 0; d0 < 4; ++d0) { const int cb = (d0 * 16 + hi * 8) * 2;
            const bf16x8 b0 = *reinterpret_cast<const LAS bf16x8*>(Rs + KSWZ(r32, cb));
            const bf16x8 b1 = *reinterpret_cast<const LAS bf16x8*>(Rs + KSWZ(32 + r32, cb));
            p0 = __builtin_amdgcn_mfma_f32_32x32x16_bf16(b0, qr[8 + d0], p0, 0, 0, 0);
            p1 = __builtin_amdgcn_mfma_f32_32x32x16_bf16(b1, qr[8 + d0], p1, 0, 0, 0); }
    }
}
template <int DQK> constexpr int attn_lds_bytes() { return 4 * SHM_T + (DQK == 192 ? 2 * SHM_T : 0) + NW * 64 * 4; }

template <int DQK, int LDQ, int LDK, int LDV, int LDO>
__device__ __forceinline__ void attn_body(const bf16_t* __restrict__ Qb, const bf16_t* __restrict__ Kh, const bf16_t* __restrict__ Rh, const bf16_t* __restrict__ Vh,
                                          bf16_t* __restrict__ Ob, int seq, LAS char* lds, const int tid) {
    constexpr int ND = DQK / 16;
    const int wid = tid >> 6, lane = tid & 63, r32 = lane & 31, hi = lane >> 5;
    LAS char* V_lds = lds; LAS char* K_lds = lds + 2 * SHM_T; LAS char* R_lds = lds + 4 * SHM_T;
    LAS float* wsl = (LAS float*)(lds + 4 * SHM_T + (DQK == 192 ? 2 * SHM_T : 0)) + wid * 64; LAS float* li_l = wsl; LAS float* al_l = wsl + 32;
    float m_reg = -1e30f, l_reg = 0; f32x16 o[4] = {}; bf16x8 qr[ND];
    const bf16_t* Qw = Qb + (long)(wid * QBLK + r32) * LDQ + hi * 8;
#pragma unroll
    for (int d0 = 0; d0 < ND; ++d0) qr[d0] = *reinterpret_cast<const bf16x8*>(Qw + d0 * 16);
    const int sr = tid >> 4, sc = (tid & 15) * 8, vst0 = v_st(sr, sc), vst1 = v_st(32 + sr, sc);
    const int rr = tid >> 3, rc = (tid & 7) * 8;
    const int vb0 = (int)(uintptr_t)V_lds + v_rd_base(lane);
    struct { bf16x8 vs0, vs1, ks0, ks1, rs; } sr_[2];
#define SLOAD(i, k0) do { sr_[i].vs0 = *reinterpret_cast<const bf16x8*>(&Vh[(long)((k0) + sr) * LDV + sc]); sr_[i].vs1 = *reinterpret_cast<const bf16x8*>(&Vh[(long)((k0) + 32 + sr) * LDV + sc]); \
    sr_[i].ks0 = *reinterpret_cast<const bf16x8*>(&Kh[(long)((k0) + sr) * LDK + sc]); sr_[i].ks1 = *reinterpret_cast<const bf16x8*>(&Kh[(long)((k0) + 32 + sr) * LDK + sc]); \
    if constexpr (DQK == 192) sr_[i].rs = *reinterpret_cast<const bf16x8*>(&Rh[(long)((k0) + rr) * 64 + rc]); } while (0)
#define SWRITE(b, i) do { *(LAS bf16x8*)(V_lds + (b) * SHM_T + vst0) = sr_[i].vs0; *(LAS bf16x8*)(V_lds + (b) * SHM_T + vst1) = sr_[i].vs1; const int kc = sc * 2; \
    *(LAS bf16x8*)(K_lds + (b) * SHM_T + KSWZ(sr, kc)) = sr_[i].ks0; *(LAS bf16x8*)(K_lds + (b) * SHM_T + KSWZ(32 + sr, kc)) = sr_[i].ks1; \
    if constexpr (DQK == 192) *(LAS bf16x8*)(R_lds + (b) * SHM_T + KSWZ(rr, rc * 2)) = sr_[i].rs; } while (0)
#define SWAIT() do { if constexpr (DQK == 192) asm volatile("s_waitcnt vmcnt(5)" ::: "memory"); else asm volatile("s_waitcnt vmcnt(4)" ::: "memory"); } while (0)
#define RESC(a) do { if (__any((a) < 1.f)) { if (hi == 0) al_l[r32] = (a); asm volatile("s_waitcnt lgkmcnt(0)" ::: "memory"); \
    _Pragma("unroll") for (int d = 0; d < 4; ++d) _Pragma("unroll") for (int r = 0; r < 16; ++r) o[d][r] *= al_l[crow(r, hi)]; } } while (0)
    f32x16 pA0, pA1, pB0, pB1; float mnA, mnB, alA, alB; bf16x8 pa0, pa1, pa2, pa3; const int NT = seq / KVBLK;
    constexpr int SE = 0, SO = 1;
    SLOAD(SE, 0); asm volatile("s_waitcnt vmcnt(0)" ::: "memory"); SWRITE(0, SE); __syncthreads();
    qkt<DQK>(pA0, pA1, K_lds, R_lds, qr, r32, hi); partialSM<DQK>(pA0, pA1, m_reg, mnA, alA);
    SLOAD(SO, KVBLK); if (2 < NT) SLOAD(SE, 2 * KVBLK);
    SWAIT(); SWRITE(1, SO); __syncthreads();
    for (int j = 1; j + 1 < NT; j += 2) {
        SBAR(); qkt<DQK>(pB0, pB1, K_lds + SHM_T, R_lds + SHM_T, qr, r32, hi);
        finishSM(pA0, pA1, alA, l_reg, pa0, pa1, pa2, pa3); SBAR();
        SLOAD(SO, (j + 2) * KVBLK); SBAR();
        pv_d0(o, vb0, pa0, pa1, pa2, pa3); partialSM<DQK>(pB0, pB1, m_reg, mnB, alB);
        __syncthreads(); SWAIT(); SWRITE(0, SE);
        RESC(alB); __syncthreads();
        SBAR(); qkt<DQK>(pA0, pA1, K_lds, R_lds, qr, r32, hi);
        finishSM(pB0, pB1, alB, l_reg, pa0, pa1, pa2, pa3); SBAR();
        if (j + 3 < NT) SLOAD(SE, (j + 3) * KVBLK); SBAR();
        pv_d0(o, vb0 + SHM_T, pa0, pa1, pa2, pa3); partialSM<DQK>(pA0, pA1, m_reg, mnA, alA);
        __syncthreads(); SWAIT(); SWRITE(1, SO);
        RESC(alA); __syncthreads();
    }
    SBAR(); qkt<DQK>(pB0, pB1, K_lds + SHM_T, R_lds + SHM_T, qr, r32, hi);
    finishSM(pA0, pA1, alA, l_reg, pa0, pa1, pa2, pa3); SBAR();
    pv_d0(o, vb0, pa0, pa1, pa2, pa3); partialSM<DQK>(pB0, pB1, m_reg, mnB, alB);
    __syncthreads(); RESC(alB);
    finishSM(pB0, pB1, alB, l_reg, pa0, pa1, pa2, pa3); SBAR();
    pv_d0(o, vb0 + SHM_T, pa0, pa1, pa2, pa3);
    if (hi == 0) li_l[r32] = l_reg; asm volatile("s_waitcnt lgkmcnt(0)" ::: "memory");
    float rli[16];
#pragma unroll
    for (int r = 0; r < 16; ++r) rli[r] = __builtin_amdgcn_rcpf(li_l[crow(r, hi)]);
    bf16_t* Ow = Ob + (long)(wid * QBLK) * LDO;
#pragma unroll
    for (int r = 0; r < 16; ++r) { const int orow = crow(r, hi);
#pragma unroll
        for (int d0 = 0; d0 < 4; ++d0) Ow[(long)orow * LDO + d0 * 32 + r32] = (bf16_t)(cvt_pk_bf16(o[d0][r] * rli[r], 0.f) & 0xffffu); }
    __syncthreads();
#undef SLOAD
#undef SWRITE
#undef SWAIT
#undef RESC
}
template <int DQK, int LDQ, int LDK, int LDV, int LDO>
__device__ __forceinline__ void attn_simple(const bf16_t* __restrict__ Qb, const bf16_t* __restrict__ Kh, const bf16_t* __restrict__ Rh, const bf16_t* __restrict__ Vh,
                                            bf16_t* __restrict__ Ob, int seq, LAS char* lds, const int tid) {
    constexpr int ND = DQK / 16;
    const int wid = tid >> 6, lane = tid & 63, r32 = lane & 31, hi = lane >> 5;
    LAS char* V_lds = lds; LAS char* K_lds = lds + 2 * SHM_T; LAS char* R_lds = lds + 4 * SHM_T;
    LAS float* wsl = (LAS float*)(lds + 4 * SHM_T + (DQK == 192 ? 2 * SHM_T : 0)) + wid * 64; LAS float* li_l = wsl; LAS float* al_l = wsl + 32;
    float m_reg = -1e30f, l_reg = 0; f32x16 o[4] = {}; bf16x8 qr[ND];
    const bf16_t* Qw = Qb + (long)(wid * QBLK + r32) * LDQ + hi * 8;
#pragma unroll
    for (int d0 = 0; d0 < ND; ++d0) qr[d0] = *reinterpret_cast<const bf16x8*>(Qw + d0 * 16);
    const int sr = tid >> 4, sc = (tid & 15) * 8, vst0 = v_st(sr, sc), vst1 = v_st(32 + sr, sc);
    const int rr = tid >> 3, rc = (tid & 7) * 8;
    const int vb0 = (int)(uintptr_t)V_lds + v_rd_base(lane);
    bf16x8 vs0, vs1, ks0, ks1, rs;
#define SLOAD(k0) do { vs0 = *reinterpret_cast<const bf16x8*>(&Vh[(long)((k0) + sr) * LDV + sc]); vs1 = *reinterpret_cast<const bf16x8*>(&Vh[(long)((k0) + 32 + sr) * LDV + sc]); \
    ks0 = *reinterpret_cast<const bf16x8*>(&Kh[(long)((k0) + sr) * LDK + sc]); ks1 = *reinterpret_cast<const bf16x8*>(&Kh[(long)((k0) + 32 + sr) * LDK + sc]); \
    if constexpr (DQK == 192) rs = *reinterpret_cast<const bf16x8*>(&Rh[(long)((k0) + rr) * 64 + rc]); } while (0)
#define SWRITE(b) do { *(LAS bf16x8*)(V_lds + (b) * SHM_T + vst0) = vs0; *(LAS bf16x8*)(V_lds + (b) * SHM_T + vst1) = vs1; const int kc = sc * 2; \
    *(LAS bf16x8*)(K_lds + (b) * SHM_T + KSWZ(sr, kc)) = ks0; *(LAS bf16x8*)(K_lds + (b) * SHM_T + KSWZ(32 + sr, kc)) = ks1; \
    if constexpr (DQK == 192) *(LAS bf16x8*)(R_lds + (b) * SHM_T + KSWZ(rr, rc * 2)) = rs; } while (0)
    const int NT = seq / KVBLK;
    SLOAD(0); asm volatile("s_waitcnt vmcnt(0)" ::: "memory"); SWRITE(0); __syncthreads();
    if (1 < NT) SLOAD(KVBLK);
    for (int j = 0; j < NT; ++j) {
        const int b = j & 1;
        f32x16 p0, p1; float mn, alpha; bf16x8 pa0, pa1, pa2, pa3;
        qkt<DQK>(p0, p1, K_lds + b * SHM_T, R_lds + b * SHM_T, qr, r32, hi);
        partialSM<DQK>(p0, p1, m_reg, mn, alpha);
        if (__any(alpha < 1.f)) { if (hi == 0) al_l[r32] = alpha; asm volatile("s_waitcnt lgkmcnt(0)" ::: "memory");
#pragma unroll
            for (int d = 0; d < 4; ++d)
#pragma unroll
                for (int r = 0; r < 16; ++r) o[d][r] *= al_l[crow(r, hi)]; }
        finishSM(p0, p1, alpha, l_reg, pa0, pa1, pa2, pa3);
        if (j + 1 < NT) SWRITE(b ^ 1);
        if (j + 2 < NT) SLOAD((j + 2) * KVBLK);
        pv_d0(o, vb0 + b * SHM_T, pa0, pa1, pa2, pa3);
        __syncthreads();
    }
    if (hi == 0) li_l[r32] = l_reg; asm volatile("s_waitcnt lgkmcnt(0)" ::: "memory");
    float rli[16];
#pragma unroll
    for (int r = 0; r < 16; ++r) rli[r] = __builtin_amdgcn_rcpf(li_l[crow(r, hi)]);
    bf16_t* Ow = Ob + (long)(wid * QBLK) * LDO;
#pragma unroll
    for (int r = 0; r < 16; ++r) { const int orow = crow(r, hi);
#pragma unroll
        for (int d0 = 0; d0 < 4; ++d0) Ow[(long)orow * LDO + d0 * 32 + r32] = (bf16_t)(cvt_pk_bf16(o[d0][r] * rli[r], 0.f) & 0xffffu); }
    __syncthreads();
#undef SLOAD
#undef SWRITE
}
}

struct Params {
    const float* in[32];
    float* out; unsigned char* ws;
    int ph_lo, ph_hi;
};
enum { I_XP = 0, I_XS, I_C, I_CAK, I_CAV, I_SRF, I_SRB, I_CCKV, I_CKR, I_CCTX, I_WMOD, I_BMOD, I_GPMIX, I_GPOMIX, I_GPMLP, I_GPOMLP, I_WIN, I_AQN, I_AKN, I_RDF, I_RDB, I_RGN,
       I_MQN, I_MKVN, I_WUQ, I_WUKV, I_WBA, I_WBB, I_WBC, I_WOUT, I_WUP, I_WDN };
constexpr size_t O_YP = 0, O_YS = 8388608, O_NAK = 25165824, O_NAV = O_NAK + 4194304, O_NRF = O_NAV + 4194304, O_NRB = O_NRF + 8388608, O_NCKV = O_NRB + 8388608, O_NKR = O_NCKV + 4194304, O_END = O_NKR + 1048576;

typedef const __attribute__((address_space(4))) Params CParams;
struct Ctx {
    LAS unsigned char* lds; int tid, lane, wave, bid, G;
    CParams* p;
};

__device__ __forceinline__ void transpose_item(const float* W, int K, int N, bf16_t* WT, int n_shift_from, int n_shift, LAS float* scr, int item, int lane) {
    const int nblk = N / 32, kb = item / nblk, nb = item - kb * nblk, k0 = 64 * kb, n0 = 32 * nb;
#pragma unroll 8
    for (int i = 0; i < 32; ++i) { const int kk = 2 * i + (lane >> 5); scr[kk * 33 + (lane & 31)] = W[(size_t)(k0 + kk) * N + n0 + (lane & 31)]; }
    LDS_WAIT(); asm volatile("" ::: "memory");
    const int c = lane & 7; const int r0 = n0 + (n0 >= n_shift_from ? n_shift : 0);
#pragma unroll
    for (int j = 0; j < 4; ++j) { const int n = (lane >> 3) + 8 * j; const LAS float* s = scr + (8 * c) * 33 + n;
        u32x4 o; o.x = cvt_pk_bf16(s[0 * 33], s[1 * 33]); o.y = cvt_pk_bf16(s[2 * 33], s[3 * 33]); o.z = cvt_pk_bf16(s[4 * 33], s[5 * 33]); o.w = cvt_pk_bf16(s[6 * 33], s[7 * 33]);
        *(u32x4*)(WT + (size_t)(r0 + n) * K + k0 + 8 * c) = o; }
    LDS_WAIT(); asm volatile("" ::: "memory");
}
__device__ __forceinline__ void phase_prologue(const Ctx& F) {
    CParams& P = *F.p; unsigned char* ws = P.ws;
    {
        LAS float* sv = (LAS float*)F.lds;
        LAS float* red = (LAS float*)(F.lds + 32768);
        for (int i = F.tid; i < 3 * 2048; i += NTHR) { const int v = i >> 11, k = i & 2047; const float x = (v == 0) ? P.in[I_CCTX][k] : P.in[I_C][(v - 1) * 2048 + k]; sv[i] = siluf_(x); }
        __syncthreads();
        float* MOD = (float*)(ws + WS_MOD);
        const int c4 = F.tid & 15, kq = F.tid >> 4;
        for (int it = F.bid; it < 4 * 192; it += F.G) {
            const int l = it / 192, cg = it - l * 192;
            const float* w = P.in[I_WMOD] + (size_t)l * 2048 * 12288 + cg * 64 + c4 * 4;
            f32x4 a0 = {0, 0, 0, 0}, a1 = a0, a2 = a0;
#pragma unroll 8
            for (int kk = 0; kk < 64; ++kk) { const int k = kq + 32 * kk; const f32x4 wv = *(const f32x4*)(w + (size_t)k * 12288);
                a0 += wv * sv[k]; a1 += wv * sv[2048 + k]; a2 += wv * sv[4096 + k]; }
#pragma unroll
            for (int j = 0; j < 4; ++j) { red[(kq * 3 + 0) * 64 + c4 * 4 + j] = a0[j]; red[(kq * 3 + 1) * 64 + c4 * 4 + j] = a1[j]; red[(kq * 3 + 2) * 64 + c4 * 4 + j] = a2[j]; }
            __syncthreads();
            if (F.tid < 192) { const int v = F.tid >> 6, col = F.tid & 63; float s = 0.f;
#pragma unroll 8
                for (int q = 0; q < 32; ++q) s += red[(q * 3 + v) * 64 + col];
                MOD[((size_t)l * 3 + v) * 12288 + cg * 64 + col] = s + P.in[I_BMOD][(size_t)l * 12288 + cg * 64 + col]; }
            __syncthreads();
        }
    }
    {
        LAS float* scr = (LAS float*)(F.lds + F.wave * 16384);
        const int gw = F.bid * NWAVES + F.wave, NGW = F.G * NWAVES;
        constexpr int I_IN = 32 * 362, I_UQ = 8 * 48, I_UKV = 4 * 64, I_BR = 16 * 64, I_OUT = 32 * 64, I_UP = 32 * 256, I_DN = 128 * 64;
        constexpr int PER_L = I_IN + I_UQ + I_UKV + 3 * I_BR + I_OUT + I_UP + I_DN;
        for (int it = gw; it < 4 * PER_L; it += NGW) {
            const int l = it / PER_L; int r = it - l * PER_L;
            if (r < I_IN) { transpose_item(P.in[I_WIN] + (size_t)l * 2048 * 11584, 2048, 11584, (bf16_t*)(ws + WS_WIN + l * SZ_WIN), 5440, 192, scr, r, F.lane); continue; } r -= I_IN;
            if (r < I_UQ) { transpose_item(P.in[I_WUQ] + (size_t)l * 512 * 1536, 512, 1536, (bf16_t*)(ws + WS_WUQ + l * SZ_WUQ), 1 << 30, 0, scr, r, F.lane); continue; } r -= I_UQ;
            if (r < I_UKV) { transpose_item(P.in[I_WUKV] + (size_t)l * 256 * 2048, 256, 2048, (bf16_t*)(ws + WS_WUKV + l * SZ_WUKV), 1 << 30, 0, scr, r, F.lane); continue; } r -= I_UKV;
            if (r < 3 * I_BR) { const int z = r / I_BR; r -= z * I_BR; transpose_item(P.in[I_WBA + z] + (size_t)l * 1024 * 2048, 1024, 2048, (bf16_t*)(ws + WS_WBR + (l * 3 + z) * SZ_WBR1), 1 << 30, 0, scr, r, F.lane); continue; } r -= 3 * I_BR;
            if (r < I_OUT) { transpose_item(P.in[I_WOUT] + (size_t)l * 2048 * 2048, 2048, 2048, (bf16_t*)(ws + WS_WOUT + l * SZ_WOUT), 1 << 30, 0, scr, r, F.lane); continue; } r -= I_OUT;
            if (r < I_UP) { transpose_item(P.in[I_WUP] + (size_t)l * 2048 * 8192, 2048, 8192, (bf16_t*)(ws + WS_WUP + l * SZ_WUP), 1 << 30, 0, scr, r, F.lane); continue; } r -= I_UP;
            transpose_item(P.in[I_WDN] + (size_t)l * 8192 * 2048, 8192, 2048, (bf16_t*)(ws + WS_WDN + l * SZ_WUP), 1 << 30, 0, scr, r, F.lane);
        }
    }
}

__device__ __forceinline__ void norm_phase(const Ctx& F, const float* xin_ctx, const float* xin_lat, const float* o0, const float* o1, float* X, bf16_t* H,
                                           const float* modA, int gate_off, const float* gA, const float* modB, int scale_off, int shift_off, const float* gB) {
    const int gw = F.bid * NWAVES + F.wave, NGW = F.G * NWAVES;
    for (int r = gw; r < NTOK; r += NGW) {
        const int v = r < NCTX ? 0 : 1 + ((r - NCTX) >> 12);
        const float* xr = r < NCTX ? xin_ctx + (size_t)r * DM : xin_lat + (size_t)(r - NCTX) * DM;
        f32x4 x[8];
#pragma unroll
        for (int j = 0; j < 8; ++j) x[j] = *(const f32x4*)(xr + (F.lane + 64 * j) * 4);
        if (o0) {
            f32x4 o[8]; float ss = 0.f;
#pragma unroll
            for (int j = 0; j < 8; ++j) { o[j] = *(const f32x4*)(o0 + (size_t)r * DM + (F.lane + 64 * j) * 4) + *(const f32x4*)(o1 + (size_t)r * DM + (F.lane + 64 * j) * 4);
                ss += (o[j][0] * o[j][0] + o[j][1] * o[j][1]) + (o[j][2] * o[j][2] + o[j][3] * o[j][3]); }
            const float rs = 1.0f / sqrtf(wave_sum(ss) * (1.0f / DM) + EPS);
#pragma unroll
            for (int j = 0; j < 8; ++j) { const int c = (F.lane + 64 * j) * 4; const f32x4 ga = *(const f32x4*)(gA + c), gt = *(const f32x4*)(modA + (size_t)v * 12288 + gate_off + c);
                x[j] += gt * (o[j] * rs * ga); }
        }
#pragma unroll
        for (int j = 0; j < 8; ++j) *(f32x4*)(X + (size_t)r * DM + (F.lane + 64 * j) * 4) = x[j];
        if (gB) {
            float ss = 0.f;
#pragma unroll
            for (int j = 0; j < 8; ++j) ss += (x[j][0] * x[j][0] + x[j][1] * x[j][1]) + (x[j][2] * x[j][2] + x[j][3] * x[j][3]);
            const float rs = 1.0f / sqrtf(wave_sum(ss) * (1.0f / DM) + EPS);
#pragma unroll
            for (int j = 0; j < 8; ++j) { const int c = (F.lane + 64 * j) * 4; const f32x4 gb = *(const f32x4*)(gB + c);
                const f32x4 sc = *(const f32x4*)(modB + (size_t)v * 12288 + scale_off + c), sh = *(const f32x4*)(modB + (size_t)v * 12288 + shift_off + c);
                const f32x4 h = (x[j] * rs * gb) * (sc + 1.0f) + sh;
                u32x2 w; w.x = cvt_pk_bf16(h[0], h[1]); w.y = cvt_pk_bf16(h[2], h[3]);
                *(u32x2*)(H + (size_t)r * DM + c) = w; }
        }
    }
}

__device__ __forceinline__ void rope128(float& y0, float& y1, int lane, int prow, int pcol) {
    const float p0 = swz_xor<16>(y0), p1 = swz_xor<16>(y1);
    const int within = (2 * lane) & 63, i0 = within & 31; const bool second = (lane & 16) != 0; const float pos = (float)((lane >> 5) ? pcol : prow);
    const float r0 = pos * __builtin_amdgcn_exp2f(-(float)i0 * (13.287712379549449f / 32.0f)) * 0.15915494309189535f;
    const float r1 = pos * __builtin_amdgcn_exp2f(-(float)(i0 + 1) * (13.287712379549449f / 32.0f)) * 0.15915494309189535f;
    const float c0 = __builtin_amdgcn_cosf(r0), s0 = __builtin_amdgcn_sinf(r0), c1 = __builtin_amdgcn_cosf(r1), s1 = __builtin_amdgcn_sinf(r1);
    y0 = second ? (y0 * c0 + p0 * s0) : (y0 * c0 - p0 * s0);
    y1 = second ? (y1 * c1 + p1 * s1) : (y1 * c1 - p1 * s1);
}
__device__ __forceinline__ void rope64(float& y0, float& y1, int g, int prow, int pcol) {
    const float p0 = swz_xor<8>(y0), p1 = swz_xor<8>(y1);
    const int within = (2 * g) & 31, i0 = within & 15; const bool second = (g & 8) != 0; const float pos = (float)((g >> 4) ? pcol : prow);
    const float r0 = pos * __builtin_amdgcn_exp2f(-(float)i0 * (13.287712379549449f / 16.0f)) * 0.15915494309189535f;
    const float r1 = pos * __builtin_amdgcn_exp2f(-(float)(i0 + 1) * (13.287712379549449f / 16.0f)) * 0.15915494309189535f;
    const float c0 = __builtin_amdgcn_cosf(r0), s0 = __builtin_amdgcn_sinf(r0), c1 = __builtin_amdgcn_cosf(r1), s1 = __builtin_amdgcn_sinf(r1);
    y0 = second ? (y0 * c0 + p0 * s0) : (y0 * c0 - p0 * s0);
    y1 = second ? (y1 * c1 + p1 * s1) : (y1 * c1 - p1 * s1);
}
__device__ __forceinline__ void phase_postproj(const Ctx& F, int l) {
    CParams& P = *F.p; unsigned char* ws = P.ws;
    bf16_t* PROJ = (bf16_t*)(ws + WS_PROJ); bf16_t* KA = (bf16_t*)(ws + WS_KA); bf16_t* VA = (bf16_t*)(ws + WS_VA); bf16_t* CKV = (bf16_t*)(ws + WS_CKV); bf16_t* KR = (bf16_t*)(ws + WS_KROPE);
    const float* qn = P.in[I_AQN] + l * 128; const float* kn = P.in[I_AKN] + l * 128; const float* mqn = P.in[I_MQN] + l * 512; const float* mkvn = P.in[I_MKVN] + l * 256;
    const int gw = F.bid * NWAVES + F.wave, NGW = F.G * NWAVES, lane = F.lane;
    for (int r = gw; r < NTOK; r += NGW) {
        const bool lat = r >= NCTX; const int lr = r - NCTX, b = lr >> 12, n = lr & 4095, prow = n >> 6, pcol = n & 63;
        const int arow = lat ? NCTX + b * KVL + n : r;
        const int cb = r >> 8, cs = r & 255;
        unsigned* P32 = (unsigned*)(PROJ + (size_t)r * NPROJ);
#pragma unroll 2
        for (int hd = 0; hd < 10; ++hd) {
            const unsigned u = P32[hd * 64 + lane]; float y0 = bf_lo(u), y1 = bf_hi(u);
            const float rs = 1.0f / sqrtf(wave_sum(y0 * y0 + y1 * y1) * (1.0f / 128.0f) + EPS);
            const float* gn = hd < 8 ? qn : kn;
            y0 *= rs * gn[2 * lane]; y1 *= rs * gn[2 * lane + 1];
            if (lat) rope128(y0, y1, lane, prow, pcol);
            if (hd < 8) P32[hd * 64 + lane] = cvt_pk_bf16(y0, y1);
            else { const int kvh = hd - 8; ((unsigned*)(KA + (size_t)arow * 256))[kvh * 64 + lane] = cvt_pk_bf16(y0, y1);
                if (!lat) *(f32x2*)(P.out + O_NAK + (((size_t)cb * 4 + l) * 256 + cs) * 256 + kvh * 128 + 2 * lane) = (f32x2){y0, y1}; }
        }
#pragma unroll
        for (int j = 0; j < 2; ++j) { const unsigned u = P32[C_AV / 2 + j * 64 + lane]; ((unsigned*)(VA + (size_t)arow * 256))[j * 64 + lane] = u;
            if (!lat) *(f32x2*)(P.out + O_NAV + (((size_t)cb * 4 + l) * 256 + cs) * 256 + j * 128 + 2 * lane) = (f32x2){bf_lo(u), bf_hi(u)}; }
#pragma unroll 2
        for (int hd = 0; hd < 8; ++hd) {
            if (!lat && hd < 4) continue;
            const unsigned u = P32[C_BQ / 2 + hd * 64 + lane]; float y0 = bf_lo(u), y1 = bf_hi(u);
            if (lat) rope128(y0, y1, lane, prow, pcol);
            if (hd >= 4) { y0 *= 0.08838834764831845f; y1 *= 0.08838834764831845f; }
            P32[C_BQ / 2 + hd * 64 + lane] = cvt_pk_bf16(y0, y1);
        }
        { u32x4 u = *(const u32x4*)(P32 + C_CQL / 2 + 4 * lane);
          float y[8] = {bf_lo(u.x), bf_hi(u.x), bf_lo(u.y), bf_hi(u.y), bf_lo(u.z), bf_hi(u.z), bf_lo(u.w), bf_hi(u.w)}; float ss = 0.f;
#pragma unroll
          for (int i = 0; i < 8; ++i) ss += y[i] * y[i];
          const float rs = 1.0f / sqrtf(wave_sum(ss) * (1.0f / 512.0f) + EPS);
          const f32x4 g0 = *(const f32x4*)(mqn + 8 * lane), g1 = *(const f32x4*)(mqn + 8 * lane + 4);
          u.x = cvt_pk_bf16(y[0] * rs * g0[0], y[1] * rs * g0[1]); u.y = cvt_pk_bf16(y[2] * rs * g0[2], y[3] * rs * g0[3]);
          u.z = cvt_pk_bf16(y[4] * rs * g1[0], y[5] * rs * g1[1]); u.w = cvt_pk_bf16(y[6] * rs * g1[2], y[7] * rs * g1[3]);
          *(u32x4*)(P32 + C_CQL / 2 + 4 * lane) = u; }
        { const u32x2 u = *(const u32x2*)(P32 + C_CKV / 2 + 2 * lane);
          float y[4] = {bf_lo(u.x), bf_hi(u.x), bf_lo(u.y), bf_hi(u.y)};
          const float rs = 1.0f / sqrtf(wave_sum((y[0] * y[0] + y[1] * y[1]) + (y[2] * y[2] + y[3] * y[3])) * (1.0f / 256.0f) + EPS);
          const f32x4 g = *(const f32x4*)(mkvn + 4 * lane);
#pragma unroll
          for (int i = 0; i < 4; ++i) y[i] *= rs * g[i];
          u32x2 w; w.x = cvt_pk_bf16(y[0], y[1]); w.y = cvt_pk_bf16(y[2], y[3]);
          *(u32x2*)(CKV + (size_t)arow * 256 + 4 * lane) = w;
          if (!lat) *(f32x4*)(P.out + O_NCKV + (((size_t)cb * 4 + l) * 256 + cs) * 256 + 4 * lane) = (f32x4){y[0], y[1], y[2], y[3]}; }
        { const unsigned u = P32[C_CKR / 2 + (lane & 31)]; float y0 = bf_lo(u), y1 = bf_hi(u);
          if (lat) rope64(y0, y1, lane & 31, prow, pcol);
          if (lane < 32) { ((unsigned*)(KR + (size_t)arow * 64))[lane] = cvt_pk_bf16(y0, y1);
              if (!lat) *(f32x2*)(P.out + O_NKR + (((size_t)cb * 4 + l) * 256 + cs) * 64 + 2 * lane) = (f32x2){y0, y1}; } }
    }
    for (int r = gw; r < 1024; r += NGW) {
        const int b = r >> 9, j = r & 511; const size_t arow = NCTX + (size_t)b * KVL + 4096 + j; const size_t src = ((size_t)b * 4 + l) * 512 + j;
        { const f32x4 k = *(const f32x4*)(P.in[I_CAK] + src * 256 + 4 * lane), v = *(const f32x4*)(P.in[I_CAV] + src * 256 + 4 * lane), c = *(const f32x4*)(P.in[I_CCKV] + src * 256 + 4 * lane);
          u32x2 w; w.x = cvt_pk_bf16(k[0], k[1]); w.y = cvt_pk_bf16(k[2], k[3]); *(u32x2*)(KA + arow * 256 + 4 * lane) = w;
          w.x = cvt_pk_bf16(v[0], v[1]); w.y = cvt_pk_bf16(v[2], v[3]); *(u32x2*)(VA + arow * 256 + 4 * lane) = w;
          w.x = cvt_pk_bf16(c[0], c[1]); w.y = cvt_pk_bf16(c[2], c[3]); *(u32x2*)(CKV + arow * 256 + 4 * lane) = w; }
        if (lane < 16) { const f32x4 k = *(const f32x4*)(P.in[I_CKR] + src * 64 + 4 * lane); u32x2 w; w.x = cvt_pk_bf16(k[0], k[1]); w.y = cvt_pk_bf16(k[2], k[3]); *(u32x2*)(KR + arow * 64 + 4 * lane) = w; }
    }
}

__device__ __forceinline__ float log_sigmoid_(float x) { return -__logf(1.0f + __expf(-x)); }
template <int SCALE_MODE>
__device__ __forceinline__ void stage_vtile(LAS char* dst, const bf16_t* src, int ld, int tid, float lg2, int jbase) {
#pragma unroll
    for (int i = 0; i < 2; ++i) { const int p = tid + 512 * i, k = p >> 4, c8 = (p & 15) * 8;
        u32x4 u = *(const u32x4*)(src + (size_t)k * ld + c8);
        if (SCALE_MODE != 0) { const float jj = (float)(jbase + k); const float f = __builtin_amdgcn_exp2f(lg2 * (SCALE_MODE == 1 ? (127.0f - jj) : jj));
            u.x = cvt_pk_bf16(bf_lo(u.x) * f, bf_hi(u.x) * f); u.y = cvt_pk_bf16(bf_lo(u.y) * f, bf_hi(u.y) * f); u.z = cvt_pk_bf16(bf_lo(u.z) * f, bf_hi(u.z) * f); u.w = cvt_pk_bf16(bf_lo(u.w) * f, bf_hi(u.w) * f); }
        *(LAS u32x4*)(dst + att::v_st(k, c8)) = u; }
}
__device__ __forceinline__ void ret_kv_unit(const Ctx& F, int l, int u) {
    CParams& P = *F.p; unsigned char* ws = P.ws;
    const int c = u >> 2, h = u & 3, row0 = c * 128, tid = F.tid, lane = F.lane, w = F.wave;
    const bf16_t* PROJ = (const bf16_t*)(ws + WS_PROJ);
    const float lgf2 = log_sigmoid_(P.in[I_RDF][l * 4 + h]) * 1.4426950408889634f, lgb2 = log_sigmoid_(P.in[I_RDB][l * 4 + h]) * 1.4426950408889634f;
    LAS char* lds = (LAS char*)F.lds;
#pragma nounroll
    for (int jt = 0; jt < 2; ++jt) {
        const bf16_t* ksrc = PROJ + (size_t)(row0 + jt * 64) * NPROJ + C_BK + h * 128;
        stage_vtile<1>(lds + jt * 16384, ksrc, NPROJ, tid, lgf2, jt * 64);
        stage_vtile<2>(lds + 32768 + jt * 16384, ksrc, NPROJ, tid, lgb2, jt * 64);
#pragma nounroll
        for (int eh = 0; eh < 2; ++eh) stage_vtile<0>(lds + 65536 + (jt * 2 + eh) * 16384, PROJ + (size_t)(row0 + jt * 64) * NPROJ + C_BV + h * 256 + eh * 128, NPROJ, tid, 0.f, 0);
    }
    __syncthreads();
    const int dblk = w & 3, eh = w >> 2;
    f32x16 accF[4] = {}, accB[4] = {};
#pragma nounroll
    for (int jt = 0; jt < 2; ++jt) {
        const int vbF = (int)(uintptr_t)lds + jt * 16384 + att::v_rd_base(lane) + dblk * 512, vbB = 32768 + vbF, vbV = 65536 + (jt * 2 + eh) * 16384 + att::v_rd_base(lane);
#define KVSTEP(KS) do { \
        const s16x4 fl = att::tr_read<att::v_rd_off(0, KS, 0)>(vbF), fh = att::tr_read<att::v_rd_off(0, KS, 1)>(vbF), bl = att::tr_read<att::v_rd_off(0, KS, 0)>(vbB), bh = att::tr_read<att::v_rd_off(0, KS, 1)>(vbB); \
        const s16x4 v0l = att::tr_read<att::v_rd_off(0, KS, 0)>(vbV), v0h = att::tr_read<att::v_rd_off(0, KS, 1)>(vbV), v1l = att::tr_read<att::v_rd_off(1, KS, 0)>(vbV), v1h = att::tr_read<att::v_rd_off(1, KS, 1)>(vbV); \
        const s16x4 v2l = att::tr_read<att::v_rd_off(2, KS, 0)>(vbV), v2h = att::tr_read<att::v_rd_off(2, KS, 1)>(vbV), v3l = att::tr_read<att::v_rd_off(3, KS, 0)>(vbV), v3h = att::tr_read<att::v_rd_off(3, KS, 1)>(vbV); \
        asm volatile("s_waitcnt lgkmcnt(0)" ::: "memory"); SBAR(); \
        const bf16x8 af = PKLH(fl, fh), ab = PKLH(bl, bh), b0 = PKLH(v0l, v0h), b1 = PKLH(v1l, v1h), b2 = PKLH(v2l, v2h), b3 = PKLH(v3l, v3h); \
        accF[0] = __builtin_amdgcn_mfma_f32_32x32x16_bf16(af, b0, accF[0], 0, 0, 0); accB[0] = __builtin_amdgcn_mfma_f32_32x32x16_bf16(ab, b0, accB[0], 0, 0, 0); \
        accF[1] = __builtin_amdgcn_mfma_f32_32x32x16_bf16(af, b1, accF[1], 0, 0, 0); accB[1] = __builtin_amdgcn_mfma_f32_32x32x16_bf16(ab, b1, accB[1], 0, 0, 0); \
        accF[2] = __builtin_amdgcn_mfma_f32_32x32x16_bf16(af, b2, accF[2], 0, 0, 0); accB[2] = __builtin_amdgcn_mfma_f32_32x32x16_bf16(ab, b2, accB[2], 0, 0, 0); \
        accF[3] = __builtin_amdgcn_mfma_f32_32x32x16_bf16(af, b3, accF[3], 0, 0, 0); accB[3] = __builtin_amdgcn_mfma_f32_32x32x16_bf16(ab, b3, accB[3], 0, 0, 0); } while (0)
        KVSTEP(0); KVSTEP(1); KVSTEP(2); KVSTEP(3);
#undef KVSTEP
    }
    float* RKV = (float*)(ws + WS_RKV) + ((size_t)(c * 4 + h) * 2) * RET_ST;
    const int r32 = lane & 31, hi = lane >> 5;
#pragma unroll
    for (int r = 0; r < 16; ++r) { const int d = dblk * 32 + att::crow(r, hi);
#pragma unroll
        for (int eb = 0; eb < 4; ++eb) { const int e = eh * 128 + eb * 32 + r32; RKV[(size_t)d * 256 + e] = accF[eb][r]; RKV[RET_ST + (size_t)d * 256 + e] = accB[eb][r]; } }
    __syncthreads();
}
__device__ __forceinline__ void phase_scan(const Ctx& F, int l) {
    CParams& P = *F.p; unsigned char* ws = P.ws;
    float* RKV = (float*)(ws + WS_RKV); bf16_t* RS = (bf16_t*)(ws + WS_RS);
    for (int it = F.bid; it < 2304; it += F.G) {
        const bool lat = it < 256; const int q = lat ? it : it - 256; const int combo = q >> 4, slab = q & 15;
        const int dir = combo & 1, h = (combo >> 1) & 3, sb = combo >> 3; const size_t e0 = (size_t)slab * 2048 + F.tid * 4;
        const float cd = __expf(128.0f * log_sigmoid_(P.in[dir ? I_RDB : I_RDF][l * 4 + h]));
        if (lat) {
            f32x4 s = *(const f32x4*)(P.in[dir ? I_SRB : I_SRF] + (((size_t)sb * 4 + l) * 4 + h) * RET_ST + e0);
            for (int t = 0; t < 32; ++t) { const int n = dir ? 31 - t : t; const size_t base = ((size_t)((32 + sb * 32 + n) * 4 + h) * 2 + dir) * RET_ST + e0;
                u32x2 w; w.x = cvt_pk_bf16(s[0], s[1]); w.y = cvt_pk_bf16(s[2], s[3]); *(u32x2*)(RS + base) = w;
                s = s * cd + *(const f32x4*)(RKV + base); }
        } else {
            f32x4 s = {0.f, 0.f, 0.f, 0.f};
#pragma unroll
            for (int t = 0; t < 2; ++t) { const int n = dir ? 1 - t : t; const size_t base = ((size_t)((sb * 2 + n) * 4 + h) * 2 + dir) * RET_ST + e0;
                u32x2 w; w.x = cvt_pk_bf16(s[0], s[1]); w.y = cvt_pk_bf16(s[2], s[3]); *(u32x2*)(RS + base) = w;
                s = s * cd + *(const f32x4*)(RKV + base); }
            *(f32x4*)(P.out + (dir ? O_NRB : O_NRF) + (((size_t)sb * 4 + l) * 4 + h) * RET_ST + e0) = s;
        }
    }
    bf16_t* CQ = (bf16_t*)(ws + WS_CQ);
    const int gw = F.bid * NWAVES + F.wave, NGW = F.G * NWAVES, lane = F.lane;
    for (int r = NCTX + gw; r < NTOK; r += NGW) {
        const int n = (r - NCTX) & 4095, prow = n >> 6, pcol = n & 63;
#pragma unroll
        for (int j = 0; j < 4; ++j) { const int hd = (lane >> 5) + 2 * j; unsigned* p = (unsigned*)(CQ + (size_t)r * 1536 + hd * 192 + 128) + (lane & 31);
            const unsigned u = *p; float y0 = bf_lo(u), y1 = bf_hi(u); rope64(y0, y1, lane & 31, prow, pcol); *p = cvt_pk_bf16(y0, y1); }
    }
}
__device__ __forceinline__ void ret_out_unit(const Ctx& F, int l, int u) {
    CParams& P = *F.p; unsigned char* ws = P.ws;
    const int c = u >> 2, h = u & 3, row0 = c * 128, tid = F.tid, lane = F.lane, w = F.wave, r32 = lane & 31, hi = lane >> 5;
    const bf16_t* PROJ = (const bf16_t*)(ws + WS_PROJ); const bf16_t* RS = (const bf16_t*)(ws + WS_RS) + ((size_t)(c * 4 + h) * 2) * RET_ST;
    const float lgf2 = log_sigmoid_(P.in[I_RDF][l * 4 + h]) * 1.4426950408889634f, lgb2 = log_sigmoid_(P.in[I_RDB][l * 4 + h]) * 1.4426950408889634f;
    LAS char* lds = (LAS char*)F.lds;
    const int qblk = w & 3, eh = w >> 2, qi = qblk * 32 + r32;
    const int ldsb = (int)(uintptr_t)lds;
    const bf16_t* Qw = PROJ + (size_t)(row0 + qi) * NPROJ + C_BQ + h * 128 + hi * 8;
#pragma nounroll
    for (int jt = 0; jt < 2; ++jt) {
        const int sr = tid >> 4, sc = (tid & 15) * 8;
        const bf16_t* ksrc = PROJ + (size_t)(row0 + jt * 64) * NPROJ + C_BK + h * 128;
        *(LAS bf16x8*)(lds + jt * 16384 + KSWZ(sr, sc * 2)) = *reinterpret_cast<const bf16x8*>(ksrc + (size_t)sr * NPROJ + sc);
        *(LAS bf16x8*)(lds + jt * 16384 + KSWZ(32 + sr, sc * 2)) = *reinterpret_cast<const bf16x8*>(ksrc + (size_t)(32 + sr) * NPROJ + sc);
#pragma nounroll
        for (int e2 = 0; e2 < 2; ++e2) stage_vtile<0>(lds + 32768 + (jt * 2 + e2) * 16384, PROJ + (size_t)(row0 + jt * 64) * NPROJ + C_BV + h * 256 + e2 * 128, NPROJ, tid, 0.f, 0);
    }
    __syncthreads();
    f32x16 o[4] = {};
    {
        bf16x8 qr[8];
#pragma unroll
        for (int d0 = 0; d0 < 8; ++d0) qr[d0] = *reinterpret_cast<const bf16x8*>(Qw + d0 * 16);
#pragma nounroll
        for (int jt = 0; jt < 2; ++jt) {
            f32x16 p0, p1; att::qkt<128>(p0, p1, lds + jt * 16384, lds, qr, r32, hi);
#pragma unroll
            for (int r = 0; r < 16; ++r) {
                const int j0 = jt * 64 + att::crow(r, hi), j1 = j0 + 32; const int d0 = qi - j0, d1 = qi - j1;
                const float w0 = d0 > 0 ? __builtin_amdgcn_exp2f(lgf2 * (float)d0) : (d0 < 0 ? __builtin_amdgcn_exp2f(lgb2 * (float)(-d0)) : 2.0f);
                const float w1 = d1 > 0 ? __builtin_amdgcn_exp2f(lgf2 * (float)d1) : (d1 < 0 ? __builtin_amdgcn_exp2f(lgb2 * (float)(-d1)) : 2.0f);
                p0[r] *= w0; p1[r] *= w1; }
            bf16x8 pa0, pa1, pa2, pa3; att::p_to_frags(p0, p1, pa0, pa1, pa2, pa3);
            att::pv_d0(o, ldsb + 32768 + (jt * 2 + eh) * 16384 + att::v_rd_base(lane), pa0, pa1, pa2, pa3);
        }
    }
    __syncthreads();
#pragma nounroll
    for (int t = 0; t < 8; ++t) stage_vtile<0>(lds + t * 16384, RS + (size_t)(t >> 2) * RET_ST + (size_t)(((t >> 1) & 1) * 64) * 256 + (t & 1) * 128, 256, tid, 0.f, 0);
    __syncthreads();
    {
        const float ff = __builtin_amdgcn_exp2f(lgf2 * (float)(qi + 1)), fb = __builtin_amdgcn_exp2f(lgb2 * (float)(128 - qi));
#pragma nounroll
        for (int sd = 0; sd < 4; ++sd) { const float f = (sd >> 1) ? fb : ff; const int dt = sd & 1; bf16x8 pa[4];
#pragma unroll
            for (int k = 0; k < 4; ++k) { const u32x4 q4 = *reinterpret_cast<const u32x4*>(Qw + (dt * 4 + k) * 16); u32x4 s4;
                s4.x = cvt_pk_bf16(bf_lo(q4.x) * f, bf_hi(q4.x) * f); s4.y = cvt_pk_bf16(bf_lo(q4.y) * f, bf_hi(q4.y) * f); s4.z = cvt_pk_bf16(bf_lo(q4.z) * f, bf_hi(q4.z) * f); s4.w = cvt_pk_bf16(bf_lo(q4.w) * f, bf_hi(q4.w) * f);
                pa[k] = *reinterpret_cast<const bf16x8*>(&s4); }
            att::pv_d0(o, ldsb + (sd * 2 + eh) * 16384 + att::v_rd_base(lane), pa[0], pa[1], pa[2], pa[3]); }
    }
    LAS float* rsum = (LAS float*)(F.lds + LDS_RS_OFF);
    float ss[16];
#pragma unroll
    for (int r = 0; r < 16; ++r) { float s = 0.f;
#pragma unroll
        for (int d0 = 0; d0 < 4; ++d0) s += o[d0][r] * o[d0][r];
        s += swz_xor<1>(s); s += swz_xor<2>(s); s += swz_xor<4>(s); s += swz_xor<8>(s); s += swz_xor<16>(s); ss[r] = s; }
    if (r32 == 0) {
#pragma unroll
        for (int r = 0; r < 16; ++r) rsum[eh * 128 + qblk * 32 + att::crow(r, hi)] = ss[r]; }
    __syncthreads();
    const float* gn = P.in[I_RGN] + l * 1024 + h * 256; bf16_t* OB = (bf16_t*)(ws + WS_OABC + SZ_O1);
#pragma unroll
    for (int r = 0; r < 16; ++r) { const int i = qblk * 32 + att::crow(r, hi);
        const float rs = 1.0f / sqrtf((rsum[i] + rsum[128 + i]) * (1.0f / 256.0f) + EPS);
#pragma unroll
        for (int d0 = 0; d0 < 4; ++d0) { const int e = eh * 128 + d0 * 32 + r32;
            const float g = __uint_as_float((unsigned)PROJ[(size_t)(row0 + i) * NPROJ + C_BG + h * 256 + e] << 16);
            OB[(size_t)(row0 + i) * 1024 + h * 256 + e] = (bf16_t)(cvt_pk_bf16(o[d0][r] * rs * gn[e] * siluf_(g), 0.f) & 0xffffu); } }
    __syncthreads();
}

constexpr int NPH_L = 11, NPH = 2 + DEPTH * NPH_L;
__global__ void __launch_bounds__(NTHR, 2) mega(Params prm) {
    extern __shared__ __attribute__((aligned(16))) unsigned char lds_raw[];
    Ctx F; F.lds = (LAS unsigned char*)lds_raw; F.tid = threadIdx.x; F.lane = F.tid & 63; F.wave = __builtin_amdgcn_readfirstlane(F.tid >> 6); F.bid = blockIdx.x; F.G = gridDim.x; F.p = (CParams*)__builtin_amdgcn_kernarg_segment_ptr();
    unsigned char* ws = F.p->ws;
    for (int u = F.tid; u < 128; u += NTHR) ((LAS unsigned*)(F.lds + LDSCTL_OFF))[u] = 0u;
    __syncthreads();
    const int lo = F.p->ph_lo, hi = F.p->ph_hi; const bool multi = (hi - lo) > 1;
    XcdBarrier bar; bar.bar = (unsigned*)(ws + WS_CTL); bar.x = 0; bar.st = nullptr;
    if (multi) bar = xcd_barrier_post((unsigned*)(ws + WS_CTL), (volatile LAS unsigned*)(F.lds + LDSCTL_OFF + 32));
#ifndef SUB_MASK
#define SUB_MASK 15
#endif
#ifndef PH_MASK
#define PH_MASK 0xFFFF
#endif
#define IN(k) (lo <= (k) && (k) < hi)
#define RELANE() do { int l_; asm volatile("v_mbcnt_lo_u32_b32 %0, -1, 0\n\tv_mbcnt_hi_u32_b32 %0, -1, %0" : "=v"(l_)); F.lane = l_; F.tid = F.wave * 64 + l_; } while (0)
#define FRESH() do { int l_; asm volatile("v_mbcnt_lo_u32_b32 %0, -1, 0\n\tv_mbcnt_hi_u32_b32 %0, -1, %0" : "=v"(l_)); F.lane = l_; F.tid = F.wave * 64 + l_; CParams* kp_ = (CParams*)__builtin_amdgcn_kernarg_segment_ptr(); asm volatile("" : "+s"(kp_)); F.p = kp_; } while (0)
#define SEAM(k) do { if (IN(k) && IN((k) + 1)) xcd_barrier(bar, F.tid == 0); } while (0)
    float* X = F.p->out;
    const float* MOD = (const float*)(ws + WS_MOD);
    bf16_t* H = (bf16_t*)(ws + WS_H); bf16_t* PROJ = (bf16_t*)(ws + WS_PROJ);
    float* PART = (float*)(ws + WS_PART);

    if ((PH_MASK & 1) && IN(0)) { FRESH(); phase_prologue(F); SEAM(0); }
    if ((PH_MASK & 2) && IN(1)) { FRESH(); norm_phase(F, F.p->in[I_XP], F.p->in[I_XS], nullptr, nullptr, X, H, nullptr, 0, nullptr, MOD, 2048, 0, F.p->in[I_GPMIX]); SEAM(1); }

    for (int l = 0; l < DEPTH; ++l) {
        const int pb = 2 + l * NPH_L; const float* MODL = MOD + (size_t)l * 3 * 12288;
        if ((PH_MASK & 4) && IN(pb + 0)) { FRESH();
            pg8::EpiBf16<0> E{PROJ, NPROJ};
            pg8::gemm_phase<pg8::EpiBf16<0>, NTOK, NPROJ, DM, DM, DM, 1, false, 0, 0>(F.lds, F.tid, H, ws + WS_WIN + l * SZ_WIN, F.G, F.bid, E);
            SEAM(pb + 0);
        }
        if ((PH_MASK & 8) && IN(pb + 1)) { FRESH(); phase_postproj(F, l); SEAM(pb + 1); }
        if ((PH_MASK & 16) && IN(pb + 2)) { FRESH();
            if (SUB_MASK & 1) { pg8::EpiBf16<0> E{(bf16_t*)(ws + WS_CQ), 1536};
              pg8::gemm_phase<pg8::EpiBf16<0>, NTOK, 1536, NPROJ, 512, 512, 1, false, 0, 0>(F.lds, F.tid, PROJ + C_CQL, ws + WS_WUQ + l * SZ_WUQ, F.G, F.bid, E); }
            if (SUB_MASK & 2) { FRESH(); pg8::EpiBf16<0> E{(bf16_t*)(ws + WS_KVUP), 2048};
              pg8::gemm_phase<pg8::EpiBf16<0>, NALL, 2048, 256, 256, 256, 1, false, 0, 0>(F.lds, F.tid, ws + WS_CKV, ws + WS_WUKV + l * SZ_WUKV, F.G, F.G - 1 - F.bid, E); }
            if (SUB_MASK & 4) { FRESH(); for (int u = F.bid; u < 384; u += F.G) { RELANE(); ret_kv_unit(F, l, u); } }
            FRESH();
            if (SUB_MASK & 8) for (int u = F.bid; u < 384; u += F.G) {
                RELANE(); int row0, kv0, seq, h;
                if (u < 256) { const int b = u >> 7; h = (u >> 4) & 7; row0 = NCTX + b * 4096 + (u & 15) * 256; kv0 = NCTX + b * KVL; seq = KVL; }
                else { const int s = (u - 256) >> 3; h = (u - 256) & 7; row0 = s * 256; kv0 = s * 256; seq = 256; }
                att::attn_body<128, NPROJ, 256, 256, 1024>(PROJ + (size_t)row0 * NPROJ + C_AQ + h * 128, (const bf16_t*)(ws + WS_KA) + (size_t)kv0 * 256 + (h >> 2) * 128, nullptr,
                    (const bf16_t*)(ws + WS_VA) + (size_t)kv0 * 256 + (h >> 2) * 128, (bf16_t*)(ws + WS_OABC) + (size_t)row0 * 1024 + h * 128, seq, (LAS char*)F.lds, F.tid);
            }
            SEAM(pb + 2);
        }
        if ((PH_MASK & 32) && IN(pb + 3)) { FRESH(); phase_scan(F, l); SEAM(pb + 3); }
        if ((PH_MASK & 64) && IN(pb + 4)) { FRESH();
            FRESH();
            if (SUB_MASK & 2) for (int u = (F.bid + F.G / 2) % F.G; u < 384; u += F.G) {
                RELANE(); int row0, kv0, seq, h;
                if (u < 256) { const int b = u >> 7; h = (u >> 4) & 7; row0 = NCTX + b * 4096 + (u & 15) * 256; kv0 = NCTX + b * KVL; seq = KVL; }
                else { const int s = (u - 256) >> 3; h = (u - 256) & 7; row0 = s * 256; kv0 = s * 256; seq = 256; }
                att::attn_simple<192, 1536, 2048, 2048, 1024>((const bf16_t*)(ws + WS_CQ) + (size_t)row0 * 1536 + h * 192, (const bf16_t*)(ws + WS_KVUP) + (size_t)kv0 * 2048 + h * 256,
                    (const bf16_t*)(ws + WS_KROPE) + (size_t)kv0 * 64, (const bf16_t*)(ws + WS_KVUP) + (size_t)kv0 * 2048 + h * 256 + 128,
                    (bf16_t*)(ws + WS_OABC + 2 * SZ_O1) + (size_t)row0 * 1024 + h * 128, seq, (LAS char*)F.lds, F.tid);
            }
            FRESH();
            if (SUB_MASK & 4) for (int u = (F.bid + F.G / 2) % F.G; u < 384; u += F.G) { RELANE(); ret_out_unit(F, l, u); }
            SEAM(pb + 4);
        }
        if ((PH_MASK & 128) && IN(pb + 5)) { FRESH();
            pg8::EpiBranch E{PROJ + C_GATE, NPROJ, PART, (bf16_t*)(ws + WS_MERGED)};
            pg8::gemm_phase<pg8::EpiBranch, NTOK, DM, 1024, 1024, 1024, 3, true, SZ_O1, SZ_WBR1>(F.lds, F.tid, ws + WS_OABC, ws + WS_WBR + (size_t)l * 3 * SZ_WBR1, F.G, F.bid, E);
            SEAM(pb + 5);
        }
        if ((PH_MASK & 256) && IN(pb + 6)) { FRESH();
            pg8::EpiF32Z E{PART, DM, (size_t)NTOK * DM};
            pg8::gemm_phase<pg8::EpiF32Z, NTOK, DM, DM, DM, 1024, 2, false, 2048, 2048>(F.lds, F.tid, ws + WS_MERGED, ws + WS_WOUT + l * SZ_WOUT, F.G, F.bid, E);
            SEAM(pb + 6);
        }
        if ((PH_MASK & 512) && IN(pb + 7)) { FRESH();
            norm_phase(F, X, X + (size_t)NCTX * DM, PART, PART + (size_t)NTOK * DM, X, H, MODL, 4096, F.p->in[I_GPOMIX] + l * DM, MODL, 8192, 6144, F.p->in[I_GPMLP] + l * DM);
            SEAM(pb + 7);
        }
        if ((PH_MASK & 1024) && IN(pb + 8)) { FRESH();
            pg8::EpiBf16<1> E{PROJ, DFF};
            pg8::gemm_phase<pg8::EpiBf16<1>, NTOK, DFF, DM, DM, DM, 1, false, 0, 0>(F.lds, F.tid, H, ws + WS_WUP + l * SZ_WUP, F.G, F.bid, E);
            SEAM(pb + 8);
        }
        if ((PH_MASK & 2048) && IN(pb + 9)) { FRESH();
            pg8::EpiF32Z E{PART, DM, (size_t)NTOK * DM};
            pg8::gemm_phase<pg8::EpiF32Z, NTOK, DM, DFF, DFF, 4096, 2, false, 8192, 8192>(F.lds, F.tid, PROJ, ws + WS_WDN + l * SZ_WUP, F.G, F.bid, E);
            SEAM(pb + 9);
        }
        if ((PH_MASK & 4096) && IN(pb + 10)) { FRESH();
            const bool more = (l + 1 < DEPTH);
            norm_phase(F, X, X + (size_t)NCTX * DM, PART, PART + (size_t)NTOK * DM, X, H, MODL, 10240, F.p->in[I_GPOMLP] + l * DM,
                       MODL + 3 * 12288, 2048, 0, more ? F.p->in[I_GPMIX] + (l + 1) * DM : nullptr);
            SEAM(pb + 10);
        }
    }
#undef IN
#undef SEAM
}

#ifndef MK_MULTI
#define MK_MULTI 0
#endif
extern "C" void kernel_launch(void* const* d_in, const int* in_sizes, int n_in, void* d_out, int out_size, void* d_ws, size_t ws_size, hipStream_t stream) {
    static int grid = 0;
    if (grid == 0) {
        if (n_in != 32 || out_size != (int)O_END || ws_size < WS_END) { fprintf(stderr, "kernel_launch: unexpected shapes: n_in %d out %d ws %zu (need %zu)\n", n_in, out_size, ws_size, (size_t)WS_END); grid = -1; return; }
        int dev = 0, cus = 0, per_cu = 0;
        if (hipGetDevice(&dev) != hipSuccess || hipDeviceGetAttribute(&cus, hipDeviceAttributeMultiprocessorCount, dev) != hipSuccess) { grid = -1; return; }
        if (hipFuncSetAttribute((const void*)mega, hipFuncAttributeMaxDynamicSharedMemorySize, LDS_BYTES) != hipSuccess) { fprintf(stderr, "kernel_launch: hipFuncSetAttribute failed\n"); grid = -1; return; }
        if (hipOccupancyMaxActiveBlocksPerMultiprocessor(&per_cu, (const void*)mega, NTHR, LDS_BYTES) != hipSuccess || per_cu < 1) fprintf(stderr, "kernel_launch: occupancy query says %d\n", per_cu);
        (void)hipGetLastError();
        grid = cus;
    }
    if (grid < 0) return;
    (void)hipMemsetAsync((char*)d_ws + WS_CTL, 0, CTL_BYTES, stream);
    Params p{};
    for (int i = 0; i < 32; ++i) p.in[i] = (const float*)d_in[i];
    p.out = (float*)d_out; p.ws = (unsigned char*)d_ws;
#if MK_MULTI
    for (int k = 0; k < NPH; ++k) { p.ph_lo = k; p.ph_hi = k + 1; hipLaunchKernelGGL(mega, dim3(grid), dim3(NTHR), LDS_BYTES, stream, p); }
#else
    p.ph_lo = 0; p.ph_hi = NPH;
    hipLaunchKernelGGL(mega, dim3(grid), dim3(NTHR), LDS_BYTES, stream, p);
#endif
    const hipError_t le = hipPeekAtLastError();
    if (le != hipSuccess) fprintf(stderr, "kernel_launch: launch failed: %s\n", hipGetErrorName(le));
}
```

```cpp
#include <hip/hip_runtime.h>
#include <cstdio>
#include <cstdint>

#define LAS __attribute__((address_space(3)))
#define GAS __attribute__((address_space(1)))
typedef unsigned short bf16_t;
typedef short bf16x8 __attribute__((ext_vector_type(8)));
typedef short s16x4 __attribute__((ext_vector_type(4)));
typedef float f32x4 __attribute__((ext_vector_type(4)));
typedef float f32x2 __attribute__((ext_vector_type(2)));
typedef float f32x16 __attribute__((ext_vector_type(16)));
typedef unsigned u32x4 __attribute__((ext_vector_type(4)));
typedef unsigned u32x2 __attribute__((ext_vector_type(2)));

constexpr int DM = 2048, NCTX = 4096, NLAT = 8192, NTOK = 12288, DEPTH = 4, DFF = 8192;
constexpr int NPROJ = 11776;
constexpr int C_AQ = 0, C_AK = 1024, C_AV = 1280, C_BQ = 1536, C_BK = 2048, C_BV = 2560, C_BG = 3584, C_CQL = 4608, C_CKV = 5120, C_CKR = 5376, C_GATE = 5632;
constexpr int NALL = 13312;
constexpr int KVL = 4608;
constexpr float EPS = 1e-6f;
constexpr int NWAVES = 8, NTHR = 512;

constexpr size_t WS_CTL = 0, CTL_BYTES = 1u << 20;
constexpr size_t WS_MOD = CTL_BYTES;
constexpr size_t WS_WIN = 2u << 20;
constexpr size_t SZ_WIN = (size_t)NPROJ * DM * 2;
constexpr size_t WS_WUQ = WS_WIN + 4 * SZ_WIN;
constexpr size_t SZ_WUQ = (size_t)1536 * 512 * 2;
constexpr size_t WS_WUKV = WS_WUQ + 4 * SZ_WUQ;
constexpr size_t SZ_WUKV = (size_t)2048 * 256 * 2;
constexpr size_t WS_WBR = WS_WUKV + 4 * SZ_WUKV;
constexpr size_t SZ_WBR1 = (size_t)2048 * 1024 * 2;
constexpr size_t WS_WOUT = WS_WBR + 12 * SZ_WBR1;
constexpr size_t SZ_WOUT = (size_t)2048 * 2048 * 2;
constexpr size_t WS_WUP = WS_WOUT + 4 * SZ_WOUT;
constexpr size_t SZ_WUP = (size_t)8192 * 2048 * 2;
constexpr size_t WS_WDN = WS_WUP + 4 * SZ_WUP;
constexpr size_t WS_H = WS_WDN + 4 * SZ_WUP;
constexpr size_t WS_PROJ = WS_H + (size_t)NTOK * DM * 2;
constexpr size_t WS_KA = WS_PROJ + (size_t)NTOK * NPROJ * 2;
constexpr size_t WS_VA = WS_KA + (size_t)NALL * 256 * 2;
constexpr size_t WS_CKV = WS_VA + (size_t)NALL * 256 * 2;
constexpr size_t WS_KROPE = WS_CKV + (size_t)NALL * 256 * 2;
constexpr size_t WS_CQ = WS_KROPE + (size_t)NALL * 64 * 2;
constexpr size_t WS_KVUP = WS_CQ + (size_t)NTOK * 1536 * 2;
constexpr size_t WS_OABC = WS_KVUP + (size_t)NALL * 2048 * 2;
constexpr size_t SZ_O1 = (size_t)NTOK * 1024 * 2;
constexpr size_t WS_MERGED = WS_OABC + 3 * SZ_O1;
constexpr size_t WS_PART = WS_MERGED + (size_t)NTOK * DM * 2;
constexpr size_t SZ_PART1 = (size_t)NTOK * DM * 4;
constexpr size_t WS_END = WS_PART + 2 * SZ_PART1;
constexpr size_t RET_ST = 32768;
constexpr size_t WS_RKV = WS_PART;
constexpr size_t WS_RS = WS_PART + (size_t)96 * 4 * 2 * RET_ST * 4;
static_assert(WS_RS + (size_t)96 * 4 * 2 * RET_ST * 2 <= WS_END, "ws map");

constexpr int LDS_BYTES = 147456;
constexpr int LDSCTL_OFF = 131072;
constexpr int LDS_RS_OFF = 131072 + 1024;

__device__ __forceinline__ unsigned cvt_pk_bf16(float lo, float hi) { unsigned r; asm volatile("v_cvt_pk_bf16_f32 %0, %1, %2" : "=v"(r) : "v"(lo), "v"(hi)); return r; }
__device__ __forceinline__ float bf_lo(unsigned u) { return __uint_as_float(u << 16); }
__device__ __forceinline__ float bf_hi(unsigned u) { return __uint_as_float(u & 0xffff0000u); }
template <int X> __device__ __forceinline__ float swz_xor(float v) { return __int_as_float(__builtin_amdgcn_ds_swizzle(__float_as_int(v), 0x1f | (X << 10))); }
__device__ __forceinline__ float wave_sum(float v) {
    v += swz_xor<1>(v); v += swz_xor<2>(v); v += swz_xor<4>(v); v += swz_xor<8>(v); v += swz_xor<16>(v);
    auto rr = __builtin_amdgcn_permlane32_swap(__float_as_uint(v), __float_as_uint(v), false, false);
    return __uint_as_float(rr[0]) + __uint_as_float(rr[1]);
}
__device__ __forceinline__ float fast_exp(float x) { return __builtin_amdgcn_exp2f(x * 1.4426950408889634f); }
__device__ __forceinline__ float sigmoidf_(float x) { return __builtin_amdgcn_rcpf(1.0f + fast_exp(-x)); }
__device__ __forceinline__ float siluf_(float x) { return x * sigmoidf_(x); }
#define LDS_WAIT() asm volatile("s_waitcnt lgkmcnt(0)" ::: "memory")
#define VM_WAIT() asm volatile("s_waitcnt vmcnt(0)" ::: "memory")

#define XB_TMO      128
#define XB_XCNT(j)  (256  + 64 * (j))
#define XB_XSUB(j)  (1280 + 64 * (j))
#define XB_XGEN(j)  (2304 + 64 * (j))
#define XB_TOP      3328
#define XB_TOPGEN   3392
#define XCD_BAR_WORDS 3456
#define XB_SPIN_CAP (1u << 22)
__device__ __forceinline__ unsigned xb_ld(unsigned* p)              { return __hip_atomic_load(p, __ATOMIC_RELAXED, __HIP_MEMORY_SCOPE_AGENT); }
__device__ __forceinline__ unsigned xb_add(unsigned* p, unsigned v) { return __hip_atomic_fetch_add(p, v, __ATOMIC_RELAXED, __HIP_MEMORY_SCOPE_AGENT); }
__device__ __forceinline__ unsigned xb_xcc_id() { return (unsigned)__builtin_amdgcn_s_getreg((3 << 11) | 20) & 0xFu; }
#define XB_SPIN(cond, bar) do { unsigned _sp = 0; while (cond) { __builtin_amdgcn_s_sleep(1); \
    if ((++_sp & 255u) == 0u) { if (xb_ld(&(bar)[XB_TMO])) break; if (_sp > XB_SPIN_CAP) { atomicAdd(&(bar)[XB_TMO], 1u); break; } } } } while (0)
struct XcdBarrier { unsigned* bar; unsigned x; volatile LAS unsigned* st; };
__device__ __forceinline__ XcdBarrier xcd_barrier_post(unsigned* bar, volatile LAS unsigned* st) {
    XcdBarrier b; b.bar = bar; b.x = xb_xcc_id(); b.st = st;
    if (threadIdx.x == 0) (void)xb_add(&bar[XB_XCNT(b.x)], 1u);
    return b;
}
__device__ __forceinline__ void xcd_barrier_complete(unsigned* bar, unsigned x, unsigned& nloc, unsigned& nx) {
    const unsigned G = gridDim.x * gridDim.y * gridDim.z;
    unsigned sum, cnt, mine, sp = 0u;
    for (;;) {
        sum = 0u; cnt = 0u; mine = 0u;
#pragma unroll
        for (unsigned j = 0; j < 16; ++j) { const unsigned c = xb_ld(&bar[XB_XCNT(j)]); sum += c; cnt += (c > 0u) ? 1u : 0u; mine = (j == x) ? c : mine; }
        if (sum == G) break;
        __builtin_amdgcn_s_sleep(1);
        if ((++sp & 255u) == 0u) { if (xb_ld(&bar[XB_TMO])) break; if (sp > XB_SPIN_CAP) { atomicAdd(&bar[XB_TMO], 1u); break; } }
    }
    nloc = mine > 0u ? mine : 1u; nx = cnt > 0u ? cnt : 1u;
}
__device__ __forceinline__ void xcd_barrier(const XcdBarrier& b, const bool leader) {
    asm volatile("s_waitcnt vmcnt(0)" ::: "memory");
    __syncthreads();
    if (leader) {
        unsigned* bar = b.bar;
        __builtin_amdgcn_s_waitcnt(0);
        unsigned nloc = b.st[0], nx = b.st[1];
        if (nloc == 0u) { xcd_barrier_complete(bar, b.x, nloc, nx); b.st[0] = nloc; b.st[1] = nx; }
        const unsigned old = xb_add(&bar[XB_XSUB(b.x)], 1u);
        const unsigned gen = old / nloc;
        if (old + 1u == (gen + 1u) * nloc) {
            __builtin_amdgcn_fence(__ATOMIC_RELEASE, "agent");
            asm volatile("s_waitcnt vmcnt(0)" ::: "memory");
            const unsigned og = xb_add(&bar[XB_TOP], 1u);
            const unsigned tg = og / nx;
            if (og + 1u == (tg + 1u) * nx) xb_add(&bar[XB_TOPGEN], 1u);
            else XB_SPIN(xb_ld(&bar[XB_TOPGEN]) == tg, bar);
            __builtin_amdgcn_fence(__ATOMIC_ACQUIRE, "agent");
            xb_add(&bar[XB_XGEN(b.x)], 1u);
            asm volatile("s_waitcnt vmcnt(0)" ::: "memory");
        } else {
            XB_SPIN(xb_ld(&bar[XB_XGEN(b.x)]) == gen, bar);
            __builtin_amdgcn_fence(__ATOMIC_ACQUIRE, "agent");
            asm volatile("s_waitcnt vmcnt(0)" ::: "memory");
        }
    }
    __syncthreads();
}

namespace pg8 {
constexpr int BM = 256, BK = 64, HALF = 128, HTB = HALF * BK * 2, STAGE_BYTES = 8 * HTB, NXCD = 8, WGM = 8;
__host__ __device__ __forceinline__ int lds_byte(int r, int c) { const int st = (r >> 4) * 2 + (c >> 5), rr = r & 15, cc = c & 31, ob = rr * 64 + cc * 2; return st * 1024 + (ob ^ (((ob >> 9) & 1) << 5)); }
__host__ __device__ __forceinline__ void stage_rc(int b, int& R, int& C) { const int st = b / 1024, sb = b % 1024, swz = sb ^ (((sb >> 9) & 1) << 5); R = (st >> 1) * 16 + swz / 64; C = (st & 1) * 32 + (swz % 64) / 2; }
__host__ __device__ __forceinline__ int perm32(int rho) { const int n = rho >> 4, i = rho & 15; return 8 * (i >> 2) + 4 * n + (i & 3); }

struct Unit { int pm, pn, z; };
template <int M, int N, int NZ, bool ZINNER>
__device__ __forceinline__ bool next_unit(int k, int G, int c, Unit& u) {
    constexpr int nM = M / BM, nN = N / BM, nNx = ZINNER ? nN : nN * NZ, nwg = nM * nNx;
    int i, z;
    if (ZINNER) { i = k / NZ; z = k - i * NZ; } else { i = k; z = 0; }
    const int L = i * G + c; if (L >= nwg) return false;
    int wgid = L; { constexpr int q = nwg / NXCD, r = nwg % NXCD; const int xcd = wgid % NXCD, off = wgid / NXCD; wgid = (xcd < r ? xcd * (q + 1) : r * (q + 1) + (xcd - r) * q) + off; }
    constexpr int nig = WGM * nNx; const int gid = wgid / nig, fm = gid * WGM, gsz = (nM - fm) < WGM ? (nM - fm) : WGM;
    u.pm = fm + ((wgid % nig) % gsz); const int pnx = (wgid % nig) / gsz;
    if (ZINNER) { u.pn = pnx; u.z = z; } else { u.z = pnx / nN; u.pn = pnx - u.z * nN; }
    return true;
}

template <int ACT  > struct EpiBf16 {
    static constexpr bool PERM = true;
    bf16_t* O; int ldc; size_t zstride;
    __device__ __forceinline__ void operator()(const f32x4 (&acc)[2][2][4][2], const Unit& u, int wr, int wc, int fr, int fq) const {
        const int row0 = u.pm * BM + wr * 64 + fr; const int col0 = u.pn * BM + wc * 32 + 8 * fq; bf16_t* Oz = O + (size_t)u.z * zstride;
#pragma unroll
        for (int ai = 0; ai < 2; ++ai)
#pragma unroll
            for (int m = 0; m < 4; ++m) { bf16_t* rowp = Oz + (size_t)(row0 + ai * HALF + m * 16) * ldc + col0;
#pragma unroll
                for (int bj = 0; bj < 2; ++bj) { f32x4 v0 = acc[ai][bj][m][0], v1 = acc[ai][bj][m][1];
                    if (ACT == 1) {
#pragma unroll
                        for (int j = 0; j < 4; ++j) { const float a = fmaxf(v0[j], 0.f), b = fmaxf(v1[j], 0.f); v0[j] = a * a; v1[j] = b * b; } }
                    u32x4 w; w.x = cvt_pk_bf16(v0[0], v0[1]); w.y = cvt_pk_bf16(v0[2], v0[3]); w.z = cvt_pk_bf16(v1[0], v1[1]); w.w = cvt_pk_bf16(v1[2], v1[3]);
                    *(u32x4*)(rowp + bj * HALF) = w; } }
    }
};
struct EpiF32Z {
    static constexpr bool PERM = false;
    float* C; int ldc; size_t zstride;
    __device__ __forceinline__ void operator()(const f32x4 (&acc)[2][2][4][2], const Unit& u, int wr, int wc, int fr, int fq) const {
        const int row0 = u.pm * BM + wr * 64 + fr, col0 = u.pn * BM + wc * 32 + 4 * fq; float* Cz = C + (size_t)u.z * zstride;
#pragma unroll
        for (int ai = 0; ai < 2; ++ai)
#pragma unroll
            for (int m = 0; m < 4; ++m) { float* rowp = Cz + (size_t)(row0 + ai * HALF + m * 16) * ldc + col0;
#pragma unroll
                for (int bj = 0; bj < 2; ++bj)
#pragma unroll
                    for (int n = 0; n < 2; ++n) *(f32x4*)(rowp + bj * HALF + n * 16) = acc[ai][bj][m][n]; }
    }
};
struct EpiBranch {
    static constexpr bool PERM = true;
    const bf16_t* gates; int ldg;
    float* scr; bf16_t* O;
    __device__ __forceinline__ void operator()(const f32x4 (&acc)[2][2][4][2], const Unit& u, int wr, int wc, int fr, int fq) const {
        const int row0 = u.pm * BM + wr * 64 + fr; const int col0 = u.pn * BM + wc * 32 + 8 * fq;
#pragma unroll
        for (int ai = 0; ai < 2; ++ai)
#pragma unroll
            for (int m = 0; m < 4; ++m) { const size_t row = (size_t)(row0 + ai * HALF + m * 16);
#pragma unroll
                for (int bj = 0; bj < 2; ++bj) { const int col = col0 + bj * HALF;
                    const u32x4 g = *(const u32x4*)(gates + row * ldg + (size_t)u.z * 2048 + col);
                    f32x4 v0 = acc[ai][bj][m][0], v1 = acc[ai][bj][m][1];
                    v0[0] *= sigmoidf_(bf_lo(g.x)); v0[1] *= sigmoidf_(bf_hi(g.x)); v0[2] *= sigmoidf_(bf_lo(g.y)); v0[3] *= sigmoidf_(bf_hi(g.y));
                    v1[0] *= sigmoidf_(bf_lo(g.z)); v1[1] *= sigmoidf_(bf_hi(g.z)); v1[2] *= sigmoidf_(bf_lo(g.w)); v1[3] *= sigmoidf_(bf_hi(g.w));
                    float* sp = scr + row * 2048 + col;
                    if (u.z != 0) { v0 += *(const f32x4*)sp; v1 += *(const f32x4*)(sp + 4); }
                    if (u.z != 2) { *(f32x4*)sp = v0; *(f32x4*)(sp + 4) = v1; }
                    else { u32x4 w; w.x = cvt_pk_bf16(v0[0], v0[1]); w.y = cvt_pk_bf16(v0[2], v0[3]); w.z = cvt_pk_bf16(v1[0], v1[1]); w.w = cvt_pk_bf16(v1[2], v1[3]);
                        *(u32x4*)(O + row * 2048 + col) = w; } } }
    }
};

template <class Epi, int M, int N, int LDA, int LDB, int KU, int NZ, bool ZINNER, size_t AZS, size_t BZS, bool ALIGN_EPI = true>
__device__ __forceinline__ void gemm_phase(LAS unsigned char* lds, const int tid, const void* Aptr, const void* Bptr, int G, int c, const Epi& E) {
    const char* const Abase = (const char*)Aptr; const char* const Bbase = (const char*)Bptr;
    const int wid = __builtin_amdgcn_readfirstlane(tid >> 6), lane = tid & 63, wr = wid >> 2, wc = wid & 3, fr = lane & 15, fq = lane >> 4;
    constexpr int nt = KU / BK;
    unsigned voffA[2], voffB[2];
#pragma unroll
    for (int i = 0; i < 2; ++i) { int R, C; stage_rc(tid * 16 + i * 8192, R, C); const int Rb = Epi::PERM ? ((R & ~31) + perm32(R & 31)) : R;
        voffA[i] = (unsigned)(R * LDA + C) * 2u; voffB[i] = (unsigned)(Rb * LDB + C) * 2u; }
    constexpr size_t kstep = (size_t)(BK * 2);
    constexpr size_t hstepA = (size_t)HALF * LDA * 2, hstepB = (size_t)HALF * LDB * 2;
    constexpr size_t tstepA = 2 * hstepA, tstepB = 2 * hstepB;
    const unsigned ldsw = (unsigned)wid * 1024u;
    const int aoff = lds_byte(wr * 64 + fr, fq * 8), boff = lds_byte(wc * 32 + fr, fq * 8);
#define PG8_SA(b, h) (((b) * 2 + (h)) * HTB)
#define PG8_SB(b, h) ((4 + (b) * 2 + (h)) * HTB)
#define PG8_STAGE(bufoff, gbase, voff) do { _Pragma("unroll") for (int _i = 0; _i < 2; ++_i) \
        __builtin_amdgcn_global_load_lds((const unsigned*)((const char*)(gbase) + (voff)[_i]), (LAS unsigned*)(lds + (bufoff) + ldsw + _i * 8192), 16, 0, 0); } while (0)
#define PG8_LDA(dst, b, h) do { _Pragma("unroll") for (int m = 0; m < 4; ++m) _Pragma("unroll") for (int k = 0; k < 2; ++k) dst[m][k] = *(const LAS bf16x8*)(lds + PG8_SA(b, h) + aoff + m * 2048 + k * 1024); } while (0)
#define PG8_LDB(dst, b, h) do { _Pragma("unroll") for (int n = 0; n < 2; ++n) _Pragma("unroll") for (int k = 0; k < 2; ++k) dst[n][k] = *(const LAS bf16x8*)(lds + PG8_SB(b, h) + boff + n * 2048 + k * 1024); } while (0)
#define PG8_MMA(ai, bj, At, Bt) do { __builtin_amdgcn_s_setprio(1); _Pragma("unroll") for (int m = 0; m < 4; ++m) _Pragma("unroll") for (int n = 0; n < 2; ++n) _Pragma("unroll") for (int k = 0; k < 2; ++k) \
        acc[ai][bj][m][n] = __builtin_amdgcn_mfma_f32_16x16x32_bf16(Bt[n][k], At[m][k], acc[ai][bj][m][n], 0, 0, 0); __builtin_amdgcn_s_setprio(0); } while (0)
#define PG8_WAIT_V(n) asm volatile("s_waitcnt vmcnt(" #n ")" ::: "memory")
#define PG8_WAIT_L(n) asm volatile("s_waitcnt lgkmcnt(" #n ")" ::: "memory")
#define PG8_BAR __builtin_amdgcn_s_barrier()
#define PG8_SCHED __builtin_amdgcn_sched_barrier(0)
    Unit cur, nxt; int ui = 0;
    if (!next_unit<M, N, NZ, ZINNER>(0, G, c, cur)) return;
    f32x4 acc[2][2][4][2];
#pragma unroll
    for (int a = 0; a < 2; ++a)
#pragma unroll
        for (int b = 0; b < 2; ++b)
#pragma unroll
            for (int m = 0; m < 4; ++m)
#pragma unroll
                for (int n = 0; n < 2; ++n) acc[a][b][m][n] = (f32x4){0.f, 0.f, 0.f, 0.f};
    bf16x8 At[4][2], B0[2][2], B1[2][2];
    const char* cA = Abase + (size_t)cur.z * AZS + (size_t)cur.pm * tstepA; const char* cB = Bbase + (size_t)cur.z * BZS + (size_t)cur.pn * tstepB;
    PG8_STAGE(PG8_SB(0, 0), cB, voffB); PG8_STAGE(PG8_SB(0, 1), cB + hstepB, voffB); PG8_STAGE(PG8_SA(0, 0), cA, voffA); PG8_STAGE(PG8_SA(0, 1), cA + hstepA, voffA);
    if (wr == 1) PG8_BAR;
    PG8_WAIT_V(2); PG8_BAR;
    PG8_STAGE(PG8_SB(1, 0), cB + kstep, voffB); PG8_STAGE(PG8_SA(1, 0), cA + kstep, voffA); PG8_STAGE(PG8_SB(1, 1), cB + hstepB + kstep, voffB);
    PG8_WAIT_V(6); PG8_BAR;
    for (;;) {
        const bool has_next = next_unit<M, N, NZ, ZINNER>(ui + 1, G, c, nxt);
        const char* nA = has_next ? Abase + (size_t)nxt.z * AZS + (size_t)nxt.pm * tstepA : cA; const char* nB = has_next ? Bbase + (size_t)nxt.z * BZS + (size_t)nxt.pn * tstepB : cB;
#pragma nounroll
        for (int t = 0; t < nt; t += 2) {
            const bool last = (t == nt - 2);
            const char* a1 = cA + (size_t)(t + 1) * kstep;
            const char* a2 = last ? nA : cA + (size_t)(t + 2) * kstep; const char* b2 = last ? nB : cB + (size_t)(t + 2) * kstep;
            const char* a3 = a2 + kstep; const char* b3 = b2 + kstep;
            PG8_LDB(B0, 0, 0); PG8_LDB(B1, 0, 1); PG8_SCHED; PG8_LDA(At, 0, 0); PG8_STAGE(PG8_SA(1, 1), a1 + hstepA, voffA);
            PG8_WAIT_V(8); PG8_WAIT_L(0); PG8_BAR; PG8_MMA(0, 0, At, B0); PG8_MMA(0, 1, At, B1); PG8_BAR; PG8_SCHED;
            PG8_LDA(At, 0, 1); PG8_STAGE(PG8_SB(0, 0), b2, voffB); PG8_STAGE(PG8_SB(0, 1), b2 + hstepB, voffB); PG8_STAGE(PG8_SA(0, 0), a2, voffA);
            PG8_WAIT_V(8); PG8_WAIT_L(0); PG8_BAR; PG8_MMA(1, 0, At, B0); PG8_MMA(1, 1, At, B1); PG8_BAR; PG8_SCHED;
            PG8_LDB(B0, 1, 0); PG8_LDB(B1, 1, 1); PG8_SCHED; PG8_LDA(At, 1, 0); PG8_STAGE(PG8_SA(0, 1), a2 + hstepA, voffA);
            PG8_WAIT_V(8); PG8_WAIT_L(0); PG8_BAR; PG8_MMA(0, 0, At, B0); PG8_MMA(0, 1, At, B1); PG8_BAR; PG8_SCHED;
            PG8_LDA(At, 1, 1); PG8_STAGE(PG8_SB(1, 0), b3, voffB); PG8_STAGE(PG8_SB(1, 1), b3 + hstepB, voffB); PG8_STAGE(PG8_SA(1, 0), a3, voffA);
            PG8_WAIT_V(8); PG8_WAIT_L(0); PG8_BAR; PG8_MMA(1, 0, At, B0); PG8_MMA(1, 1, At, B1); PG8_BAR; PG8_SCHED;
        }
        if constexpr (ALIGN_EPI) { if (wr == 0) PG8_BAR; }
        E(acc, cur, wr, wc, fr, fq);
        if (!has_next) break;
#pragma unroll
        for (int a = 0; a < 2; ++a)
#pragma unroll
            for (int b = 0; b < 2; ++b)
#pragma unroll
                for (int m = 0; m < 4; ++m)
#pragma unroll
                    for (int n = 0; n < 2; ++n) acc[a][b][m][n] = (f32x4){0.f, 0.f, 0.f, 0.f};
        cur = nxt; cA = nA; cB = nB; ++ui;
        if constexpr (ALIGN_EPI) { if (wr == 1) PG8_BAR; }
    }
    PG8_WAIT_V(0);
    if constexpr (!ALIGN_EPI) { if (wr == 0) PG8_BAR; }
    PG8_BAR;
#undef PG8_SA
#undef PG8_SB
#undef PG8_STAGE
#undef PG8_LDA
#undef PG8_LDB
#undef PG8_MMA
#undef PG8_WAIT_V
#undef PG8_WAIT_L
#undef PG8_BAR
#undef PG8_SCHED
}
}

namespace att {
constexpr int NW = 8, QBLK = 32, KVBLK = 64;
constexpr int SHM_T = KVBLK * 128 * 2;
#define KSWZ(row, colB) ((row) * 256 + ((colB) ^ (((row) & 7) << 4)))
#define SBAR() __builtin_amdgcn_sched_barrier(0)
__device__ __forceinline__ int crow(int r, int hi) { return (r & 3) + 8 * (r >> 2) + 4 * hi; }
__device__ __forceinline__ int v_st(int k, int c) { const int kk = (k & ~0xC) | ((k & 4) << 1) | ((k & 8) >> 1); return ((kk >> 3) * 4 + (c >> 5)) * 512 + ((kk & 7) * 32 + (c & 31)) * 2; }
__device__ __forceinline__ int v_rd_base(int lane) { return ((lane & 3) << 3) | (((lane >> 2) & 3) << 6) | (((lane >> 4) & 1) << 5) | (((lane >> 5) & 1) << 8); }
constexpr int v_rd_off(int d0, int ks, int half) { return d0 * 512 + ks * 4096 + half * 2048; }
template <int OFF> __device__ __forceinline__ s16x4 tr_read(int vb) {
    s16x4 r; asm volatile("ds_read_b64_tr_b16 %0, %1 offset:%2" : "=&v"(r) : "v"(vb), "i"(OFF) : "memory"); return r;
}
#define PKLH(L, H) (bf16x8){L[0], L[1], L[2], L[3], H[0], H[1], H[2], H[3]}
template <int D0> __device__ __forceinline__ void pv_one(f32x16& od, int vb, bf16x8 pa0, bf16x8 pa1, bf16x8 pa2, bf16x8 pa3) {
    const s16x4 l0 = tr_read<v_rd_off(D0, 0, 0)>(vb), h0 = tr_read<v_rd_off(D0, 0, 1)>(vb), l1 = tr_read<v_rd_off(D0, 1, 0)>(vb), h1 = tr_read<v_rd_off(D0, 1, 1)>(vb);
    const s16x4 l2 = tr_read<v_rd_off(D0, 2, 0)>(vb), h2 = tr_read<v_rd_off(D0, 2, 1)>(vb), l3 = tr_read<v_rd_off(D0, 3, 0)>(vb), h3 = tr_read<v_rd_off(D0, 3, 1)>(vb);
    asm volatile("s_waitcnt lgkmcnt(0)" ::: "memory"); SBAR();
    od = __builtin_amdgcn_mfma_f32_32x32x16_bf16(pa0, PKLH(l0, h0), od, 0, 0, 0);
    od = __builtin_amdgcn_mfma_f32_32x32x16_bf16(pa1, PKLH(l1, h1), od, 0, 0, 0);
    od = __builtin_amdgcn_mfma_f32_32x32x16_bf16(pa2, PKLH(l2, h2), od, 0, 0, 0);
    od = __builtin_amdgcn_mfma_f32_32x32x16_bf16(pa3, PKLH(l3, h3), od, 0, 0, 0);
}
__device__ __forceinline__ void pv_d0(f32x16* o, int vb, bf16x8 pa0, bf16x8 pa1, bf16x8 pa2, bf16x8 pa3) {
    pv_one<0>(o[0], vb, pa0, pa1, pa2, pa3); pv_one<1>(o[1], vb, pa0, pa1, pa2, pa3); pv_one<2>(o[2], vb, pa0, pa1, pa2, pa3); pv_one<3>(o[3], vb, pa0, pa1, pa2, pa3);
}
__device__ __forceinline__ void p_to_frags(const f32x16& p0, const f32x16& p1, bf16x8& pa0, bf16x8& pa1, bf16x8& pa2, bf16x8& pa3) {
#define PK4(P, BASE, OUT) do { unsigned a0 = cvt_pk_bf16(P[BASE + 0], P[BASE + 1]), a1 = cvt_pk_bf16(P[BASE + 2], P[BASE + 3]);   \
    unsigned b0 = cvt_pk_bf16(P[BASE + 4], P[BASE + 5]), b1 = cvt_pk_bf16(P[BASE + 6], P[BASE + 7]);                              \
    auto r0 = __builtin_amdgcn_permlane32_swap(a0, b0, false, false); auto r1 = __builtin_amdgcn_permlane32_swap(a1, b1, false, false); \
    u32x4 w = {r0[0], r1[0], r0[1], r1[1]}; OUT = *reinterpret_cast<bf16x8*>(&w); } while (0)
    PK4(p0, 0, pa0); PK4(p0, 8, pa1); PK4(p1, 0, pa2); PK4(p1, 8, pa3);
#undef PK4
}
template <int DQK> struct Cfg { static constexpr float SCALE = DQK == 128 ? 0.088388347648318440f : 0.072168783648703220f; static constexpr float THR = 8.f; };
template <int DQK>
__device__ __forceinline__ void partialSM(f32x16& p0, f32x16& p1, float& m_reg, float& mn, float& alpha) {
    constexpr float SCALE = Cfg<DQK>::SCALE, THR = Cfg<DQK>::THR;
    constexpr float C = SCALE * 1.4426950408889634f;
    float pmax = p0[0];
#pragma unroll
    for (int r = 1; r < 16; ++r) pmax = fmaxf(pmax, p0[r]);
#pragma unroll
    for (int r = 0; r < 16; ++r) pmax = fmaxf(pmax, p1[r]);
    { auto rr = __builtin_amdgcn_permlane32_swap(__float_as_uint(pmax), __float_as_uint(pmax), false, false);
      pmax = fmaxf(__uint_as_float(rr[0]), __uint_as_float(rr[1])); }
    if (__builtin_expect(__all(pmax - m_reg <= THR / SCALE), 1)) { mn = m_reg; alpha = 1.f; }
    else { mn = fmaxf(m_reg, pmax); alpha = __builtin_amdgcn_exp2f((m_reg - mn) * C); m_reg = mn; }
    float mnC = -mn * C;
#pragma unroll
    for (int r = 0; r < 16; ++r) p0[r] = fmaf(p0[r], C, mnC);
#pragma unroll
    for (int r = 0; r < 16; ++r) p1[r] = fmaf(p1[r], C, mnC);
#pragma unroll
    for (int r = 0; r < 16; ++r) p0[r] = __builtin_amdgcn_exp2f(p0[r]);
}
__device__ __forceinline__ void finishSM(f32x16& p0, f32x16& p1, float alpha, float& l_reg, bf16x8& pa0, bf16x8& pa1, bf16x8& pa2, bf16x8& pa3) {
#pragma unroll
    for (int r = 0; r < 16; ++r) p1[r] = __builtin_amdgcn_exp2f(p1[r]);
    float ps = 0;
#pragma unroll
    for (int r = 0; r < 16; ++r) ps += p0[r];
#pragma unroll
    for (int r = 0; r < 16; ++r) ps += p1[r];
    { auto rr = __builtin_amdgcn_permlane32_swap(__float_as_uint(ps), __float_as_uint(ps), false, false);
      ps = __uint_as_float(rr[0]) + __uint_as_float(rr[1]); }
    l_reg = l_reg * alpha + ps;
    p_to_frags(p0, p1, pa0, pa1, pa2, pa3);
}
template <int DQK>
__device__ __forceinline__ void qkt(f32x16& p0, f32x16& p1, const LAS char* Ks, const LAS char* Rs, const bf16x8* qr, int r32, int hi) {
    p0 = f32x16{}; p1 = f32x16{};
#pragma unroll
    for (int d0 = 0; d0 < 8; ++d0) { const int cb = (d0 * 16 + hi * 8) * 2;
        const bf16x8 b0 = *reinterpret_cast<const LAS bf16x8*>(Ks + KSWZ(r32, cb));
        const bf16x8 b1 = *reinterpret_cast<const LAS bf16x8*>(Ks + KSWZ(32 + r32, cb));
        p0 = __builtin_amdgcn_mfma_f32_32x32x16_bf16(b0, qr[d0], p0, 0, 0, 0);
        p1 = __builtin_amdgcn_mfma_f32_32x32x16_bf16(b1, qr[d0], p1, 0, 0, 0); }
    if constexpr (DQK == 192) {
#pragma unroll
        for (int d0 = 0; d0 < 4; ++d0) { const int cb = (d0 * 16 + hi * 8) * 2;
            const bf16x8 b0 = *reinterpret_cast<const LAS bf16x8*>(Rs + KSWZ(r32, cb));
            const bf16x8 b1 = *reinterpret_cast<const LAS bf16x8*>(Rs + KSWZ(32 + r32, cb));
            p0 = __builtin_amdgcn_mfma_f32_32x32x16_bf16(b0, qr[8 + d0], p0, 0, 0, 0);
            p1 = __builtin_amdgcn_mfma_f32_32x32x16_bf16(b1, qr[8 + d0], p1, 0, 0, 0); }
    }
}
template <int DQK> constexpr int attn_lds_bytes() { return 4 * SHM_T + (DQK == 192 ? 2 * SHM_T : 0) + NW * 64 * 4; }

template <int DQK, int LDQ, int LDK, int LDV, int LDO>
__device__ __forceinline__ void attn_body(const bf16_t* __restrict__ Qb, const bf16_t* __restrict__ Kh, const bf16_t* __restrict__ Rh, const bf16_t* __restrict__ Vh,
                                          bf16_t* __restrict__ Ob, int seq, LAS char* lds, const int tid) {
    constexpr int ND = DQK / 16;
    const int wid = tid >> 6, lane = tid & 63, r32 = lane & 31, hi = lane >> 5;
    LAS char* V_lds = lds; LAS char* K_lds = lds + 2 * SHM_T; LAS char* R_lds = lds + 4 * SHM_T;
    LAS float* wsl = (LAS float*)(lds + 4 * SHM_T + (DQK == 192 ? 2 * SHM_T : 0)) + wid * 64; LAS float* li_l = wsl; LAS float* al_l = wsl + 32;
    float m_reg = -1e30f, l_reg = 0; f32x16 o[4] = {}; bf16x8 qr[ND];
    const bf16_t* Qw = Qb + (long)(wid * QBLK + r32) * LDQ + hi * 8;
#pragma unroll
    for (int d0 = 0; d0 < ND; ++d0) qr[d0] = *reinterpret_cast<const bf16x8*>(Qw + d0 * 16);
    const int sr = tid >> 4, sc = (tid & 15) * 8, vst0 = v_st(sr, sc), vst1 = v_st(32 + sr, sc);
    const int rr = tid >> 3, rc = (tid & 7) * 8;
    const int vb0 = (int)(uintptr_t)V_lds + v_rd_base(lane);
    struct { bf16x8 vs0, vs1, ks0, ks1, rs; } sr_[2];
#define SLOAD(i, k0) do { sr_[i].vs0 = *reinterpret_cast<const bf16x8*>(&Vh[(long)((k0) + sr) * LDV + sc]); sr_[i].vs1 = *reinterpret_cast<const bf16x8*>(&Vh[(long)((k0) + 32 + sr) * LDV + sc]); \
    sr_[i].ks0 = *reinterpret_cast<const bf16x8*>(&Kh[(long)((k0) + sr) * LDK + sc]); sr_[i].ks1 = *reinterpret_cast<const bf16x8*>(&Kh[(long)((k0) + 32 + sr) * LDK + sc]); \
    if constexpr (DQK == 192) sr_[i].rs = *reinterpret_cast<const bf16x8*>(&Rh[(long)((k0) + rr) * 64 + rc]); } while (0)
#define SWRITE(b, i) do { *(LAS bf16x8*)(V_lds + (b) * SHM_T + vst0) = sr_[i].vs0; *(LAS bf16x8*)(V_lds + (b) * SHM_T + vst1) = sr_[i].vs1; const int kc = sc * 2; \
    *(LAS bf16x8*)(K_lds + (b) * SHM_T + KSWZ(sr, kc)) = sr_[i].ks0; *(LAS bf16x8*)(K_lds + (b) * SHM_T + KSWZ(32 + sr, kc)) = sr_[i].ks1; \
    if constexpr (DQK == 192) *(LAS bf16x8*)(R_lds + (b) * SHM_T + KSWZ(rr, rc * 2)) = sr_[i].rs; } while (0)
#define SWAIT() do { if constexpr (DQK == 192) asm volatile("s_waitcnt vmcnt(5)" ::: "memory"); else asm volatile("s_waitcnt vmcnt(4)" ::: "memory"); } while (0)
#define RESC(a) do { if (__any((a) < 1.f)) { if (hi == 0) al_l[r32] = (a); asm volatile("s_waitcnt lgkmcnt(0)" ::: "memory"); \
    _Pragma("unroll") for (int d = 0; d < 4; ++d) _Pragma("unroll") for (int r = 0; r < 16; ++r) o[d][r] *= al_l[crow(r, hi)]; } } while (0)
    f32x16 pA0, pA1, pB0, pB1; float mnA, mnB, alA, alB; bf16x8 pa0, pa1, pa2, pa3; const int NT = seq / KVBLK;
    constexpr int SE = 0, SO = 1;
    SLOAD(SE, 0); asm volatile("s_waitcnt vmcnt(0)" ::: "memory"); SWRITE(0, SE); __syncthreads();
    qkt<DQK>(pA0, pA1, K_lds, R_lds, qr, r32, hi); partialSM<DQK>(pA0, pA1, m_reg, mnA, alA);
    SLOAD(SO, KVBLK); if (2 < NT) SLOAD(SE, 2 * KVBLK);
    SWAIT(); SWRITE(1, SO); __syncthreads();
    for (int j = 1; j + 1 < NT; j += 2) {
        SBAR(); qkt<DQK>(pB0, pB1, K_lds + SHM_T, R_lds + SHM_T, qr, r32, hi);
        finishSM(pA0, pA1, alA, l_reg, pa0, pa1, pa2, pa3); SBAR();
        SLOAD(SO, (j + 2) * KVBLK); SBAR();
        pv_d0(o, vb0, pa0, pa1, pa2, pa3); partialSM<DQK>(pB0, pB1, m_reg, mnB, alB);
        __syncthreads(); SWAIT(); SWRITE(0, SE);
        RESC(alB); __syncthreads();
        SBAR(); qkt<DQK>(pA0, pA1, K_lds, R_lds, qr, r32, hi);
        finishSM(pB0, pB1, alB, l_reg, pa0, pa1, pa2, pa3); SBAR();
        if (j + 3 < NT) SLOAD(SE, (j + 3) * KVBLK); SBAR();
        pv_d0(o, vb0 + SHM_T, pa0, pa1, pa2, pa3); partialSM<DQK>(pA0, pA1, m_reg, mnA, alA);
        __syncthreads(); SWAIT(); SWRITE(1, SO);
        RESC(alA); __syncthreads();
    }
    SBAR(); qkt<DQK>(pB0, pB1, K_lds + SHM_T, R_lds + SHM_T, qr, r32, hi);
    finishSM(pA0, pA1, alA, l_reg, pa0, pa1, pa2, pa3); SBAR();
    pv_d0(o, vb0, pa0, pa1, pa2, pa3); partialSM<DQK>(pB0, pB1, m_reg, mnB, alB);
    __syncthreads(); RESC(alB);
    finishSM(pB0, pB1, alB, l_reg, pa0, pa1, pa2, pa3); SBAR();
    pv_d0(o, vb0 + SHM_T, pa0, pa1, pa2, pa3);
    if (hi == 0) li_l[r32] = l_reg; asm volatile("s_waitcnt lgkmcnt(0)" ::: "memory");
    float rli[16];
#pragma unroll
    for (int r = 0; r < 16; ++r) rli[r] = __builtin_amdgcn_rcpf(li_l[crow(r, hi)]);
    bf16_t* Ow = Ob + (long)(wid * QBLK) * LDO;
#pragma unroll
    for (int r = 0; r < 16; ++r) { const int orow = crow(r, hi);
#pragma unroll
        for (int d0 = 0; d0 < 4; ++d0) Ow[(long)orow * LDO + d0 * 32 + r32] = (bf16_t)(cvt_pk_bf16(o[d0][r] * rli[r], 0.f) & 0xffffu); }
    __syncthreads();
#undef SLOAD
#undef SWRITE
#undef SWAIT
#undef RESC
}
template <int DQK, int LDQ, int LDK, int LDV, int LDO>
__device__ __forceinline__ void attn_simple(const bf16_t* __restrict__ Qb, const bf16_t* __restrict__ Kh, const bf16_t* __restrict__ Rh, const bf16_t* __restrict__ Vh,
                                            bf16_t* __restrict__ Ob, int seq, LAS char* lds, const int tid) {
    constexpr int ND = DQK / 16;
    const int wid = tid >> 6, lane = tid & 63, r32 = lane & 31, hi = lane >> 5;
    LAS char* V_lds = lds; LAS char* K_lds = lds + 2 * SHM_T; LAS char* R_lds = lds + 4 * SHM_T;
    LAS float* wsl = (LAS float*)(lds + 4 * SHM_T + (DQK == 192 ? 2 * SHM_T : 0)) + wid * 64; LAS float* li_l = wsl; LAS float* al_l = wsl + 32;
    float m_reg = -1e30f, l_reg = 0; f32x16 o[4] = {}; bf16x8 qr[ND];
    const bf16_t* Qw = Qb + (long)(wid * QBLK + r32) * LDQ + hi * 8;
#pragma unroll
    for (int d0 = 0; d0 < ND; ++d0) qr[d0] = *reinterpret_cast<const bf16x8*>(Qw + d0 * 16);
    const int sr = tid >> 4, sc = (tid & 15) * 8, vst0 = v_st(sr, sc), vst1 = v_st(32 + sr, sc);
    const int rr = tid >> 3, rc = (tid & 7) * 8;
    const int vb0 = (int)(uintptr_t)V_lds + v_rd_base(lane);
    bf16x8 vs0, vs1, ks0, ks1, rs;
#define SLOAD(k0) do { vs0 = *reinterpret_cast<const bf16x8*>(&Vh[(long)((k0) + sr) * LDV + sc]); vs1 = *reinterpret_cast<const bf16x8*>(&Vh[(long)((k0) + 32 + sr) * LDV + sc]); \
    ks0 = *reinterpret_cast<const bf16x8*>(&Kh[(long)((k0) + sr) * LDK + sc]); ks1 = *reinterpret_cast<const bf16x8*>(&Kh[(long)((k0) + 32 + sr) * LDK + sc]); \
    if constexpr (DQK == 192) rs = *reinterpret_cast<const bf16x8*>(&Rh[(long)((k0) + rr) * 64 + rc]); } while (0)
#define SWRITE(b) do { *(LAS bf16x8*)(V_lds + (b) * SHM_T + vst0) = vs0; *(LAS bf16x8*)(V_lds + (b) * SHM_T + vst1) = vs1; const int kc = sc * 2; \
    *(LAS bf16x8*)(K_lds + (b) * SHM_T + KSWZ(sr, kc)) = ks0; *(LAS bf16x8*)(K_lds + (b) * SHM_T + KSWZ(32 + sr, kc)) = ks1; \
    if constexpr (DQK == 192) *(LAS bf16x8*)(R_lds + (b) * SHM_T + KSWZ(rr, rc * 2)) = rs; } while (0)
    const int NT = seq / KVBLK;
    SLOAD(0); asm volatile("s_waitcnt vmcnt(0)" ::: "memory"); SWRITE(0); __syncthreads();
    if (1 < NT) SLOAD(KVBLK);
    for (int j = 0; j < NT; ++j) {
        const int b = j & 1;
        f32x16 p0, p1; float mn, alpha; bf16x8 pa0, pa1, pa2, pa3;
        qkt<DQK>(p0, p1, K_lds + b * SHM_T, R_lds + b * SHM_T, qr, r32, hi);
        partialSM<DQK>(p0, p1, m_reg, mn, alpha);
        if (__any(alpha < 1.f)) { if (hi == 0) al_l[r32] = alpha; asm volatile("s_waitcnt lgkmcnt(0)" ::: "memory");
#pragma unroll
            for (int d = 0; d < 4; ++d)
#pragma unroll
                for (int r = 0; r < 16; ++r) o[d][r] *= al_l[crow(r, hi)]; }
        finishSM(p0, p1, alpha, l_reg, pa0, pa1, pa2, pa3);
        if (j + 1 < NT) SWRITE(b ^ 1);
        if (j + 2 < NT) SLOAD((j + 2) * KVBLK);
        pv_d0(o, vb0 + b * SHM_T, pa0, pa1, pa2, pa3);
        __syncthreads();
    }
    if (hi == 0) li_l[r32] = l_reg; asm volatile("s_waitcnt lgkmcnt(0)" ::: "memory");
    float rli[16];
#pragma unroll
    for (int r = 0; r < 16; ++r) rli[r] = __builtin_amdgcn_rcpf(li_l[crow(r, hi)]);
    bf16_t* Ow = Ob + (long)(wid * QBLK) * LDO;
#pragma unroll
    for (int r = 0; r < 16; ++r) { const int orow = crow(r, hi);
#pragma unroll
        for (int d0 = 0; d0 < 4; ++d0) Ow[(long)orow * LDO + d0 * 32 + r32] = (bf16_t)(cvt_pk_bf16(o[d0][r] * rli[r], 0.f) & 0xffffu); }
    __syncthreads();
#undef SLOAD
#undef SWRITE
}
}

struct Params {
    const float* in[32];
    float* out; unsigned char* ws;
    int ph_lo, ph_hi;
};
enum { I_XP = 0, I_XS, I_C, I_CAK, I_CAV, I_SRF, I_SRB, I_CCKV, I_CKR, I_CCTX, I_WMOD, I_BMOD, I_GPMIX, I_GPOMIX, I_GPMLP, I_GPOMLP, I_WIN, I_AQN, I_AKN, I_RDF, I_RDB, I_RGN,
       I_MQN, I_MKVN, I_WUQ, I_WUKV, I_WBA, I_WBB, I_WBC, I_WOUT, I_WUP, I_WDN };
constexpr size_t O_YP = 0, O_YS = 8388608, O_NAK = 25165824, O_NAV = O_NAK + 4194304, O_NRF = O_NAV + 4194304, O_NRB = O_NRF + 8388608, O_NCKV = O_NRB + 8388608, O_NKR = O_NCKV + 4194304, O_END = O_NKR + 1048576;

typedef const __attribute__((address_space(4))) Params CParams;
struct Ctx {
    LAS unsigned char* lds; int tid, lane, wave, bid, G;
    CParams* p;
};

__device__ __forceinline__ void transpose_item(const float* W, int K, int N, bf16_t* WT, int n_shift_from, int n_shift, LAS float* scr, int item, int lane) {
    const int nblk = N / 32, kb = item / nblk, nb = item - kb * nblk, k0 = 64 * kb, n0 = 32 * nb;
#pragma unroll 8
    for (int i = 0; i < 32; ++i) { const int kk = 2 * i + (lane >> 5); scr[kk * 33 + (lane & 31)] = W[(size_t)(k0 + kk) * N + n0 + (lane & 31)]; }
    LDS_WAIT(); asm volatile("" ::: "memory");
    const int c = lane & 7; const int r0 = n0 + (n0 >= n_shift_from ? n_shift : 0);
#pragma unroll
    for (int j = 0; j < 4; ++j) { const int n = (lane >> 3) + 8 * j; const LAS float* s = scr + (8 * c) * 33 + n;
        u32x4 o; o.x = cvt_pk_bf16(s[0 * 33], s[1 * 33]); o.y = cvt_pk_bf16(s[2 * 33], s[3 * 33]); o.z = cvt_pk_bf16(s[4 * 33], s[5 * 33]); o.w = cvt_pk_bf16(s[6 * 33], s[7 * 33]);
        *(u32x4*)(WT + (size_t)(r0 + n) * K + k0 + 8 * c) = o; }
    LDS_WAIT(); asm volatile("" ::: "memory");
}
__device__ __forceinline__ void phase_prologue(const Ctx& F) {
    CParams& P = *F.p; unsigned char* ws = P.ws;
    {
        LAS float* sv = (LAS float*)F.lds;
        LAS float* red = (LAS float*)(F.lds + 32768);
        for (int i = F.tid; i < 3 * 2048; i += NTHR) { const int v = i >> 11, k = i & 2047; const float x = (v == 0) ? P.in[I_CCTX][k] : P.in[I_C][(v - 1) * 2048 + k]; sv[i] = siluf_(x); }
        __syncthreads();
        float* MOD = (float*)(ws + WS_MOD);
        const int c4 = F.tid & 15, kq = F.tid >> 4;
        for (int it = F.bid; it < 4 * 192; it += F.G) {
            const int l = it / 192, cg = it - l * 192;
            const float* w = P.in[I_WMOD] + (size_t)l * 2048 * 12288 + cg * 64 + c4 * 4;
            f32x4 a0 = {0, 0, 0, 0}, a1 = a0, a2 = a0;
#pragma unroll 8
            for (int kk = 0; kk < 64; ++kk) { const int k = kq + 32 * kk; const f32x4 wv = *(const f32x4*)(w + (size_t)k * 12288);
                a0 += wv * sv[k]; a1 += wv * sv[2048 + k]; a2 += wv * sv[4096 + k]; }
#pragma unroll
            for (int j = 0; j < 4; ++j) { red[(kq * 3 + 0) * 64 + c4 * 4 + j] = a0[j]; red[(kq * 3 + 1) * 64 + c4 * 4 + j] = a1[j]; red[(kq * 3 + 2) * 64 + c4 * 4 + j] = a2[j]; }
            __syncthreads();
            if (F.tid < 192) { const int v = F.tid >> 6, col = F.tid & 63; float s = 0.f;
#pragma unroll 8
                for (int q = 0; q < 32; ++q) s += red[(q * 3 + v) * 64 + col];
                MOD[((size_t)l * 3 + v) * 12288 + cg * 64 + col] = s + P.in[I_BMOD][(size_t)l * 12288 + cg * 64 + col]; }
            __syncthreads();
        }
    }
    {
        LAS float* scr = (LAS float*)(F.lds + F.wave * 16384);
        const int gw = F.bid * NWAVES + F.wave, NGW = F.G * NWAVES;
        constexpr int I_IN = 32 * 362, I_UQ = 8 * 48, I_UKV = 4 * 64, I_BR = 16 * 64, I_OUT = 32 * 64, I_UP = 32 * 256, I_DN = 128 * 64;
        constexpr int PER_L = I_IN + I_UQ + I_UKV + 3 * I_BR + I_OUT + I_UP + I_DN;
        for (int it = gw; it < 4 * PER_L; it += NGW) {
            const int l = it / PER_L; int r = it - l * PER_L;
            if (r < I_IN) { transpose_item(P.in[I_WIN] + (size_t)l * 2048 * 11584, 2048, 11584, (bf16_t*)(ws + WS_WIN + l * SZ_WIN), 5440, 192, scr, r, F.lane); continue; } r -= I_IN;
            if (r < I_UQ) { transpose_item(P.in[I_WUQ] + (size_t)l * 512 * 1536, 512, 1536, (bf16_t*)(ws + WS_WUQ + l * SZ_WUQ), 1 << 30, 0, scr, r, F.lane); continue; } r -= I_UQ;
            if (r < I_UKV) { transpose_item(P.in[I_WUKV] + (size_t)l * 256 * 2048, 256, 2048, (bf16_t*)(ws + WS_WUKV + l * SZ_WUKV), 1 << 30, 0, scr, r, F.lane); continue; } r -= I_UKV;
            if (r < 3 * I_BR) { const int z = r / I_BR; r -= z * I_BR; transpose_item(P.in[I_WBA + z] + (size_t)l * 1024 * 2048, 1024, 2048, (bf16_t*)(ws + WS_WBR + (l * 3 + z) * SZ_WBR1), 1 << 30, 0, scr, r, F.lane); continue; } r -= 3 * I_BR;
            if (r < I_OUT) { transpose_item(P.in[I_WOUT] + (size_t)l * 2048 * 2048, 2048, 2048, (bf16_t*)(ws + WS_WOUT + l * SZ_WOUT), 1 << 30, 0, scr, r, F.lane); continue; } r -= I_OUT;
            if (r < I_UP) { transpose_item(P.in[I_WUP] + (size_t)l * 2048 * 8192, 2048, 8192, (bf16_t*)(ws + WS_WUP + l * SZ_WUP), 1 << 30, 0, scr, r, F.lane); continue; } r -= I_UP;
            transpose_item(P.in[I_WDN] + (size_t)l * 8192 * 2048, 8192, 2048, (bf16_t*)(ws + WS_WDN + l * SZ_WUP), 1 << 30, 0, scr, r, F.lane);
        }
    }
}

__device__ __forceinline__ void norm_phase(const Ctx& F, const float* xin_ctx, const float* xin_lat, const bf16_t* o0, const bf16_t* o1, float* X, bf16_t* H,
                                           const float* modA, int gate_off, const float* gA, const float* modB, int scale_off, int shift_off, const float* gB) {
    const int gw = F.bid * NWAVES + F.wave, NGW = F.G * NWAVES;
    for (int r = gw; r < NTOK; r += NGW) {
        const int v = r < NCTX ? 0 : 1 + ((r - NCTX) >> 12);
        const float* xr = r < NCTX ? xin_ctx + (size_t)r * DM : xin_lat + (size_t)(r - NCTX) * DM;
        f32x4 x[8];
#pragma unroll
        for (int j = 0; j < 8; ++j) x[j] = *(const f32x4*)(xr + (F.lane + 64 * j) * 4);
        if (o0) {
            f32x4 o[8]; float ss = 0.f;
#pragma unroll
            for (int j = 0; j < 8; ++j) { const u32x2 pa = *(const u32x2*)(o0 + (size_t)r * DM + (F.lane + 64 * j) * 4), pb = *(const u32x2*)(o1 + (size_t)r * DM + (F.lane + 64 * j) * 4);
                o[j] = (f32x4){bf_lo(pa.x) + bf_lo(pb.x), bf_hi(pa.x) + bf_hi(pb.x), bf_lo(pa.y) + bf_lo(pb.y), bf_hi(pa.y) + bf_hi(pb.y)};
                ss += (o[j][0] * o[j][0] + o[j][1] * o[j][1]) + (o[j][2] * o[j][2] + o[j][3] * o[j][3]); }
            const float rs = 1.0f / sqrtf(wave_sum(ss) * (1.0f / DM) + EPS);
#pragma unroll
            for (int j = 0; j < 8; ++j) { const int c = (F.lane + 64 * j) * 4; const f32x4 ga = *(const f32x4*)(gA + c), gt = *(const f32x4*)(modA + (size_t)v * 12288 + gate_off + c);
                x[j] += gt * (o[j] * rs * ga); }
        }
#pragma unroll
        for (int j = 0; j < 8; ++j) *(f32x4*)(X + (size_t)r * DM + (F.lane + 64 * j) * 4) = x[j];
        if (gB) {
            float ss = 0.f;
#pragma unroll
            for (int j = 0; j < 8; ++j) ss += (x[j][0] * x[j][0] + x[j][1] * x[j][1]) + (x[j][2] * x[j][2] + x[j][3] * x[j][3]);
            const float rs = 1.0f / sqrtf(wave_sum(ss) * (1.0f / DM) + EPS);
#pragma unroll
            for (int j = 0; j < 8; ++j) { const int c = (F.lane + 64 * j) * 4; const f32x4 gb = *(const f32x4*)(gB + c);
                const f32x4 sc = *(const f32x4*)(modB + (size_t)v * 12288 + scale_off + c), sh = *(const f32x4*)(modB + (size_t)v * 12288 + shift_off + c);
                const f32x4 h = (x[j] * rs * gb) * (sc + 1.0f) + sh;
                u32x2 w; w.x = cvt_pk_bf16(h[0], h[1]); w.y = cvt_pk_bf16(h[2], h[3]);
                *(u32x2*)(H + (size_t)r * DM + c) = w; }
        }
    }
}

struct RopeCS { float c0, s0, c1, s1; };
__device__ __forceinline__ RopeCS rope_cs128(int lane, int prow, int pcol) {
    const int i0 = (2 * lane) & 31; const float pos = (float)((lane >> 5) ? pcol : prow);
    const float r0 = pos * __builtin_amdgcn_exp2f(-(float)i0 * (13.287712379549449f / 32.0f)) * 0.15915494309189535f;
    const float r1 = pos * __builtin_amdgcn_exp2f(-(float)(i0 + 1) * (13.287712379549449f / 32.0f)) * 0.15915494309189535f;
    RopeCS t; t.c0 = __builtin_amdgcn_cosf(r0); t.s0 = __builtin_amdgcn_sinf(r0); t.c1 = __builtin_amdgcn_cosf(r1); t.s1 = __builtin_amdgcn_sinf(r1);
    if ((lane & 16) == 0) { t.s0 = -t.s0; t.s1 = -t.s1; }
    return t;
}
__device__ __forceinline__ RopeCS rope_cs64(int g, int prow, int pcol) {
    const int i0 = (2 * g) & 15; const float pos = (float)((g >> 4) ? pcol : prow);
    const float r0 = pos * __builtin_amdgcn_exp2f(-(float)i0 * (13.287712379549449f / 16.0f)) * 0.15915494309189535f;
    const float r1 = pos * __builtin_amdgcn_exp2f(-(float)(i0 + 1) * (13.287712379549449f / 16.0f)) * 0.15915494309189535f;
    RopeCS t; t.c0 = __builtin_amdgcn_cosf(r0); t.s0 = __builtin_amdgcn_sinf(r0); t.c1 = __builtin_amdgcn_cosf(r1); t.s1 = __builtin_amdgcn_sinf(r1);
    if ((g & 8) == 0) { t.s0 = -t.s0; t.s1 = -t.s1; }
    return t;
}
__device__ __forceinline__ void rope128(float& y0, float& y1, const RopeCS& t) { const float p0 = swz_xor<16>(y0), p1 = swz_xor<16>(y1); y0 = y0 * t.c0 + p0 * t.s0; y1 = y1 * t.c1 + p1 * t.s1; }
__device__ __forceinline__ void rope64(float& y0, float& y1, const RopeCS& t) { const float p0 = swz_xor<8>(y0), p1 = swz_xor<8>(y1); y0 = y0 * t.c0 + p0 * t.s0; y1 = y1 * t.c1 + p1 * t.s1; }
struct PPRow { unsigned uq[10], uv[2], ub[8], ukr; u32x4 ucq; u32x2 ukv; };
__device__ __forceinline__ void pp_load(PPRow& R, const unsigned* P32, int lane) {
#pragma unroll
    for (int hd = 0; hd < 10; ++hd) R.uq[hd] = P32[hd * 64 + lane];
#pragma unroll
    for (int j = 0; j < 2; ++j) R.uv[j] = P32[C_AV / 2 + j * 64 + lane];
#pragma unroll
    for (int hd = 0; hd < 8; ++hd) R.ub[hd] = P32[C_BQ / 2 + hd * 64 + lane];
    R.ucq = *(const u32x4*)(P32 + C_CQL / 2 + 4 * lane); R.ukv = *(const u32x2*)(P32 + C_CKV / 2 + 2 * lane); R.ukr = P32[C_CKR / 2 + (lane & 31)];
}
template <bool DRY>
__device__ __forceinline__ void phase_postproj(const Ctx& F, int l) {
    CParams& P = *F.p; unsigned char* ws = P.ws;
    bf16_t* PROJ = (bf16_t*)(ws + WS_PROJ); bf16_t* KA = (bf16_t*)(ws + WS_KA); bf16_t* VA = (bf16_t*)(ws + WS_VA); bf16_t* CKV = (bf16_t*)(ws + WS_CKV); bf16_t* KR = (bf16_t*)(ws + WS_KROPE);
    const int gw = F.bid * NWAVES + F.wave, NGW = F.G * NWAVES, lane = F.lane;
    const f32x2 qn = *(const f32x2*)(P.in[I_AQN] + l * 128 + 2 * lane), kn = *(const f32x2*)(P.in[I_AKN] + l * 128 + 2 * lane);
    const f32x4 mq0 = *(const f32x4*)(P.in[I_MQN] + l * 512 + 8 * lane), mq1 = *(const f32x4*)(P.in[I_MQN] + l * 512 + 8 * lane + 4), mkv = *(const f32x4*)(P.in[I_MKVN] + l * 256 + 4 * lane);
    PPRow cur, nxt;
    if (gw < NTOK) pp_load(cur, (const unsigned*)(PROJ + (size_t)gw * NPROJ), lane);
    for (int r = gw; r < NTOK; r += NGW) {
        if (r + NGW < NTOK) pp_load(nxt, (const unsigned*)(PROJ + (size_t)(r + NGW) * NPROJ), lane);
        const bool lat = r >= NCTX; const int lr = r - NCTX, b = lr >> 12, n = lr & 4095, prow = n >> 6, pcol = n & 63;
        const int arow = lat ? NCTX + b * KVL + n : r;
        const int cb = r >> 8, cs = r & 255;
        unsigned* P32 = DRY ? (unsigned*)((bf16_t*)(ws + WS_PART) + (size_t)r * 5632) : (unsigned*)(PROJ + (size_t)r * NPROJ);
        RopeCS t128, t64;
        if (lat) { t128 = rope_cs128(lane, prow, pcol); t64 = rope_cs64(lane & 31, prow, pcol); }
        float y0[10], y1[10], ss[10];
#pragma unroll
        for (int hd = 0; hd < 10; ++hd) { y0[hd] = bf_lo(cur.uq[hd]); y1[hd] = bf_hi(cur.uq[hd]); ss[hd] = y0[hd] * y0[hd] + y1[hd] * y1[hd]; }
#pragma unroll
        for (int hd = 0; hd < 10; ++hd) ss[hd] = wave_sum(ss[hd]);
#pragma unroll
        for (int hd = 0; hd < 10; ++hd) {
            const float rs = 1.0f / sqrtf(ss[hd] * (1.0f / 128.0f) + EPS); const f32x2 gn = hd < 8 ? qn : kn;
            float a0 = y0[hd] * rs * gn[0], a1 = y1[hd] * rs * gn[1];
            if (lat) rope128(a0, a1, t128);
            if (hd < 8) P32[hd * 64 + lane] = cvt_pk_bf16(a0, a1);
            else { const int kvh = hd - 8; ((unsigned*)(KA + (size_t)arow * 256))[kvh * 64 + lane] = cvt_pk_bf16(a0, a1);
                if (!lat) *(f32x2*)(P.out + O_NAK + (((size_t)cb * 4 + l) * 256 + cs) * 256 + kvh * 128 + 2 * lane) = (f32x2){a0, a1}; }
        }
#pragma unroll
        for (int j = 0; j < 2; ++j) { const unsigned u = cur.uv[j]; ((unsigned*)(VA + (size_t)arow * 256))[j * 64 + lane] = u;
            if (!lat) *(f32x2*)(P.out + O_NAV + (((size_t)cb * 4 + l) * 256 + cs) * 256 + j * 128 + 2 * lane) = (f32x2){bf_lo(u), bf_hi(u)}; }
#pragma unroll
        for (int hd = 0; hd < 8; ++hd) {
            if (!lat && hd < 4) continue;
            float a0 = bf_lo(cur.ub[hd]), a1 = bf_hi(cur.ub[hd]);
            if (lat) rope128(a0, a1, t128);
            if (hd >= 4) { a0 *= 0.08838834764831845f; a1 *= 0.08838834764831845f; }
            P32[C_BQ / 2 + hd * 64 + lane] = cvt_pk_bf16(a0, a1);
        }
        { u32x4 u = cur.ucq;
          float y[8] = {bf_lo(u.x), bf_hi(u.x), bf_lo(u.y), bf_hi(u.y), bf_lo(u.z), bf_hi(u.z), bf_lo(u.w), bf_hi(u.w)}; float s2 = 0.f;
#pragma unroll
          for (int i = 0; i < 8; ++i) s2 += y[i] * y[i];
          const float rs = 1.0f / sqrtf(wave_sum(s2) * (1.0f / 512.0f) + EPS);
          u.x = cvt_pk_bf16(y[0] * rs * mq0[0], y[1] * rs * mq0[1]); u.y = cvt_pk_bf16(y[2] * rs * mq0[2], y[3] * rs * mq0[3]);
          u.z = cvt_pk_bf16(y[4] * rs * mq1[0], y[5] * rs * mq1[1]); u.w = cvt_pk_bf16(y[6] * rs * mq1[2], y[7] * rs * mq1[3]);
          *(u32x4*)(P32 + C_CQL / 2 + 4 * lane) = u; }
        { const u32x2 u = cur.ukv;
          float y[4] = {bf_lo(u.x), bf_hi(u.x), bf_lo(u.y), bf_hi(u.y)};
          const float rs = 1.0f / sqrtf(wave_sum((y[0] * y[0] + y[1] * y[1]) + (y[2] * y[2] + y[3] * y[3])) * (1.0f / 256.0f) + EPS);
#pragma unroll
          for (int i = 0; i < 4; ++i) y[i] *= rs * mkv[i];
          u32x2 w; w.x = cvt_pk_bf16(y[0], y[1]); w.y = cvt_pk_bf16(y[2], y[3]);
          *(u32x2*)(CKV + (size_t)arow * 256 + 4 * lane) = w;
          if (!lat) *(f32x4*)(P.out + O_NCKV + (((size_t)cb * 4 + l) * 256 + cs) * 256 + 4 * lane) = (f32x4){y[0], y[1], y[2], y[3]}; }
        { float a0 = bf_lo(cur.ukr), a1 = bf_hi(cur.ukr);
          if (lat) rope64(a0, a1, t64);
          if (lane < 32) { ((unsigned*)(KR + (size_t)arow * 64))[lane] = cvt_pk_bf16(a0, a1);
              if (!lat) *(f32x2*)(P.out + O_NKR + (((size_t)cb * 4 + l) * 256 + cs) * 64 + 2 * lane) = (f32x2){a0, a1}; } }
        cur = nxt;
    }
    for (int r = gw; r < 1024; r += NGW) {
        const int b = r >> 9, j = r & 511; const size_t arow = NCTX + (size_t)b * KVL + 4096 + j; const size_t src = ((size_t)b * 4 + l) * 512 + j;
        { const f32x4 k = *(const f32x4*)(P.in[I_CAK] + src * 256 + 4 * lane), v = *(const f32x4*)(P.in[I_CAV] + src * 256 + 4 * lane), c = *(const f32x4*)(P.in[I_CCKV] + src * 256 + 4 * lane);
          u32x2 w; w.x = cvt_pk_bf16(k[0], k[1]); w.y = cvt_pk_bf16(k[2], k[3]); *(u32x2*)(KA + arow * 256 + 4 * lane) = w;
          w.x = cvt_pk_bf16(v[0], v[1]); w.y = cvt_pk_bf16(v[2], v[3]); *(u32x2*)(VA + arow * 256 + 4 * lane) = w;
          w.x = cvt_pk_bf16(c[0], c[1]); w.y = cvt_pk_bf16(c[2], c[3]); *(u32x2*)(CKV + arow * 256 + 4 * lane) = w; }
        if (lane < 16) { const f32x4 k = *(const f32x4*)(P.in[I_CKR] + src * 64 + 4 * lane); u32x2 w; w.x = cvt_pk_bf16(k[0], k[1]); w.y = cvt_pk_bf16(k[2], k[3]); *(u32x2*)(KR + arow * 64 + 4 * lane) = w; }
    }
}

__device__ __forceinline__ float log_sigmoid_(float x) { return -__logf(1.0f + __expf(-x)); }
template <int SCALE_MODE>
__device__ __forceinline__ void stage_vtile(LAS char* dst, const bf16_t* src, int ld, int tid, float lg2, int jbase) {
#pragma unroll
    for (int i = 0; i < 2; ++i) { const int p = tid + 512 * i, k = p >> 4, c8 = (p & 15) * 8;
        u32x4 u = *(const u32x4*)(src + (size_t)k * ld + c8);
        if (SCALE_MODE != 0) { const float jj = (float)(jbase + k); const float f = __builtin_amdgcn_exp2f(lg2 * (SCALE_MODE == 1 ? (127.0f - jj) : jj));
            u.x = cvt_pk_bf16(bf_lo(u.x) * f, bf_hi(u.x) * f); u.y = cvt_pk_bf16(bf_lo(u.y) * f, bf_hi(u.y) * f); u.z = cvt_pk_bf16(bf_lo(u.z) * f, bf_hi(u.z) * f); u.w = cvt_pk_bf16(bf_lo(u.w) * f, bf_hi(u.w) * f); }
        *(LAS u32x4*)(dst + att::v_st(k, c8)) = u; }
}
__device__ __forceinline__ void ret_kv_unit(const Ctx& F, int l, int u) {
    CParams& P = *F.p; unsigned char* ws = P.ws;
    const int c = u >> 2, h = u & 3, row0 = c * 128, tid = F.tid, lane = F.lane, w = F.wave;
    const bf16_t* PROJ = (const bf16_t*)(ws + WS_PROJ);
    const float lgf2 = log_sigmoid_(P.in[I_RDF][l * 4 + h]) * 1.4426950408889634f, lgb2 = log_sigmoid_(P.in[I_RDB][l * 4 + h]) * 1.4426950408889634f;
    LAS char* lds = (LAS char*)F.lds;
#pragma nounroll
    for (int jt = 0; jt < 2; ++jt) {
        const bf16_t* ksrc = PROJ + (size_t)(row0 + jt * 64) * NPROJ + C_BK + h * 128;
        stage_vtile<1>(lds + jt * 16384, ksrc, NPROJ, tid, lgf2, jt * 64);
        stage_vtile<2>(lds + 32768 + jt * 16384, ksrc, NPROJ, tid, lgb2, jt * 64);
#pragma nounroll
        for (int eh = 0; eh < 2; ++eh) stage_vtile<0>(lds + 65536 + (jt * 2 + eh) * 16384, PROJ + (size_t)(row0 + jt * 64) * NPROJ + C_BV + h * 256 + eh * 128, NPROJ, tid, 0.f, 0);
    }
    __syncthreads();
    const int dblk = w & 3, eh = w >> 2;
    f32x16 accF[4] = {}, accB[4] = {};
#pragma nounroll
    for (int jt = 0; jt < 2; ++jt) {
        const int vbF = (int)(uintptr_t)lds + jt * 16384 + att::v_rd_base(lane) + dblk * 512, vbB = 32768 + vbF, vbV = 65536 + (jt * 2 + eh) * 16384 + att::v_rd_base(lane);
#define KVSTEP(KS) do { \
        const s16x4 fl = att::tr_read<att::v_rd_off(0, KS, 0)>(vbF), fh = att::tr_read<att::v_rd_off(0, KS, 1)>(vbF), bl = att::tr_read<att::v_rd_off(0, KS, 0)>(vbB), bh = att::tr_read<att::v_rd_off(0, KS, 1)>(vbB); \
        const s16x4 v0l = att::tr_read<att::v_rd_off(0, KS, 0)>(vbV), v0h = att::tr_read<att::v_rd_off(0, KS, 1)>(vbV), v1l = att::tr_read<att::v_rd_off(1, KS, 0)>(vbV), v1h = att::tr_read<att::v_rd_off(1, KS, 1)>(vbV); \
        const s16x4 v2l = att::tr_read<att::v_rd_off(2, KS, 0)>(vbV), v2h = att::tr_read<att::v_rd_off(2, KS, 1)>(vbV), v3l = att::tr_read<att::v_rd_off(3, KS, 0)>(vbV), v3h = att::tr_read<att::v_rd_off(3, KS, 1)>(vbV); \
        asm volatile("s_waitcnt lgkmcnt(0)" ::: "memory"); SBAR(); \
        const bf16x8 af = PKLH(fl, fh), ab = PKLH(bl, bh), b0 = PKLH(v0l, v0h), b1 = PKLH(v1l, v1h), b2 = PKLH(v2l, v2h), b3 = PKLH(v3l, v3h); \
        accF[0] = __builtin_amdgcn_mfma_f32_32x32x16_bf16(af, b0, accF[0], 0, 0, 0); accB[0] = __builtin_amdgcn_mfma_f32_32x32x16_bf16(ab, b0, accB[0], 0, 0, 0); \
        accF[1] = __builtin_amdgcn_mfma_f32_32x32x16_bf16(af, b1, accF[1], 0, 0, 0); accB[1] = __builtin_amdgcn_mfma_f32_32x32x16_bf16(ab, b1, accB[1], 0, 0, 0); \
        accF[2] = __builtin_amdgcn_mfma_f32_32x32x16_bf16(af, b2, accF[2], 0, 0, 0); accB[2] = __builtin_amdgcn_mfma_f32_32x32x16_bf16(ab, b2, accB[2], 0, 0, 0); \
        accF[3] = __builtin_amdgcn_mfma_f32_32x32x16_bf16(af, b3, accF[3], 0, 0, 0); accB[3] = __builtin_amdgcn_mfma_f32_32x32x16_bf16(ab, b3, accB[3], 0, 0, 0); } while (0)
        KVSTEP(0); KVSTEP(1); KVSTEP(2); KVSTEP(3);
#undef KVSTEP
    }
    float* RKV = (float*)(ws + WS_RKV) + ((size_t)(c * 4 + h) * 2) * RET_ST;
    const int r32 = lane & 31, hi = lane >> 5;
#pragma unroll
    for (int r = 0; r < 16; ++r) { const int d = dblk * 32 + att::crow(r, hi);
#pragma unroll
        for (int eb = 0; eb < 4; ++eb) { const int e = eh * 128 + eb * 32 + r32; RKV[(size_t)d * 256 + e] = accF[eb][r]; RKV[RET_ST + (size_t)d * 256 + e] = accB[eb][r]; } }
    __syncthreads();
}
__device__ __forceinline__ void phase_scan(const Ctx& F, int l, bool do_rope) {
    CParams& P = *F.p; unsigned char* ws = P.ws;
    float* RKV = (float*)(ws + WS_RKV); bf16_t* RS = (bf16_t*)(ws + WS_RS);
    for (int it = F.bid; it < 2304; it += F.G) {
        const bool lat = it < 256; const int q = lat ? it : it - 256; const int combo = q >> 4, slab = q & 15;
        const int dir = combo & 1, h = (combo >> 1) & 3, sb = combo >> 3; const size_t e0 = (size_t)slab * 2048 + F.tid * 4;
        const float cd = __expf(128.0f * log_sigmoid_(P.in[dir ? I_RDB : I_RDF][l * 4 + h]));
        if (lat) {
            f32x4 s = *(const f32x4*)(P.in[dir ? I_SRB : I_SRF] + (((size_t)sb * 4 + l) * 4 + h) * RET_ST + e0);
            for (int t = 0; t < 32; ++t) { const int n = dir ? 31 - t : t; const size_t base = ((size_t)((32 + sb * 32 + n) * 4 + h) * 2 + dir) * RET_ST + e0;
                u32x2 w; w.x = cvt_pk_bf16(s[0], s[1]); w.y = cvt_pk_bf16(s[2], s[3]); *(u32x2*)(RS + base) = w;
                s = s * cd + *(const f32x4*)(RKV + base); }
        } else {
            f32x4 s = {0.f, 0.f, 0.f, 0.f};
#pragma unroll
            for (int t = 0; t < 2; ++t) { const int n = dir ? 1 - t : t; const size_t base = ((size_t)((sb * 2 + n) * 4 + h) * 2 + dir) * RET_ST + e0;
                u32x2 w; w.x = cvt_pk_bf16(s[0], s[1]); w.y = cvt_pk_bf16(s[2], s[3]); *(u32x2*)(RS + base) = w;
                s = s * cd + *(const f32x4*)(RKV + base); }
            *(f32x4*)(P.out + (dir ? O_NRB : O_NRF) + (((size_t)sb * 4 + l) * 4 + h) * RET_ST + e0) = s;
        }
    }
    bf16_t* CQ = (bf16_t*)(ws + WS_CQ);
    const int gw = F.bid * NWAVES + F.wave, NGW = F.G * NWAVES, lane = F.lane;
    if (do_rope) for (int r = NCTX + gw; r < NTOK; r += NGW) {
        const int n = (r - NCTX) & 4095, prow = n >> 6, pcol = n & 63; const RopeCS t64 = rope_cs64(lane & 31, prow, pcol);
        unsigned uu[4];
#pragma unroll
        for (int j = 0; j < 4; ++j) uu[j] = *((const unsigned*)(CQ + (size_t)r * 1536 + ((lane >> 5) + 2 * j) * 192 + 128) + (lane & 31));
#pragma unroll
        for (int j = 0; j < 4; ++j) { float y0 = bf_lo(uu[j]), y1 = bf_hi(uu[j]); rope64(y0, y1, t64); *((unsigned*)(CQ + (size_t)r * 1536 + ((lane >> 5) + 2 * j) * 192 + 128) + (lane & 31)) = cvt_pk_bf16(y0, y1); }
    }
}
__device__ __forceinline__ void ret_out_unit(const Ctx& F, int l, int u) {
    CParams& P = *F.p; unsigned char* ws = P.ws;
    const int c = u >> 2, h = u & 3, row0 = c * 128, tid = F.tid, lane = F.lane, w = F.wave, r32 = lane & 31, hi = lane >> 5;
    const bf16_t* PROJ = (const bf16_t*)(ws + WS_PROJ); const bf16_t* RS = (const bf16_t*)(ws + WS_RS) + ((size_t)(c * 4 + h) * 2) * RET_ST;
    const float lgf2 = log_sigmoid_(P.in[I_RDF][l * 4 + h]) * 1.4426950408889634f, lgb2 = log_sigmoid_(P.in[I_RDB][l * 4 + h]) * 1.4426950408889634f;
    LAS char* lds = (LAS char*)F.lds;
    const int qblk = w & 3, eh = w >> 2, qi = qblk * 32 + r32;
    const int ldsb = (int)(uintptr_t)lds;
    const bf16_t* Qw = PROJ + (size_t)(row0 + qi) * NPROJ + C_BQ + h * 128 + hi * 8;
#pragma nounroll
    for (int jt = 0; jt < 2; ++jt) {
        const int sr = tid >> 4, sc = (tid & 15) * 8;
        const bf16_t* ksrc = PROJ + (size_t)(row0 + jt * 64) * NPROJ + C_BK + h * 128;
        *(LAS bf16x8*)(lds + jt * 16384 + KSWZ(sr, sc * 2)) = *reinterpret_cast<const bf16x8*>(ksrc + (size_t)sr * NPROJ + sc);
        *(LAS bf16x8*)(lds + jt * 16384 + KSWZ(32 + sr, sc * 2)) = *reinterpret_cast<const bf16x8*>(ksrc + (size_t)(32 + sr) * NPROJ + sc);
#pragma nounroll
        for (int e2 = 0; e2 < 2; ++e2) stage_vtile<0>(lds + 32768 + (jt * 2 + e2) * 16384, PROJ + (size_t)(row0 + jt * 64) * NPROJ + C_BV + h * 256 + e2 * 128, NPROJ, tid, 0.f, 0);
    }
    __syncthreads();
    f32x16 o[4] = {};
    {
        bf16x8 qr[8];
#pragma unroll
        for (int d0 = 0; d0 < 8; ++d0) qr[d0] = *reinterpret_cast<const bf16x8*>(Qw + d0 * 16);
#pragma nounroll
        for (int jt = 0; jt < 2; ++jt) {
            f32x16 p0, p1; att::qkt<128>(p0, p1, lds + jt * 16384, lds, qr, r32, hi);
#pragma unroll
            for (int r = 0; r < 16; ++r) {
                const int j0 = jt * 64 + att::crow(r, hi), j1 = j0 + 32; const int d0 = qi - j0, d1 = qi - j1;
                const float w0 = d0 > 0 ? __builtin_amdgcn_exp2f(lgf2 * (float)d0) : (d0 < 0 ? __builtin_amdgcn_exp2f(lgb2 * (float)(-d0)) : 2.0f);
                const float w1 = d1 > 0 ? __builtin_amdgcn_exp2f(lgf2 * (float)d1) : (d1 < 0 ? __builtin_amdgcn_exp2f(lgb2 * (float)(-d1)) : 2.0f);
                p0[r] *= w0; p1[r] *= w1; }
            bf16x8 pa0, pa1, pa2, pa3; att::p_to_frags(p0, p1, pa0, pa1, pa2, pa3);
            att::pv_d0(o, ldsb + 32768 + (jt * 2 + eh) * 16384 + att::v_rd_base(lane), pa0, pa1, pa2, pa3);
        }
    }
    __syncthreads();
#pragma nounroll
    for (int t = 0; t < 8; ++t) stage_vtile<0>(lds + t * 16384, RS + (size_t)(t >> 2) * RET_ST + (size_t)(((t >> 1) & 1) * 64) * 256 + (t & 1) * 128, 256, tid, 0.f, 0);
    __syncthreads();
    {
        const float ff = __builtin_amdgcn_exp2f(lgf2 * (float)(qi + 1)), fb = __builtin_amdgcn_exp2f(lgb2 * (float)(128 - qi));
#pragma nounroll
        for (int sd = 0; sd < 4; ++sd) { const float f = (sd >> 1) ? fb : ff; const int dt = sd & 1; bf16x8 pa[4];
#pragma unroll
            for (int k = 0; k < 4; ++k) { const u32x4 q4 = *reinterpret_cast<const u32x4*>(Qw + (dt * 4 + k) * 16); u32x4 s4;
                s4.x = cvt_pk_bf16(bf_lo(q4.x) * f, bf_hi(q4.x) * f); s4.y = cvt_pk_bf16(bf_lo(q4.y) * f, bf_hi(q4.y) * f); s4.z = cvt_pk_bf16(bf_lo(q4.z) * f, bf_hi(q4.z) * f); s4.w = cvt_pk_bf16(bf_lo(q4.w) * f, bf_hi(q4.w) * f);
                pa[k] = *reinterpret_cast<const bf16x8*>(&s4); }
            att::pv_d0(o, ldsb + (sd * 2 + eh) * 16384 + att::v_rd_base(lane), pa[0], pa[1], pa[2], pa[3]); }
    }
    LAS float* rsum = (LAS float*)(F.lds + LDS_RS_OFF);
    float ss[16];
#pragma unroll
    for (int r = 0; r < 16; ++r) { float s = 0.f;
#pragma unroll
        for (int d0 = 0; d0 < 4; ++d0) s += o[d0][r] * o[d0][r];
        s += swz_xor<1>(s); s += swz_xor<2>(s); s += swz_xor<4>(s); s += swz_xor<8>(s); s += swz_xor<16>(s); ss[r] = s; }
    if (r32 == 0) {
#pragma unroll
        for (int r = 0; r < 16; ++r) rsum[eh * 128 + qblk * 32 + att::crow(r, hi)] = ss[r]; }
    __syncthreads();
    const float* gn = P.in[I_RGN] + l * 1024 + h * 256; bf16_t* OB = (bf16_t*)(ws + WS_OABC + SZ_O1);
#pragma unroll
    for (int r = 0; r < 16; ++r) { const int i = qblk * 32 + att::crow(r, hi);
        const float rs = 1.0f / sqrtf((rsum[i] + rsum[128 + i]) * (1.0f / 256.0f) + EPS);
#pragma unroll
        for (int d0 = 0; d0 < 4; ++d0) { const int e = eh * 128 + d0 * 32 + r32;
            const float g = __uint_as_float((unsigned)PROJ[(size_t)(row0 + i) * NPROJ + C_BG + h * 256 + e] << 16);
            OB[(size_t)(row0 + i) * 1024 + h * 256 + e] = (bf16_t)(cvt_pk_bf16(o[d0][r] * rs * gn[e] * siluf_(g), 0.f) & 0xffffu); } }
    __syncthreads();
}

constexpr int NPH_L = 11, NPH = 2 + DEPTH * NPH_L;
__global__ void __launch_bounds__(NTHR, 2) mega(Params prm) {
    extern __shared__ __attribute__((aligned(16))) unsigned char lds_raw[];
    Ctx F; F.lds = (LAS unsigned char*)lds_raw; F.tid = threadIdx.x; F.lane = F.tid & 63; F.wave = __builtin_amdgcn_readfirstlane(F.tid >> 6); F.bid = blockIdx.x; F.G = gridDim.x; F.p = (CParams*)__builtin_amdgcn_kernarg_segment_ptr();
    unsigned char* ws = F.p->ws;
    for (int u = F.tid; u < 128; u += NTHR) ((LAS unsigned*)(F.lds + LDSCTL_OFF))[u] = 0u;
    __syncthreads();
    const int lo = F.p->ph_lo, hi = F.p->ph_hi; const bool multi = (hi - lo) > 1;
    XcdBarrier bar; bar.bar = (unsigned*)(ws + WS_CTL); bar.x = 0; bar.st = nullptr;
    if (multi) bar = xcd_barrier_post((unsigned*)(ws + WS_CTL), (volatile LAS unsigned*)(F.lds + LDSCTL_OFF + 32));
#ifndef SUB_MASK
#define SUB_MASK 15
#endif
#ifndef PH_MASK
#define PH_MASK 0xFFFF
#endif
#ifndef DUP_MASK
#define DUP_MASK 0
#endif
#define REPS(bit) ((DUP_MASK & (bit)) ? 2 : 1)
#define IN(k) (lo <= (k) && (k) < hi)
#define RELANE() do { int l_; asm volatile("v_mbcnt_lo_u32_b32 %0, -1, 0\n\tv_mbcnt_hi_u32_b32 %0, -1, %0" : "=v"(l_)); F.lane = l_; F.tid = F.wave * 64 + l_; } while (0)
#define FRESH() do { int l_; asm volatile("v_mbcnt_lo_u32_b32 %0, -1, 0\n\tv_mbcnt_hi_u32_b32 %0, -1, %0" : "=v"(l_)); F.lane = l_; F.tid = F.wave * 64 + l_; CParams* kp_ = (CParams*)__builtin_amdgcn_kernarg_segment_ptr(); asm volatile("" : "+s"(kp_)); F.p = kp_; } while (0)
#define SEAM(k) do { if (IN(k) && IN((k) + 1)) xcd_barrier(bar, F.tid == 0); } while (0)
    float* X = F.p->out;
    const float* MOD = (const float*)(ws + WS_MOD);
    bf16_t* H = (bf16_t*)(ws + WS_H); bf16_t* PROJ = (bf16_t*)(ws + WS_PROJ);
    float* PART = (float*)(ws + WS_PART);

    if ((PH_MASK & 1) && IN(0)) _Pragma("nounroll") for (int rp = 0; rp < REPS(1); ++rp) { FRESH(); phase_prologue(F); SEAM(0); }
    if ((PH_MASK & 2) && IN(1)) { FRESH(); norm_phase(F, F.p->in[I_XP], F.p->in[I_XS], nullptr, nullptr, X, H, nullptr, 0, nullptr, MOD, 2048, 0, F.p->in[I_GPMIX]); SEAM(1); }

    for (int l = 0; l < DEPTH; ++l) {
        const int pb = 2 + l * NPH_L; const float* MODL = MOD + (size_t)l * 3 * 12288;
        if ((PH_MASK & 4) && IN(pb + 0)) _Pragma("nounroll") for (int rp = 0; rp < REPS(4); ++rp) { FRESH();
            pg8::EpiBf16<0> E{PROJ, NPROJ, 0};
            pg8::gemm_phase<pg8::EpiBf16<0>, NTOK, NPROJ, DM, DM, DM, 1, false, 0, 0>(F.lds, F.tid, H, ws + WS_WIN + l * SZ_WIN, F.G, F.bid, E);
            SEAM(pb + 0);
        }
        if ((PH_MASK & 8) && IN(pb + 1)) _Pragma("nounroll") for (int rp = 0; rp < REPS(8); ++rp) { FRESH(); if (REPS(8) == 2 && rp == 0) phase_postproj<true>(F, l); else phase_postproj<false>(F, l); SEAM(pb + 1); }
        if ((PH_MASK & 16) && IN(pb + 2)) _Pragma("nounroll") for (int rp = 0; rp < REPS(16); ++rp) { FRESH();
            if (SUB_MASK & 1) { pg8::EpiBf16<0> E{(bf16_t*)(ws + WS_CQ), 1536, 0};
              pg8::gemm_phase<pg8::EpiBf16<0>, NTOK, 1536, NPROJ, 512, 512, 1, false, 0, 0>(F.lds, F.tid, PROJ + C_CQL, ws + WS_WUQ + l * SZ_WUQ, F.G, F.bid, E); }
            if (SUB_MASK & 2) { FRESH(); pg8::EpiBf16<0> E{(bf16_t*)(ws + WS_KVUP), 2048, 0};
              pg8::gemm_phase<pg8::EpiBf16<0>, NALL, 2048, 256, 256, 256, 1, false, 0, 0>(F.lds, F.tid, ws + WS_CKV, ws + WS_WUKV + l * SZ_WUKV, F.G, F.G - 1 - F.bid, E); }
            if (SUB_MASK & 4) { FRESH(); for (int u = F.bid; u < 384; u += F.G) { RELANE(); ret_kv_unit(F, l, u); } }
            FRESH();
            if (SUB_MASK & 8) for (int u = F.bid; u < 384; u += F.G) {
                RELANE(); int row0, kv0, seq, h;
                if (u < 256) { const int b = u >> 7; h = (u >> 4) & 7; row0 = NCTX + b * 4096 + (u & 15) * 256; kv0 = NCTX + b * KVL; seq = KVL; }
                else { const int s = (u - 256) >> 3; h = (u - 256) & 7; row0 = s * 256; kv0 = s * 256; seq = 256; }
                att::attn_body<128, NPROJ, 256, 256, 1024>(PROJ + (size_t)row0 * NPROJ + C_AQ + h * 128, (const bf16_t*)(ws + WS_KA) + (size_t)kv0 * 256 + (h >> 2) * 128, nullptr,
                    (const bf16_t*)(ws + WS_VA) + (size_t)kv0 * 256 + (h >> 2) * 128, (bf16_t*)(ws + WS_OABC) + (size_t)row0 * 1024 + h * 128, seq, (LAS char*)F.lds, F.tid);
            }
            SEAM(pb + 2);
        }
        if ((PH_MASK & 32) && IN(pb + 3)) _Pragma("nounroll") for (int rp = 0; rp < REPS(32); ++rp) { FRESH(); phase_scan(F, l, rp == 0); SEAM(pb + 3); }
        if ((PH_MASK & 64) && IN(pb + 4)) _Pragma("nounroll") for (int rp = 0; rp < REPS(64); ++rp) { FRESH();
            FRESH();
            if (SUB_MASK & 2) for (int u = (F.bid + F.G / 2) % F.G; u < 384; u += F.G) {
                RELANE(); int row0, kv0, seq, h;
                if (u < 256) { const int b = u >> 7; h = (u >> 4) & 7; row0 = NCTX + b * 4096 + (u & 15) * 256; kv0 = NCTX + b * KVL; seq = KVL; }
                else { const int s = (u - 256) >> 3; h = (u - 256) & 7; row0 = s * 256; kv0 = s * 256; seq = 256; }
                att::attn_simple<192, 1536, 2048, 2048, 1024>((const bf16_t*)(ws + WS_CQ) + (size_t)row0 * 1536 + h * 192, (const bf16_t*)(ws + WS_KVUP) + (size_t)kv0 * 2048 + h * 256,
                    (const bf16_t*)(ws + WS_KROPE) + (size_t)kv0 * 64, (const bf16_t*)(ws + WS_KVUP) + (size_t)kv0 * 2048 + h * 256 + 128,
                    (bf16_t*)(ws + WS_OABC + 2 * SZ_O1) + (size_t)row0 * 1024 + h * 128, seq, (LAS char*)F.lds, F.tid);
            }
            FRESH();
            if (SUB_MASK & 4) for (int u = (F.bid + F.G / 2) % F.G; u < 384; u += F.G) { RELANE(); ret_out_unit(F, l, u); }
            SEAM(pb + 4);
        }
        if ((PH_MASK & 128) && IN(pb + 5)) _Pragma("nounroll") for (int rp = 0; rp < REPS(128); ++rp) { FRESH();
            pg8::EpiBranch E{PROJ + C_GATE, NPROJ, PART, (bf16_t*)(ws + WS_MERGED)};
            pg8::gemm_phase<pg8::EpiBranch, NTOK, DM, 1024, 1024, 1024, 3, true, SZ_O1, SZ_WBR1>(F.lds, F.tid, ws + WS_OABC, ws + WS_WBR + (size_t)l * 3 * SZ_WBR1, F.G, F.bid, E);
            SEAM(pb + 5);
        }
        if ((PH_MASK & 256) && IN(pb + 6)) _Pragma("nounroll") for (int rp = 0; rp < REPS(256); ++rp) { FRESH();
            pg8::EpiBf16<0> E{(bf16_t*)PART, DM, (size_t)NTOK * DM};
            pg8::gemm_phase<pg8::EpiBf16<0>, NTOK, DM, DM, DM, 1024, 2, false, 2048, 2048>(F.lds, F.tid, ws + WS_MERGED, ws + WS_WOUT + l * SZ_WOUT, F.G, F.bid, E);
            SEAM(pb + 6);
        }
        if ((PH_MASK & 512) && IN(pb + 7)) _Pragma("nounroll") for (int rp = 0; rp < REPS(512); ++rp) { FRESH();
            norm_phase(F, X, X + (size_t)NCTX * DM, (const bf16_t*)PART, (const bf16_t*)PART + (size_t)NTOK * DM, (REPS(512) == 2 && rp == 0) ? (float*)PROJ : X, (REPS(512) == 2 && rp == 0) ? (bf16_t*)(ws + WS_PROJ + SZ_PART1) : H, MODL, 4096, F.p->in[I_GPOMIX] + l * DM, MODL, 8192, 6144, F.p->in[I_GPMLP] + l * DM);
            SEAM(pb + 7);
        }
        if ((PH_MASK & 1024) && IN(pb + 8)) _Pragma("nounroll") for (int rp = 0; rp < REPS(1024); ++rp) { FRESH();
            pg8::EpiBf16<1> E{PROJ, DFF, 0};
            pg8::gemm_phase<pg8::EpiBf16<1>, NTOK, DFF, DM, DM, DM, 1, false, 0, 0>(F.lds, F.tid, H, ws + WS_WUP + l * SZ_WUP, F.G, F.bid, E);
            SEAM(pb + 8);
        }
        if ((PH_MASK & 2048) && IN(pb + 9)) _Pragma("nounroll") for (int rp = 0; rp < REPS(2048); ++rp) { FRESH();
            pg8::EpiBf16<0> E{(bf16_t*)PART, DM, (size_t)NTOK * DM};
            pg8::gemm_phase<pg8::EpiBf16<0>, NTOK, DM, DFF, DFF, 4096, 2, false, 8192, 8192>(F.lds, F.tid, PROJ, ws + WS_WDN + l * SZ_WUP, F.G, F.bid, E);
            SEAM(pb + 9);
        }
        if ((PH_MASK & 4096) && IN(pb + 10)) _Pragma("nounroll") for (int rp = 0; rp < REPS(4096); ++rp) { FRESH();
            const bool more = (l + 1 < DEPTH);
            norm_phase(F, X, X + (size_t)NCTX * DM, (const bf16_t*)PART, (const bf16_t*)PART + (size_t)NTOK * DM, (REPS(4096) == 2 && rp == 0) ? (float*)PROJ : X, (REPS(4096) == 2 && rp == 0) ? (bf16_t*)(ws + WS_PROJ + SZ_PART1) : H, MODL, 10240, F.p->in[I_GPOMLP] + l * DM,
                       MODL + 3 * 12288, 2048, 0, more ? F.p->in[I_GPMIX] + (l + 1) * DM : nullptr);
            SEAM(pb + 10);
        }
    }
#undef IN
#undef SEAM
}

#ifndef MK_MULTI
#define MK_MULTI 0
#endif
extern "C" void kernel_launch(void* const* d_in, const int* in_sizes, int n_in, void* d_out, int out_size, void* d_ws, size_t ws_size, hipStream_t stream) {
    static int grid = 0;
    if (grid == 0) {
        if (n_in != 32 || out_size != (int)O_END || ws_size < WS_END) { fprintf(stderr, "kernel_launch: unexpected shapes: n_in %d out %d ws %zu (need %zu)\n", n_in, out_size, ws_size, (size_t)WS_END); grid = -1; return; }
        int dev = 0, cus = 0, per_cu = 0;
        if (hipGetDevice(&dev) != hipSuccess || hipDeviceGetAttribute(&cus, hipDeviceAttributeMultiprocessorCount, dev) != hipSuccess) { grid = -1; return; }
        if (hipFuncSetAttribute((const void*)mega, hipFuncAttributeMaxDynamicSharedMemorySize, LDS_BYTES) != hipSuccess) { fprintf(stderr, "kernel_launch: hipFuncSetAttribute failed\n"); grid = -1; return; }
        if (hipOccupancyMaxActiveBlocksPerMultiprocessor(&per_cu, (const void*)mega, NTHR, LDS_BYTES) != hipSuccess || per_cu < 1) fprintf(stderr, "kernel_launch: occupancy query says %d\n", per_cu);
        (void)hipGetLastError();
        grid = cus;
    }
    if (grid < 0) return;
    (void)hipMemsetAsync((char*)d_ws + WS_CTL, 0, CTL_BYTES, stream);
    Params p{};
    for (int i = 0; i < 32; ++i) p.in[i] = (const float*)d_in[i];
    p.out = (float*)d_out; p.ws = (unsigned char*)d_ws;
#if MK_MULTI
    for (int k = 0; k < NPH; ++k) { p.ph_lo = k; p.ph_hi = k + 1; hipLaunchKernelGGL(mega, dim3(grid), dim3(NTHR), LDS_BYTES, stream, p); }
#else
    p.ph_lo = 0; p.ph_hi = NPH;
    hipLaunchKernelGGL(mega, dim3(grid), dim3(NTHR), LDS_BYTES, stream, p);
#endif
    const hipError_t le = hipPeekAtLastError();
    if (le != hipSuccess) fprintf(stderr, "kernel_launch: launch failed: %s\n", hipGetErrorName(le));
}
```

```cpp
#include <hip/hip_runtime.h>
#include <cstdio>
#include <cstdint>

#define LAS __attribute__((address_space(3)))
#define GAS __attribute__((address_space(1)))
typedef unsigned short bf16_t;
typedef short bf16x8 __attribute__((ext_vector_type(8)));
typedef short s16x4 __attribute__((ext_vector_type(4)));
typedef float f32x4 __attribute__((ext_vector_type(4)));
typedef float f32x2 __attribute__((ext_vector_type(2)));
typedef float f32x16 __attribute__((ext_vector_type(16)));
typedef unsigned u32x4 __attribute__((ext_vector_type(4)));
typedef unsigned u32x2 __attribute__((ext_vector_type(2)));

constexpr int DM = 2048, NCTX = 4096, NLAT = 8192, NTOK = 12288, DEPTH = 4, DFF = 8192;
constexpr int NPROJ = 11776;
constexpr int PADE = 64;
constexpr int LDP = NPROJ + PADE, LDH = DM + PADE, LDU = DFF + PADE, LDO = 1024 + PADE, LDCQ = 1536 + PADE, LDKV = 2048 + PADE;
constexpr int C_AQ = 0, C_AK = 1024, C_AV = 1280, C_BQ = 1536, C_BK = 2048, C_BV = 2560, C_BG = 3584, C_CQL = 4608, C_CKV = 5120, C_CKR = 5376, C_GATE = 5632;
constexpr int NALL = 13312;
constexpr int KVL = 4608;
constexpr float EPS = 1e-6f;
constexpr int NWAVES = 8, NTHR = 512;

constexpr size_t WS_CTL = 0, CTL_BYTES = 1u << 20;
constexpr size_t WS_MOD = CTL_BYTES;
constexpr size_t WS_WIN = 2u << 20;
constexpr size_t SZ_WIN = (size_t)NPROJ * LDH * 2;
constexpr size_t WS_WUQ = WS_WIN + 4 * SZ_WIN;
constexpr size_t SZ_WUQ = (size_t)1536 * 512 * 2;
constexpr size_t WS_WUKV = WS_WUQ + 4 * SZ_WUQ;
constexpr size_t SZ_WUKV = (size_t)2048 * 256 * 2;
constexpr size_t WS_WBR = WS_WUKV + 4 * SZ_WUKV;
constexpr size_t SZ_WBR1 = (size_t)2048 * LDO * 2;
constexpr size_t WS_WOUT = WS_WBR + 12 * SZ_WBR1;
constexpr size_t SZ_WOUT = (size_t)2048 * LDH * 2;
constexpr size_t WS_WUP = WS_WOUT + 4 * SZ_WOUT;
constexpr size_t SZ_WUP = (size_t)8192 * LDH * 2, SZ_WDN = (size_t)2048 * LDU * 2;
constexpr size_t WS_WDN = WS_WUP + 4 * SZ_WUP;
constexpr size_t WS_H = WS_WDN + 4 * SZ_WDN;
constexpr size_t WS_PROJ = WS_H + (size_t)NTOK * LDH * 2;
constexpr size_t WS_KA = WS_PROJ + (size_t)NTOK * LDP * 2;
constexpr size_t WS_VA = WS_KA + (size_t)NALL * 256 * 2;
constexpr size_t WS_CKV = WS_VA + (size_t)NALL * 256 * 2;
constexpr size_t WS_KROPE = WS_CKV + (size_t)NALL * 256 * 2;
constexpr size_t WS_CQ = WS_KROPE + (size_t)NALL * 64 * 2;
constexpr size_t WS_KVUP = WS_CQ + (size_t)NTOK * LDCQ * 2;
constexpr size_t WS_OABC = WS_KVUP + (size_t)NALL * LDKV * 2;
constexpr size_t SZ_O1 = (size_t)NTOK * LDO * 2;
constexpr size_t WS_MERGED = WS_OABC + 3 * SZ_O1;
constexpr size_t WS_PART = WS_MERGED + (size_t)NTOK * LDH * 2;
constexpr size_t SZ_PART1 = (size_t)NTOK * DM * 4;
constexpr size_t WS_END = WS_PART + 2 * SZ_PART1;
constexpr size_t RET_ST = 32768;
constexpr size_t WS_RKV = WS_PART;
constexpr size_t WS_RS = WS_PART + (size_t)96 * 4 * 2 * RET_ST * 4;
static_assert(WS_RS + (size_t)96 * 4 * 2 * RET_ST * 2 <= WS_END, "ws map");

constexpr int LDS_BYTES = 147456;
constexpr int LDSCTL_OFF = 131072;
constexpr int LDS_RS_OFF = 131072 + 1024;
constexpr int LDS_WSCR_OFF = 131072 + 2048;

__device__ __forceinline__ unsigned cvt_pk_bf16(float lo, float hi) { unsigned r; asm volatile("v_cvt_pk_bf16_f32 %0, %1, %2" : "=v"(r) : "v"(lo), "v"(hi)); return r; }
__device__ __forceinline__ float bf_lo(unsigned u) { return __uint_as_float(u << 16); }
__device__ __forceinline__ float bf_hi(unsigned u) { return __uint_as_float(u & 0xffff0000u); }
template <int X> __device__ __forceinline__ float swz_xor(float v) { return __int_as_float(__builtin_amdgcn_ds_swizzle(__float_as_int(v), 0x1f | (X << 10))); }
__device__ __forceinline__ float wave_sum(float v) {
    v += swz_xor<1>(v); v += swz_xor<2>(v); v += swz_xor<4>(v); v += swz_xor<8>(v); v += swz_xor<16>(v);
    auto rr = __builtin_amdgcn_permlane32_swap(__float_as_uint(v), __float_as_uint(v), false, false);
    return __uint_as_float(rr[0]) + __uint_as_float(rr[1]);
}
__device__ __forceinline__ float fast_exp(float x) { return __builtin_amdgcn_exp2f(x * 1.4426950408889634f); }
__device__ __forceinline__ float sigmoidf_(float x) { return __builtin_amdgcn_rcpf(1.0f + fast_exp(-x)); }
__device__ __forceinline__ float siluf_(float x) { return x * sigmoidf_(x); }
#define LDS_WAIT() asm volatile("s_waitcnt lgkmcnt(0)" ::: "memory")
#define VM_WAIT() asm volatile("s_waitcnt vmcnt(0)" ::: "memory")

#define XB_TMO      128
#define XB_XCNT(j)  (256  + 64 * (j))
#define XB_XSUB(j)  (1280 + 64 * (j))
#define XB_XGEN(j)  (2304 + 64 * (j))
#define XB_TOP      3328
#define XB_TOPGEN   3392
#define XCD_BAR_WORDS 3456
#define XB_SPIN_CAP (1u << 22)
__device__ __forceinline__ unsigned xb_ld(unsigned* p)              { return __hip_atomic_load(p, __ATOMIC_RELAXED, __HIP_MEMORY_SCOPE_AGENT); }
__device__ __forceinline__ unsigned xb_add(unsigned* p, unsigned v) { return __hip_atomic_fetch_add(p, v, __ATOMIC_RELAXED, __HIP_MEMORY_SCOPE_AGENT); }
__device__ __forceinline__ unsigned xb_xcc_id() { return (unsigned)__builtin_amdgcn_s_getreg((3 << 11) | 20) & 0xFu; }
#define XB_SPIN(cond, bar) do { unsigned _sp = 0; while (cond) { __builtin_amdgcn_s_sleep(1); \
    if ((++_sp & 255u) == 0u) { if (xb_ld(&(bar)[XB_TMO])) break; if (_sp > XB_SPIN_CAP) { atomicAdd(&(bar)[XB_TMO], 1u); break; } } } } while (0)
struct XcdBarrier { unsigned* bar; unsigned x; volatile LAS unsigned* st; };
__device__ __forceinline__ XcdBarrier xcd_barrier_post(unsigned* bar, volatile LAS unsigned* st) {
    XcdBarrier b; b.bar = bar; b.x = xb_xcc_id(); b.st = st;
    if (threadIdx.x == 0) (void)xb_add(&bar[XB_XCNT(b.x)], 1u);
    return b;
}
__device__ __forceinline__ void xcd_barrier_complete(unsigned* bar, unsigned x, unsigned& nloc, unsigned& nx) {
    const unsigned G = gridDim.x * gridDim.y * gridDim.z;
    unsigned sum, cnt, mine, sp = 0u;
    for (;;) {
        sum = 0u; cnt = 0u; mine = 0u;
#pragma unroll
        for (unsigned j = 0; j < 16; ++j) { const unsigned c = xb_ld(&bar[XB_XCNT(j)]); sum += c; cnt += (c > 0u) ? 1u : 0u; mine = (j == x) ? c : mine; }
        if (sum == G) break;
        __builtin_amdgcn_s_sleep(1);
        if ((++sp & 255u) == 0u) { if (xb_ld(&bar[XB_TMO])) break; if (sp > XB_SPIN_CAP) { atomicAdd(&bar[XB_TMO], 1u); break; } }
    }
    nloc = mine > 0u ? mine : 1u; nx = cnt > 0u ? cnt : 1u;
}
__device__ __forceinline__ void xcd_barrier(const XcdBarrier& b, const bool leader) {
    asm volatile("s_waitcnt vmcnt(0)" ::: "memory");
    __syncthreads();
    if (leader) {
        unsigned* bar = b.bar;
        __builtin_amdgcn_s_waitcnt(0);
        unsigned nloc = b.st[0], nx = b.st[1];
        if (nloc == 0u) { xcd_barrier_complete(bar, b.x, nloc, nx); b.st[0] = nloc; b.st[1] = nx; }
        const unsigned old = xb_add(&bar[XB_XSUB(b.x)], 1u);
        const unsigned gen = old / nloc;
        if (old + 1u == (gen + 1u) * nloc) {
            __builtin_amdgcn_fence(__ATOMIC_RELEASE, "agent");
            asm volatile("s_waitcnt vmcnt(0)" ::: "memory");
            const unsigned og = xb_add(&bar[XB_TOP], 1u);
            const unsigned tg = og / nx;
            if (og + 1u == (tg + 1u) * nx) xb_add(&bar[XB_TOPGEN], 1u);
            else XB_SPIN(xb_ld(&bar[XB_TOPGEN]) == tg, bar);
            __builtin_amdgcn_fence(__ATOMIC_ACQUIRE, "agent");
            xb_add(&bar[XB_XGEN(b.x)], 1u);
            asm volatile("s_waitcnt vmcnt(0)" ::: "memory");
        } else {
            XB_SPIN(xb_ld(&bar[XB_XGEN(b.x)]) == gen, bar);
            __builtin_amdgcn_fence(__ATOMIC_ACQUIRE, "agent");
            asm volatile("s_waitcnt vmcnt(0)" ::: "memory");
        }
    }
    __syncthreads();
}

namespace pg8 {
constexpr int BM = 256, BK = 64, HALF = 128, HTB = HALF * BK * 2, STAGE_BYTES = 8 * HTB, NXCD = 8, WGM = 8;
__host__ __device__ __forceinline__ int lds_byte(int r, int c) { const int st = (r >> 4) * 2 + (c >> 5), rr = r & 15, cc = c & 31, ob = rr * 64 + cc * 2; return st * 1024 + (ob ^ (((ob >> 9) & 1) << 5)); }
__host__ __device__ __forceinline__ void stage_rc(int b, int& R, int& C) { const int st = b / 1024, sb = b % 1024, swz = sb ^ (((sb >> 9) & 1) << 5); R = (st >> 1) * 16 + swz / 64; C = (st & 1) * 32 + (swz % 64) / 2; }
__host__ __device__ __forceinline__ int perm32(int rho) { const int n = rho >> 4, i = rho & 15; return 8 * (i >> 2) + 4 * n + (i & 3); }

struct Unit { int pm, pn, z; };
template <int M, int N, int NZ, bool ZINNER>
__device__ __forceinline__ bool next_unit(int k, int G, int c, Unit& u) {
    constexpr int nM = M / BM, nN = N / BM, nNx = ZINNER ? nN : nN * NZ, nwg = nM * nNx;
    int i, z;
    if (ZINNER) { i = k / NZ; z = k - i * NZ; } else { i = k; z = 0; }
    const int L = i * G + c; if (L >= nwg) return false;
    int wgid = L; { constexpr int q = nwg / NXCD, r = nwg % NXCD; const int xcd = wgid % NXCD, off = wgid / NXCD; wgid = (xcd < r ? xcd * (q + 1) : r * (q + 1) + (xcd - r) * q) + off; }
    constexpr int nig = WGM * nNx; const int gid = wgid / nig, fm = gid * WGM, gsz = (nM - fm) < WGM ? (nM - fm) : WGM;
    u.pm = fm + ((wgid % nig) % gsz); const int pnx = (wgid % nig) / gsz;
    if (ZINNER) { u.pn = pnx; u.z = z; } else { u.z = pnx / nN; u.pn = pnx - u.z * nN; }
    return true;
}

template <int ACT  > struct EpiBf16 {
    static constexpr bool PERM = true;
    bf16_t* O; int ldc; size_t zstride;
    __device__ __forceinline__ void operator()(const f32x4 (&acc)[2][2][4][2], const Unit& u, int wr, int wc, int fr, int fq) const {
        const int row0 = u.pm * BM + wr * 64 + fr; const int col0 = u.pn * BM + wc * 32 + 8 * fq; bf16_t* Oz = O + (size_t)u.z * zstride;
#pragma unroll
        for (int ai = 0; ai < 2; ++ai)
#pragma unroll
            for (int m = 0; m < 4; ++m) { bf16_t* rowp = Oz + (size_t)(row0 + ai * HALF + m * 16) * ldc + col0;
#pragma unroll
                for (int bj = 0; bj < 2; ++bj) { f32x4 v0 = acc[ai][bj][m][0], v1 = acc[ai][bj][m][1];
                    if (ACT == 1) {
#pragma unroll
                        for (int j = 0; j < 4; ++j) { const float a = fmaxf(v0[j], 0.f), b = fmaxf(v1[j], 0.f); v0[j] = a * a; v1[j] = b * b; } }
                    u32x4 w; w.x = cvt_pk_bf16(v0[0], v0[1]); w.y = cvt_pk_bf16(v0[2], v0[3]); w.z = cvt_pk_bf16(v1[0], v1[1]); w.w = cvt_pk_bf16(v1[2], v1[3]);
                    *(u32x4*)(rowp + bj * HALF) = w; } }
    }
};
struct EpiF32Z {
    static constexpr bool PERM = false;
    float* C; int ldc; size_t zstride;
    __device__ __forceinline__ void operator()(const f32x4 (&acc)[2][2][4][2], const Unit& u, int wr, int wc, int fr, int fq) const {
        const int row0 = u.pm * BM + wr * 64 + fr, col0 = u.pn * BM + wc * 32 + 4 * fq; float* Cz = C + (size_t)u.z * zstride;
#pragma unroll
        for (int ai = 0; ai < 2; ++ai)
#pragma unroll
            for (int m = 0; m < 4; ++m) { float* rowp = Cz + (size_t)(row0 + ai * HALF + m * 16) * ldc + col0;
#pragma unroll
                for (int bj = 0; bj < 2; ++bj)
#pragma unroll
                    for (int n = 0; n < 2; ++n) *(f32x4*)(rowp + bj * HALF + n * 16) = acc[ai][bj][m][n]; }
    }
};
struct EpiBranch {
    static constexpr bool PERM = true;
    const bf16_t* gates; int ldg;
    bf16_t* scr; bf16_t* O;
    __device__ __forceinline__ void operator()(const f32x4 (&acc)[2][2][4][2], const Unit& u, int wr, int wc, int fr, int fq) const {
        const int row0 = u.pm * BM + wr * 64 + fr; const int col0 = u.pn * BM + wc * 32 + 8 * fq;
#pragma unroll
        for (int ai = 0; ai < 2; ++ai)
#pragma unroll
            for (int mp = 0; mp < 2; ++mp) {
                u32x4 g[2][2], s[2][2];
#pragma unroll
                for (int mm = 0; mm < 2; ++mm)
#pragma unroll
                    for (int bj = 0; bj < 2; ++bj) { const size_t row = (size_t)(row0 + ai * HALF + (mp * 2 + mm) * 16); const int col = col0 + bj * HALF;
                        g[mm][bj] = *(const u32x4*)(gates + row * ldg + (size_t)u.z * 2048 + col);
                        if (u.z != 0) s[mm][bj] = *(const u32x4*)(scr + row * 2048 + col); }
#pragma unroll
                for (int mm = 0; mm < 2; ++mm)
#pragma unroll
                    for (int bj = 0; bj < 2; ++bj) { const int m = mp * 2 + mm; const size_t row = (size_t)(row0 + ai * HALF + m * 16); const int col = col0 + bj * HALF;
                        const u32x4 gg = g[mm][bj]; f32x4 v0 = acc[ai][bj][m][0], v1 = acc[ai][bj][m][1];
                        v0[0] *= sigmoidf_(bf_lo(gg.x)); v0[1] *= sigmoidf_(bf_hi(gg.x)); v0[2] *= sigmoidf_(bf_lo(gg.y)); v0[3] *= sigmoidf_(bf_hi(gg.y));
                        v1[0] *= sigmoidf_(bf_lo(gg.z)); v1[1] *= sigmoidf_(bf_hi(gg.z)); v1[2] *= sigmoidf_(bf_lo(gg.w)); v1[3] *= sigmoidf_(bf_hi(gg.w));
                        if (u.z != 0) { const u32x4 ss = s[mm][bj]; v0[0] += bf_lo(ss.x); v0[1] += bf_hi(ss.x); v0[2] += bf_lo(ss.y); v0[3] += bf_hi(ss.y);
                            v1[0] += bf_lo(ss.z); v1[1] += bf_hi(ss.z); v1[2] += bf_lo(ss.w); v1[3] += bf_hi(ss.w); }
                        u32x4 w; w.x = cvt_pk_bf16(v0[0], v0[1]); w.y = cvt_pk_bf16(v0[2], v0[3]); w.z = cvt_pk_bf16(v1[0], v1[1]); w.w = cvt_pk_bf16(v1[2], v1[3]);
                        if (u.z != 2) *(u32x4*)(scr + row * 2048 + col) = w; else *(u32x4*)(O + row * LDH + col) = w; }
            }
    }
};

template <class Epi, int M, int N, int LDA, int LDB, int KU, int NZ, bool ZINNER, size_t AZS, size_t BZS, bool ALIGN_EPI = true>
__device__ __forceinline__ void gemm_phase(LAS unsigned char* lds, const int tid, const void* Aptr, const void* Bptr, int G, int c, const Epi& E) {
    const char* const Abase = (const char*)Aptr; const char* const Bbase = (const char*)Bptr;
    const int wid = __builtin_amdgcn_readfirstlane(tid >> 6), lane = tid & 63, wr = wid >> 2, wc = wid & 3, fr = lane & 15, fq = lane >> 4;
    constexpr int nt = KU / BK;
    unsigned voffA[2], voffB[2];
#pragma unroll
    for (int i = 0; i < 2; ++i) { int R, C; stage_rc(tid * 16 + i * 8192, R, C); const int Rb = Epi::PERM ? ((R & ~31) + perm32(R & 31)) : R;
        voffA[i] = (unsigned)(R * LDA + C) * 2u; voffB[i] = (unsigned)(Rb * LDB + C) * 2u; }
    constexpr size_t kstep = (size_t)(BK * 2);
    constexpr size_t hstepA = (size_t)HALF * LDA * 2, hstepB = (size_t)HALF * LDB * 2;
    constexpr size_t tstepA = 2 * hstepA, tstepB = 2 * hstepB;
    const unsigned ldsw = (unsigned)wid * 1024u;
    const int aoff = lds_byte(wr * 64 + fr, fq * 8), boff = lds_byte(wc * 32 + fr, fq * 8);
#define PG8_SA(b, h) (((b) * 2 + (h)) * HTB)
#define PG8_SB(b, h) ((4 + (b) * 2 + (h)) * HTB)
#define PG8_STAGE(bufoff, gbase, voff) do { _Pragma("unroll") for (int _i = 0; _i < 2; ++_i) \
        __builtin_amdgcn_global_load_lds((const unsigned*)((const char*)(gbase) + (voff)[_i]), (LAS unsigned*)(lds + (bufoff) + ldsw + _i * 8192), 16, 0, 0); } while (0)
#define PG8_LDA(dst, b, h) do { _Pragma("unroll") for (int m = 0; m < 4; ++m) _Pragma("unroll") for (int k = 0; k < 2; ++k) dst[m][k] = *(const LAS bf16x8*)(lds + PG8_SA(b, h) + aoff + m * 2048 + k * 1024); } while (0)
#define PG8_LDB(dst, b, h) do { _Pragma("unroll") for (int n = 0; n < 2; ++n) _Pragma("unroll") for (int k = 0; k < 2; ++k) dst[n][k] = *(const LAS bf16x8*)(lds + PG8_SB(b, h) + boff + n * 2048 + k * 1024); } while (0)
#define PG8_MMA(ai, bj, At, Bt) do { __builtin_amdgcn_s_setprio(1); _Pragma("unroll") for (int m = 0; m < 4; ++m) _Pragma("unroll") for (int n = 0; n < 2; ++n) _Pragma("unroll") for (int k = 0; k < 2; ++k) \
        acc[ai][bj][m][n] = __builtin_amdgcn_mfma_f32_16x16x32_bf16(Bt[n][k], At[m][k], acc[ai][bj][m][n], 0, 0, 0); __builtin_amdgcn_s_setprio(0); } while (0)
#define PG8_WAIT_V(n) asm volatile("s_waitcnt vmcnt(" #n ")" ::: "memory")
#define PG8_WAIT_L(n) asm volatile("s_waitcnt lgkmcnt(" #n ")" ::: "memory")
#define PG8_BAR __builtin_amdgcn_s_barrier()
#define PG8_SCHED __builtin_amdgcn_sched_barrier(0)
    Unit cur, nxt; int ui = 0;
    if (!next_unit<M, N, NZ, ZINNER>(0, G, c, cur)) return;
    f32x4 acc[2][2][4][2];
#pragma unroll
    for (int a = 0; a < 2; ++a)
#pragma unroll
        for (int b = 0; b < 2; ++b)
#pragma unroll
            for (int m = 0; m < 4; ++m)
#pragma unroll
                for (int n = 0; n < 2; ++n) acc[a][b][m][n] = (f32x4){0.f, 0.f, 0.f, 0.f};
    bf16x8 At[4][2], B0[2][2], B1[2][2];
    const char* cA = Abase + (size_t)cur.z * AZS + (size_t)cur.pm * tstepA; const char* cB = Bbase + (size_t)cur.z * BZS + (size_t)cur.pn * tstepB;
    PG8_STAGE(PG8_SB(0, 0), cB, voffB); PG8_STAGE(PG8_SB(0, 1), cB + hstepB, voffB); PG8_STAGE(PG8_SA(0, 0), cA, voffA); PG8_STAGE(PG8_SA(0, 1), cA + hstepA, voffA);
    if (wr == 1) PG8_BAR;
    PG8_WAIT_V(2); PG8_BAR;
    PG8_STAGE(PG8_SB(1, 0), cB + kstep, voffB); PG8_STAGE(PG8_SA(1, 0), cA + kstep, voffA); PG8_STAGE(PG8_SB(1, 1), cB + hstepB + kstep, voffB);
    PG8_WAIT_V(6); PG8_BAR;
    for (;;) {
        const bool has_next = next_unit<M, N, NZ, ZINNER>(ui + 1, G, c, nxt);
        const char* nA = has_next ? Abase + (size_t)nxt.z * AZS + (size_t)nxt.pm * tstepA : cA; const char* nB = has_next ? Bbase + (size_t)nxt.z * BZS + (size_t)nxt.pn * tstepB : cB;
#pragma nounroll
        for (int t = 0; t < nt; t += 2) {
            const bool last = (t == nt - 2);
            const char* a1 = cA + (size_t)(t + 1) * kstep;
            const char* a2 = last ? nA : cA + (size_t)(t + 2) * kstep; const char* b2 = last ? nB : cB + (size_t)(t + 2) * kstep;
            const char* a3 = a2 + kstep; const char* b3 = b2 + kstep;
            PG8_LDB(B0, 0, 0); PG8_LDB(B1, 0, 1); PG8_SCHED; PG8_LDA(At, 0, 0); PG8_STAGE(PG8_SA(1, 1), a1 + hstepA, voffA);
            PG8_WAIT_V(8); PG8_WAIT_L(0); PG8_BAR; PG8_MMA(0, 0, At, B0); PG8_MMA(0, 1, At, B1); PG8_BAR; PG8_SCHED;
            PG8_LDA(At, 0, 1); PG8_STAGE(PG8_SB(0, 0), b2, voffB); PG8_STAGE(PG8_SB(0, 1), b2 + hstepB, voffB); PG8_STAGE(PG8_SA(0, 0), a2, voffA);
            PG8_WAIT_V(8); PG8_WAIT_L(0); PG8_BAR; PG8_MMA(1, 0, At, B0); PG8_MMA(1, 1, At, B1); PG8_BAR; PG8_SCHED;
            PG8_LDB(B0, 1, 0); PG8_LDB(B1, 1, 1); PG8_SCHED; PG8_LDA(At, 1, 0); PG8_STAGE(PG8_SA(0, 1), a2 + hstepA, voffA);
            PG8_WAIT_V(8); PG8_WAIT_L(0); PG8_BAR; PG8_MMA(0, 0, At, B0); PG8_MMA(0, 1, At, B1); PG8_BAR; PG8_SCHED;
            PG8_LDA(At, 1, 1); PG8_STAGE(PG8_SB(1, 0), b3, voffB); PG8_STAGE(PG8_SB(1, 1), b3 + hstepB, voffB); PG8_STAGE(PG8_SA(1, 0), a3, voffA);
            PG8_WAIT_V(8); PG8_WAIT_L(0); PG8_BAR; PG8_MMA(1, 0, At, B0); PG8_MMA(1, 1, At, B1); PG8_BAR; PG8_SCHED;
        }
        if constexpr (ALIGN_EPI) { if (wr == 0) PG8_BAR; }
        E(acc, cur, wr, wc, fr, fq);
        if (!has_next) break;
#pragma unroll
        for (int a = 0; a < 2; ++a)
#pragma unroll
            for (int b = 0; b < 2; ++b)
#pragma unroll
                for (int m = 0; m < 4; ++m)
#pragma unroll
                    for (int n = 0; n < 2; ++n) acc[a][b][m][n] = (f32x4){0.f, 0.f, 0.f, 0.f};
        cur = nxt; cA = nA; cB = nB; ++ui;
        if constexpr (ALIGN_EPI) { if (wr == 1) PG8_BAR; }
    }
    PG8_WAIT_V(0);
    if constexpr (!ALIGN_EPI) { if (wr == 0) PG8_BAR; }
    PG8_BAR;
#undef PG8_SA
#undef PG8_SB
#undef PG8_STAGE
#undef PG8_LDA
#undef PG8_LDB
#undef PG8_MMA
#undef PG8_WAIT_V
#undef PG8_WAIT_L
#undef PG8_BAR
#undef PG8_SCHED
}
}

namespace att {
constexpr int NW = 8, QBLK = 32, KVBLK = 64;
constexpr int SHM_T = KVBLK * 128 * 2;
#define KSWZ(row, colB) ((row) * 256 + ((colB) ^ (((row) & 7) << 4)))
#define SBAR() __builtin_amdgcn_sched_barrier(0)
__device__ __forceinline__ int crow(int r, int hi) { return (r & 3) + 8 * (r >> 2) + 4 * hi; }
__device__ __forceinline__ int v_st(int k, int c) { const int kk = (k & ~0xC) | ((k & 4) << 1) | ((k & 8) >> 1); return ((kk >> 3) * 4 + (c >> 5)) * 512 + ((kk & 7) * 32 + (c & 31)) * 2; }
__device__ __forceinline__ int v_rd_base(int lane) { return ((lane & 3) << 3) | (((lane >> 2) & 3) << 6) | (((lane >> 4) & 1) << 5) | (((lane >> 5) & 1) << 8); }
constexpr int v_rd_off(int d0, int ks, int half) { return d0 * 512 + ks * 4096 + half * 2048; }
template <int OFF> __device__ __forceinline__ s16x4 tr_read(int vb) {
    s16x4 r; asm volatile("ds_read_b64_tr_b16 %0, %1 offset:%2" : "=&v"(r) : "v"(vb), "i"(OFF) : "memory"); return r;
}
#define PKLH(L, H) (bf16x8){L[0], L[1], L[2], L[3], H[0], H[1], H[2], H[3]}
template <int D0> __device__ __forceinline__ void pv_one(f32x16& od, int vb, bf16x8 pa0, bf16x8 pa1, bf16x8 pa2, bf16x8 pa3) {
    const s16x4 l0 = tr_read<v_rd_off(D0, 0, 0)>(vb), h0 = tr_read<v_rd_off(D0, 0, 1)>(vb), l1 = tr_read<v_rd_off(D0, 1, 0)>(vb), h1 = tr_read<v_rd_off(D0, 1, 1)>(vb);
    const s16x4 l2 = tr_read<v_rd_off(D0, 2, 0)>(vb), h2 = tr_read<v_rd_off(D0, 2, 1)>(vb), l3 = tr_read<v_rd_off(D0, 3, 0)>(vb), h3 = tr_read<v_rd_off(D0, 3, 1)>(vb);
    asm volatile("s_waitcnt lgkmcnt(0)" ::: "memory"); SBAR();
    od = __builtin_amdgcn_mfma_f32_32x32x16_bf16(pa0, PKLH(l0, h0), od, 0, 0, 0);
    od = __builtin_amdgcn_mfma_f32_32x32x16_bf16(pa1, PKLH(l1, h1), od, 0, 0, 0);
    od = __builtin_amdgcn_mfma_f32_32x32x16_bf16(pa2, PKLH(l2, h2), od, 0, 0, 0);
    od = __builtin_amdgcn_mfma_f32_32x32x16_bf16(pa3, PKLH(l3, h3), od, 0, 0, 0);
}
__device__ __forceinline__ void pv_d0(f32x16* o, int vb, bf16x8 pa0, bf16x8 pa1, bf16x8 pa2, bf16x8 pa3) {
    pv_one<0>(o[0], vb, pa0, pa1, pa2, pa3); pv_one<1>(o[1], vb, pa0, pa1, pa2, pa3); pv_one<2>(o[2], vb, pa0, pa1, pa2, pa3); pv_one<3>(o[3], vb, pa0, pa1, pa2, pa3);
}
__device__ __forceinline__ void p_to_frags(const f32x16& p0, const f32x16& p1, bf16x8& pa0, bf16x8& pa1, bf16x8& pa2, bf16x8& pa3) {
#define PK4(P, BASE, OUT) do { unsigned a0 = cvt_pk_bf16(P[BASE + 0], P[BASE + 1]), a1 = cvt_pk_bf16(P[BASE + 2], P[BASE + 3]);   \
    unsigned b0 = cvt_pk_bf16(P[BASE + 4], P[BASE + 5]), b1 = cvt_pk_bf16(P[BASE + 6], P[BASE + 7]);                              \
    auto r0 = __builtin_amdgcn_permlane32_swap(a0, b0, false, false); auto r1 = __builtin_amdgcn_permlane32_swap(a1, b1, false, false); \
    u32x4 w = {r0[0], r1[0], r0[1], r1[1]}; OUT = *reinterpret_cast<bf16x8*>(&w); } while (0)
    PK4(p0, 0, pa0); PK4(p0, 8, pa1); PK4(p1, 0, pa2); PK4(p1, 8, pa3);
#undef PK4
}
template <int DQK> struct Cfg { static constexpr float SCALE = DQK == 128 ? 0.088388347648318440f : 0.072168783648703220f; static constexpr float THR = 8.f; };
template <int DQK>
__device__ __forceinline__ void partialSM(f32x16& p0, f32x16& p1, float& m_reg, float& mn, float& alpha) {
    constexpr float SCALE = Cfg<DQK>::SCALE, THR = Cfg<DQK>::THR;
    constexpr float C = SCALE * 1.4426950408889634f;
    float pmax = p0[0];
#pragma unroll
    for (int r = 1; r < 16; ++r) pmax = fmaxf(pmax, p0[r]);
#pragma unroll
    for (int r = 0; r < 16; ++r) pmax = fmaxf(pmax, p1[r]);
    { auto rr = __builtin_amdgcn_permlane32_swap(__float_as_uint(pmax), __float_as_uint(pmax), false, false);
      pmax = fmaxf(__uint_as_float(rr[0]), __uint_as_float(rr[1])); }
    if (__builtin_expect(__all(pmax - m_reg <= THR / SCALE), 1)) { mn = m_reg; alpha = 1.f; }
    else { mn = fmaxf(m_reg, pmax); alpha = __builtin_amdgcn_exp2f((m_reg - mn) * C); m_reg = mn; }
    float mnC = -mn * C;
#pragma unroll
    for (int r = 0; r < 16; ++r) p0[r] = fmaf(p0[r], C, mnC);
#pragma unroll
    for (int r = 0; r < 16; ++r) p1[r] = fmaf(p1[r], C, mnC);
#pragma unroll
    for (int r = 0; r < 16; ++r) p0[r] = __builtin_amdgcn_exp2f(p0[r]);
}
__device__ __forceinline__ void finishSM(f32x16& p0, f32x16& p1, float alpha, float& l_reg, bf16x8& pa0, bf16x8& pa1, bf16x8& pa2, bf16x8& pa3) {
#pragma unroll
    for (int r = 0; r < 16; ++r) p1[r] = __builtin_amdgcn_exp2f(p1[r]);
    float ps = 0;
#pragma unroll
    for (int r = 0; r < 16; ++r) ps += p0[r];
#pragma unroll
    for (int r = 0; r < 16; ++r) ps += p1[r];
    { auto rr = __builtin_amdgcn_permlane32_swap(__float_as_uint(ps), __float_as_uint(ps), false, false);
      ps = __uint_as_float(rr[0]) + __uint_as_float(rr[1]); }
    l_reg = l_reg * alpha + ps;
    p_to_frags(p0, p1, pa0, pa1, pa2, pa3);
}
template <int DQK>
__device__ __forceinline__ void qkt(f32x16& p0, f32x16& p1, const LAS char* Ks, const LAS char* Rs, const bf16x8* qr, int r32, int hi) {
    p0 = f32x16{}; p1 = f32x16{};
#pragma unroll
    for (int d0 = 0; d0 < 8; ++d0) { const int cb = (d0 * 16 + hi * 8) * 2;
        const bf16x8 b0 = *reinterpret_cast<const LAS bf16x8*>(Ks + KSWZ(r32, cb));
        const bf16x8 b1 = *reinterpret_cast<const LAS bf16x8*>(Ks + KSWZ(32 + r32, cb));
        p0 = __builtin_amdgcn_mfma_f32_32x32x16_bf16(b0, qr[d0], p0, 0, 0, 0);
        p1 = __builtin_amdgcn_mfma_f32_32x32x16_bf16(b1, qr[d0], p1, 0, 0, 0); }
    if constexpr (DQK == 192) {
#pragma unroll
        for (int d0 = 0; d0 < 4; ++d0) { const int cb = (d0 * 16 + hi * 8) * 2;
            const bf16x8 b0 = *reinterpret_cast<const LAS bf16x8*>(Rs + KSWZ(r32, cb));
            const bf16x8 b1 = *reinterpret_cast<const LAS bf16x8*>(Rs + KSWZ(32 + r32, cb));
            p0 = __builtin_amdgcn_mfma_f32_32x32x16_bf16(b0, qr[8 + d0], p0, 0, 0, 0);
            p1 = __builtin_amdgcn_mfma_f32_32x32x16_bf16(b1, qr[8 + d0], p1, 0, 0, 0); }
    }
}
template <int DQK> constexpr int attn_lds_bytes() { return 4 * SHM_T + (DQK == 192 ? 2 * SHM_T : 0) + NW * 64 * 4; }

template <int DQK, int LDQ, int LDK, int LDV, int LDO>
__device__ __forceinline__ void attn_body(const bf16_t* __restrict__ Qb, const bf16_t* __restrict__ Kh, const bf16_t* __restrict__ Rh, const bf16_t* __restrict__ Vh,
                                          bf16_t* __restrict__ Ob, int seq, LAS char* lds, const int tid) {
    constexpr int ND = DQK / 16;
    const int wid = tid >> 6, lane = tid & 63, r32 = lane & 31, hi = lane >> 5;
    LAS char* V_lds = lds; LAS char* K_lds = lds + 2 * SHM_T; LAS char* R_lds = lds + 4 * SHM_T;
    LAS float* wsl = (LAS float*)(lds + 4 * SHM_T + (DQK == 192 ? 2 * SHM_T : 0)) + wid * 64; LAS float* li_l = wsl; LAS float* al_l = wsl + 32;
    float m_reg = -1e30f, l_reg = 0; f32x16 o[4] = {}; bf16x8 qr[ND];
    const bf16_t* Qw = Qb + (long)(wid * QBLK + r32) * LDQ + hi * 8;
#pragma unroll
    for (int d0 = 0; d0 < ND; ++d0) qr[d0] = *reinterpret_cast<const bf16x8*>(Qw + d0 * 16);
    const int sr = tid >> 4, sc = (tid & 15) * 8, vst0 = v_st(sr, sc), vst1 = v_st(32 + sr, sc);
    const int rr = tid >> 3, rc = (tid & 7) * 8;
    const int vb0 = (int)(uintptr_t)V_lds + v_rd_base(lane);
    struct { bf16x8 vs0, vs1, ks0, ks1, rs; } sr_[2];
#define SLOAD(i, k0) do { sr_[i].vs0 = *reinterpret_cast<const bf16x8*>(&Vh[(long)((k0) + sr) * LDV + sc]); sr_[i].vs1 = *reinterpret_cast<const bf16x8*>(&Vh[(long)((k0) + 32 + sr) * LDV + sc]); \
    sr_[i].ks0 = *reinterpret_cast<const bf16x8*>(&Kh[(long)((k0) + sr) * LDK + sc]); sr_[i].ks1 = *reinterpret_cast<const bf16x8*>(&Kh[(long)((k0) + 32 + sr) * LDK + sc]); \
    if constexpr (DQK == 192) sr_[i].rs = *reinterpret_cast<const bf16x8*>(&Rh[(long)((k0) + rr) * 64 + rc]); } while (0)
#define SWRITE(b, i) do { *(LAS bf16x8*)(V_lds + (b) * SHM_T + vst0) = sr_[i].vs0; *(LAS bf16x8*)(V_lds + (b) * SHM_T + vst1) = sr_[i].vs1; const int kc = sc * 2; \
    *(LAS bf16x8*)(K_lds + (b) * SHM_T + KSWZ(sr, kc)) = sr_[i].ks0; *(LAS bf16x8*)(K_lds + (b) * SHM_T + KSWZ(32 + sr, kc)) = sr_[i].ks1; \
    if constexpr (DQK == 192) *(LAS bf16x8*)(R_lds + (b) * SHM_T + KSWZ(rr, rc * 2)) = sr_[i].rs; } while (0)
#define SWAIT() do { if constexpr (DQK == 192) asm volatile("s_waitcnt vmcnt(5)" ::: "memory"); else asm volatile("s_waitcnt vmcnt(4)" ::: "memory"); } while (0)
#define RESC(a) do { if (__any((a) < 1.f)) { if (hi == 0) al_l[r32] = (a); asm volatile("s_waitcnt lgkmcnt(0)" ::: "memory"); \
    _Pragma("unroll") for (int d = 0; d < 4; ++d) _Pragma("unroll") for (int r = 0; r < 16; ++r) o[d][r] *= al_l[crow(r, hi)]; } } while (0)
    f32x16 pA0, pA1, pB0, pB1; float mnA, mnB, alA, alB; bf16x8 pa0, pa1, pa2, pa3; const int NT = seq / KVBLK;
    constexpr int SE = 0, SO = 1;
    SLOAD(SE, 0); asm volatile("s_waitcnt vmcnt(0)" ::: "memory"); SWRITE(0, SE); __syncthreads();
    qkt<DQK>(pA0, pA1, K_lds, R_lds, qr, r32, hi); partialSM<DQK>(pA0, pA1, m_reg, mnA, alA);
    SLOAD(SO, KVBLK); if (2 < NT) SLOAD(SE, 2 * KVBLK);
    SWAIT(); SWRITE(1, SO); __syncthreads();
    for (int j = 1; j + 1 < NT; j += 2) {
        SBAR(); qkt<DQK>(pB0, pB1, K_lds + SHM_T, R_lds + SHM_T, qr, r32, hi);
        finishSM(pA0, pA1, alA, l_reg, pa0, pa1, pa2, pa3); SBAR();
        SLOAD(SO, (j + 2) * KVBLK); SBAR();
        pv_d0(o, vb0, pa0, pa1, pa2, pa3); partialSM<DQK>(pB0, pB1, m_reg, mnB, alB);
        __syncthreads(); SWAIT(); SWRITE(0, SE);
        RESC(alB); __syncthreads();
        SBAR(); qkt<DQK>(pA0, pA1, K_lds, R_lds, qr, r32, hi);
        finishSM(pB0, pB1, alB, l_reg, pa0, pa1, pa2, pa3); SBAR();
        if (j + 3 < NT) SLOAD(SE, (j + 3) * KVBLK); SBAR();
        pv_d0(o, vb0 + SHM_T, pa0, pa1, pa2, pa3); partialSM<DQK>(pA0, pA1, m_reg, mnA, alA);
        __syncthreads(); SWAIT(); SWRITE(1, SO);
        RESC(alA); __syncthreads();
    }
    SBAR(); qkt<DQK>(pB0, pB1, K_lds + SHM_T, R_lds + SHM_T, qr, r32, hi);
    finishSM(pA0, pA1, alA, l_reg, pa0, pa1, pa2, pa3); SBAR();
    pv_d0(o, vb0, pa0, pa1, pa2, pa3); partialSM<DQK>(pB0, pB1, m_reg, mnB, alB);
    __syncthreads(); RESC(alB);
    finishSM(pB0, pB1, alB, l_reg, pa0, pa1, pa2, pa3); SBAR();
    pv_d0(o, vb0 + SHM_T, pa0, pa1, pa2, pa3);
    if (hi == 0) li_l[r32] = l_reg; asm volatile("s_waitcnt lgkmcnt(0)" ::: "memory");
    float rli[16];
#pragma unroll
    for (int r = 0; r < 16; ++r) rli[r] = __builtin_amdgcn_rcpf(li_l[crow(r, hi)]);
    bf16_t* Ow = Ob + (long)(wid * QBLK) * LDO;
#pragma unroll
    for (int r = 0; r < 16; ++r) { const int orow = crow(r, hi);
#pragma unroll
        for (int d0 = 0; d0 < 4; ++d0) Ow[(long)orow * LDO + d0 * 32 + r32] = (bf16_t)(cvt_pk_bf16(o[d0][r] * rli[r], 0.f) & 0xffffu); }
    __syncthreads();
#undef SLOAD
#undef SWRITE
#undef SWAIT
#undef RESC
}
template <int DQK, int LDQ, int LDK, int LDV, int LDO>
__device__ __forceinline__ void attn_simple(const bf16_t* __restrict__ Qb, const bf16_t* __restrict__ Kh, const bf16_t* __restrict__ Rh, const bf16_t* __restrict__ Vh,
                                            bf16_t* __restrict__ Ob, int seq, LAS char* lds, const int tid) {
    constexpr int ND = DQK / 16;
    const int wid = tid >> 6, lane = tid & 63, r32 = lane & 31, hi = lane >> 5;
    LAS char* V_lds = lds; LAS char* K_lds = lds + 2 * SHM_T; LAS char* R_lds = lds + 4 * SHM_T;
    LAS float* wsl = (LAS float*)(lds + 4 * SHM_T + (DQK == 192 ? 2 * SHM_T : 0)) + wid * 64; LAS float* li_l = wsl; LAS float* al_l = wsl + 32;
    float m_reg = -1e30f, l_reg = 0; f32x16 o[4] = {}; bf16x8 qr[ND];
    const bf16_t* Qw = Qb + (long)(wid * QBLK + r32) * LDQ + hi * 8;
#pragma unroll
    for (int d0 = 0; d0 < ND; ++d0) qr[d0] = *reinterpret_cast<const bf16x8*>(Qw + d0 * 16);
    const int sr = tid >> 4, sc = (tid & 15) * 8, vst0 = v_st(sr, sc), vst1 = v_st(32 + sr, sc);
    const int rr = tid >> 3, rc = (tid & 7) * 8;
    const int vb0 = (int)(uintptr_t)V_lds + v_rd_base(lane);
    bf16x8 vs0, vs1, ks0, ks1, rs;
#define SLOAD(k0) do { vs0 = *reinterpret_cast<const bf16x8*>(&Vh[(long)((k0) + sr) * LDV + sc]); vs1 = *reinterpret_cast<const bf16x8*>(&Vh[(long)((k0) + 32 + sr) * LDV + sc]); \
    ks0 = *reinterpret_cast<const bf16x8*>(&Kh[(long)((k0) + sr) * LDK + sc]); ks1 = *reinterpret_cast<const bf16x8*>(&Kh[(long)((k0) + 32 + sr) * LDK + sc]); \
    if constexpr (DQK == 192) rs = *reinterpret_cast<const bf16x8*>(&Rh[(long)((k0) + rr) * 64 + rc]); } while (0)
#define SWRITE(b) do { *(LAS bf16x8*)(V_lds + (b) * SHM_T + vst0) = vs0; *(LAS bf16x8*)(V_lds + (b) * SHM_T + vst1) = vs1; const int kc = sc * 2; \
    *(LAS bf16x8*)(K_lds + (b) * SHM_T + KSWZ(sr, kc)) = ks0; *(LAS bf16x8*)(K_lds + (b) * SHM_T + KSWZ(32 + sr, kc)) = ks1; \
    if constexpr (DQK == 192) *(LAS bf16x8*)(R_lds + (b) * SHM_T + KSWZ(rr, rc * 2)) = rs; } while (0)
    const int NT = seq / KVBLK;
    SLOAD(0); asm volatile("s_waitcnt vmcnt(0)" ::: "memory"); SWRITE(0); __syncthreads();
    if (1 < NT) SLOAD(KVBLK);
    for (int j = 0; j < NT; ++j) {
        const int b = j & 1;
        f32x16 p0, p1; float mn, alpha; bf16x8 pa0, pa1, pa2, pa3;
        qkt<DQK>(p0, p1, K_lds + b * SHM_T, R_lds + b * SHM_T, qr, r32, hi);
        partialSM<DQK>(p0, p1, m_reg, mn, alpha);
        if (__any(alpha < 1.f)) { if (hi == 0) al_l[r32] = alpha; asm volatile("s_waitcnt lgkmcnt(0)" ::: "memory");
#pragma unroll
            for (int d = 0; d < 4; ++d)
#pragma unroll
                for (int r = 0; r < 16; ++r) o[d][r] *= al_l[crow(r, hi)]; }
        finishSM(p0, p1, alpha, l_reg, pa0, pa1, pa2, pa3);
        if (j + 1 < NT) SWRITE(b ^ 1);
        if (j + 2 < NT) SLOAD((j + 2) * KVBLK);
        pv_d0(o, vb0 + b * SHM_T, pa0, pa1, pa2, pa3);
        __syncthreads();
    }
    if (hi == 0) li_l[r32] = l_reg; asm volatile("s_waitcnt lgkmcnt(0)" ::: "memory");
    float rli[16];
#pragma unroll
    for (int r = 0; r < 16; ++r) rli[r] = __builtin_amdgcn_rcpf(li_l[crow(r, hi)]);
    bf16_t* Ow = Ob + (long)(wid * QBLK) * LDO;
#pragma unroll
    for (int r = 0; r < 16; ++r) { const int orow = crow(r, hi);
#pragma unroll
        for (int d0 = 0; d0 < 4; ++d0) Ow[(long)orow * LDO + d0 * 32 + r32] = (bf16_t)(cvt_pk_bf16(o[d0][r] * rli[r], 0.f) & 0xffffu); }
    __syncthreads();
#undef SLOAD
#undef SWRITE
}
#define RSWZ(row, colB) ((row) * 128 + ((colB) ^ ((((row) >> 1) & 7) << 4)))
template <int DQK>
__device__ __forceinline__ void qkt_dma(f32x16& p0, f32x16& p1, const LAS char* Ks, const LAS char* Rs, const bf16x8* qr, int r32, int hi) {
    p0 = f32x16{}; p1 = f32x16{};
#pragma unroll
    for (int d0 = 0; d0 < 8; ++d0) { const int cb = (d0 * 16 + hi * 8) * 2;
        const bf16x8 b0 = *reinterpret_cast<const LAS bf16x8*>(Ks + KSWZ(r32, cb));
        const bf16x8 b1 = *reinterpret_cast<const LAS bf16x8*>(Ks + KSWZ(32 + r32, cb));
        p0 = __builtin_amdgcn_mfma_f32_32x32x16_bf16(b0, qr[d0], p0, 0, 0, 0);
        p1 = __builtin_amdgcn_mfma_f32_32x32x16_bf16(b1, qr[d0], p1, 0, 0, 0); }
    if constexpr (DQK == 192) {
#pragma unroll
        for (int d0 = 0; d0 < 4; ++d0) { const int cb = (d0 * 16 + hi * 8) * 2;
            const bf16x8 b0 = *reinterpret_cast<const LAS bf16x8*>(Rs + RSWZ(r32, cb));
            const bf16x8 b1 = *reinterpret_cast<const LAS bf16x8*>(Rs + RSWZ(32 + r32, cb));
            p0 = __builtin_amdgcn_mfma_f32_32x32x16_bf16(b0, qr[8 + d0], p0, 0, 0, 0);
            p1 = __builtin_amdgcn_mfma_f32_32x32x16_bf16(b1, qr[8 + d0], p1, 0, 0, 0); }
    }
}
template <int DQK, int LDQ, int LDK, int LDV, int LDO>
__device__ __forceinline__ void attn_dma(const bf16_t* __restrict__ Qb, const bf16_t* __restrict__ Kh, const bf16_t* __restrict__ Rh, const bf16_t* __restrict__ Vh,
                                         bf16_t* __restrict__ Ob, int seq, LAS char* lds, LAS float* wscr, const int tid) {
    constexpr int ND = DQK / 16, KOFF = 0, VOFF = 3 * SHM_T, ROFF = 6 * SHM_T;
    const int wid = __builtin_amdgcn_readfirstlane(tid >> 6), lane = tid & 63, r32 = lane & 31, hi = lane >> 5;
    LAS float* li_l = wscr + wid * 64; LAS float* al_l = li_l + 32;
    float m_reg = -1e30f, l_reg = 0; f32x16 o[4] = {}; bf16x8 qr[ND];
    const bf16_t* Qw = Qb + (long)(wid * QBLK + r32) * LDQ + hi * 8;
#pragma unroll
    for (int d0 = 0; d0 < ND; ++d0) qr[d0] = *reinterpret_cast<const bf16x8*>(Qw + d0 * 16);
    unsigned voK[2], voV[2], voR;
#pragma unroll
    for (int i = 0; i < 2; ++i) { const int B = i * 8192 + wid * 1024 + lane * 16;
        { const int row = B >> 8, colB = (B & 255) ^ ((row & 7) << 4); voK[i] = (unsigned)(row * LDK * 2 + colB); }
        { const int sub = B >> 9, kk = (sub >> 2) * 8 + ((B & 511) >> 6), c = (sub & 3) * 32 + ((B & 63) >> 1); const int k = (kk & ~0xC) | ((kk & 4) << 1) | ((kk & 8) >> 1);
          voV[i] = (unsigned)((k * LDV + c) * 2); } }
    { const int B = wid * 1024 + lane * 16, row = B >> 7, colB = (B & 127) ^ (((row >> 1) & 7) << 4); voR = (unsigned)(row * 128 + colB); }
    const int vb0 = (int)(uintptr_t)lds + VOFF + v_rd_base(lane);
    const int NT = seq / KVBLK;
#define GLDS(gp, lp) __builtin_amdgcn_global_load_lds((const unsigned*)(gp), (LAS unsigned*)(lp), 16, 0, 0)
#define ISSUE(t, b) do { const char* kg_ = (const char*)Kh + (size_t)(t) * (KVBLK * LDK * 2); const char* vg_ = (const char*)Vh + (size_t)(t) * (KVBLK * LDV * 2); \
    LAS char* kl_ = lds + KOFF + (b) * SHM_T + wid * 1024; LAS char* vl_ = lds + VOFF + (b) * SHM_T + wid * 1024; \
    GLDS(kg_ + voK[0], kl_); GLDS(kg_ + voK[1], kl_ + 8192); GLDS(vg_ + voV[0], vl_); GLDS(vg_ + voV[1], vl_ + 8192); \
    if constexpr (DQK == 192) GLDS((const char*)Rh + (size_t)(t) * (KVBLK * 128) + voR, lds + ROFF + (b) * 8192 + wid * 1024); } while (0)
#define WAITV(n) asm volatile("s_waitcnt vmcnt(" #n ")" ::: "memory")
#define BARX() do { asm volatile("s_waitcnt lgkmcnt(0)" ::: "memory"); __builtin_amdgcn_s_barrier(); asm volatile("" ::: "memory"); SBAR(); } while (0)
#define RESC(a) do { if (__any((a) < 1.f)) { if (hi == 0) al_l[r32] = (a); asm volatile("s_waitcnt lgkmcnt(0)" ::: "memory"); \
    _Pragma("unroll") for (int d = 0; d < 4; ++d) _Pragma("unroll") for (int r = 0; r < 16; ++r) o[d][r] *= al_l[crow(r, hi)]; } } while (0)
    f32x16 pA0, pA1, pB0, pB1; float mnA, mnB, alA, alB; bf16x8 pa0, pa1, pa2, pa3;
    ISSUE(0, 0); ISSUE(1, 1); if (2 < NT) ISSUE(2, 2);
    if (2 < NT) { if constexpr (DQK == 192) WAITV(10); else WAITV(8); } else { if constexpr (DQK == 192) WAITV(5); else WAITV(4); }
    BARX();
    qkt_dma<DQK>(pA0, pA1, lds + KOFF, lds + ROFF, qr, r32, hi); partialSM<DQK>(pA0, pA1, m_reg, mnA, alA);
    if (2 < NT) { if constexpr (DQK == 192) WAITV(5); else WAITV(4); } else WAITV(0);
    BARX();
    int bp = 0, bc = 1;
#define STEP(j, C0, C1, mnC, alC, P0, P1, alP) do { \
    SBAR(); qkt_dma<DQK>(C0, C1, lds + KOFF + bc * SHM_T, lds + ROFF + bc * 8192, qr, r32, hi); \
    finishSM(P0, P1, alP, l_reg, pa0, pa1, pa2, pa3); SBAR(); \
    pv_d0(o, vb0 + bp * SHM_T, pa0, pa1, pa2, pa3); partialSM<DQK>(C0, C1, m_reg, mnC, alC); \
    WAITV(0); BARX(); \
    if ((j) + 2 < NT) ISSUE((j) + 2, bp); \
    RESC(alC); \
    bp = bc; bc = (bc == 2) ? 0 : bc + 1; } while (0)
    for (int j = 1; j + 1 < NT; j += 2) {
        STEP(j, pB0, pB1, mnB, alB, pA0, pA1, alA);
        STEP(j + 1, pA0, pA1, mnA, alA, pB0, pB1, alB);
    }
    STEP(NT - 1, pB0, pB1, mnB, alB, pA0, pA1, alA);
    finishSM(pB0, pB1, alB, l_reg, pa0, pa1, pa2, pa3); SBAR();
    pv_d0(o, vb0 + bp * SHM_T, pa0, pa1, pa2, pa3);
    if (hi == 0) li_l[r32] = l_reg; asm volatile("s_waitcnt lgkmcnt(0)" ::: "memory");
    float rli[16];
#pragma unroll
    for (int r = 0; r < 16; ++r) rli[r] = __builtin_amdgcn_rcpf(li_l[crow(r, hi)]);
    bf16_t* Ow = Ob + (long)(wid * QBLK) * LDO;
#pragma unroll
    for (int r = 0; r < 16; ++r) { const int orow = crow(r, hi);
#pragma unroll
        for (int d0 = 0; d0 < 4; ++d0) Ow[(long)orow * LDO + d0 * 32 + r32] = (bf16_t)(cvt_pk_bf16(o[d0][r] * rli[r], 0.f) & 0xffffu); }
    BARX();
#undef GLDS
#undef ISSUE
#undef WAITV
#undef BARX
#undef RESC
#undef STEP
}
}

struct Params {
    const float* in[32];
    float* out; unsigned char* ws;
    int ph_lo, ph_hi;
};
enum { I_XP = 0, I_XS, I_C, I_CAK, I_CAV, I_SRF, I_SRB, I_CCKV, I_CKR, I_CCTX, I_WMOD, I_BMOD, I_GPMIX, I_GPOMIX, I_GPMLP, I_GPOMLP, I_WIN, I_AQN, I_AKN, I_RDF, I_RDB, I_RGN,
       I_MQN, I_MKVN, I_WUQ, I_WUKV, I_WBA, I_WBB, I_WBC, I_WOUT, I_WUP, I_WDN };
constexpr size_t O_YP = 0, O_YS = 8388608, O_NAK = 25165824, O_NAV = O_NAK + 4194304, O_NRF = O_NAV + 4194304, O_NRB = O_NRF + 8388608, O_NCKV = O_NRB + 8388608, O_NKR = O_NCKV + 4194304, O_END = O_NKR + 1048576;

typedef const __attribute__((address_space(4))) Params CParams;
struct Ctx {
    LAS unsigned char* lds; int tid, lane, wave, bid, G;
    CParams* p;
};

struct TItem { const float* W; bf16_t* WT; int K, N, ldw, shift_from, shift; };
__device__ __forceinline__ void ti_load(f32x4 (&v)[8], const TItem& t, int item, int lane) {
    const int nblk = t.N / 32, kb = item / nblk, nb = item - kb * nblk, k0 = 64 * kb, n0 = 32 * nb;
    const float* p = t.W + (size_t)(k0 + (lane >> 3)) * t.N + n0 + (lane & 7) * 4;
#pragma unroll
    for (int i = 0; i < 8; ++i) v[i] = *(const f32x4*)(p + (size_t)(8 * i) * t.N);
}
__device__ __forceinline__ void ti_store(const f32x4 (&v)[8], const TItem& t, int item, int lane, LAS float* scr) {
    const int nblk = t.N / 32, kb = item / nblk, nb = item - kb * nblk, k0 = 64 * kb, n0 = 32 * nb;
#pragma unroll
    for (int i = 0; i < 8; ++i) { LAS float* s = scr + (8 * i + (lane >> 3)) * 33 + (lane & 7) * 4; s[0] = v[i][0]; s[1] = v[i][1]; s[2] = v[i][2]; s[3] = v[i][3]; }
    LDS_WAIT(); asm volatile("" ::: "memory");
    const int c = lane & 7; const int r0 = n0 + (n0 >= t.shift_from ? t.shift : 0);
#pragma unroll
    for (int j = 0; j < 4; ++j) { const int n = (lane >> 3) + 8 * j; const LAS float* s = scr + (8 * c) * 33 + n;
        u32x4 o; o.x = cvt_pk_bf16(s[0 * 33], s[1 * 33]); o.y = cvt_pk_bf16(s[2 * 33], s[3 * 33]); o.z = cvt_pk_bf16(s[4 * 33], s[5 * 33]); o.w = cvt_pk_bf16(s[6 * 33], s[7 * 33]);
        *(u32x4*)(t.WT + (size_t)(r0 + n) * t.ldw + k0 + 8 * c) = o; }
    LDS_WAIT(); asm volatile("" ::: "memory");
}
__device__ __forceinline__ TItem ti_decode(CParams& P, unsigned char* ws, int l, int& r) {
    constexpr int I_IN = 32 * 362, I_UQ = 8 * 48, I_UKV = 4 * 64, I_BR = 16 * 64, I_OUT = 32 * 64, I_UP = 32 * 256;
    if (r < I_IN) return TItem{P.in[I_WIN] + (size_t)l * 2048 * 11584, (bf16_t*)(ws + WS_WIN + l * SZ_WIN), 2048, 11584, LDH, 5440, 192}; r -= I_IN;
    if (r < I_UQ) return TItem{P.in[I_WUQ] + (size_t)l * 512 * 1536, (bf16_t*)(ws + WS_WUQ + l * SZ_WUQ), 512, 1536, 512, 1 << 30, 0}; r -= I_UQ;
    if (r < I_UKV) return TItem{P.in[I_WUKV] + (size_t)l * 256 * 2048, (bf16_t*)(ws + WS_WUKV + l * SZ_WUKV), 256, 2048, 256, 1 << 30, 0}; r -= I_UKV;
    if (r < 3 * I_BR) { const int z = r / I_BR; r -= z * I_BR; return TItem{P.in[I_WBA + z] + (size_t)l * 1024 * 2048, (bf16_t*)(ws + WS_WBR + (l * 3 + z) * SZ_WBR1), 1024, 2048, LDO, 1 << 30, 0}; } r -= 3 * I_BR;
    if (r < I_OUT) return TItem{P.in[I_WOUT] + (size_t)l * 2048 * 2048, (bf16_t*)(ws + WS_WOUT + l * SZ_WOUT), 2048, 2048, LDH, 1 << 30, 0}; r -= I_OUT;
    if (r < I_UP) return TItem{P.in[I_WUP] + (size_t)l * 2048 * 8192, (bf16_t*)(ws + WS_WUP + l * SZ_WUP), 2048, 8192, LDH, 1 << 30, 0}; r -= I_UP;
    return TItem{P.in[I_WDN] + (size_t)l * 8192 * 2048, (bf16_t*)(ws + WS_WDN + l * SZ_WDN), 8192, 2048, LDU, 1 << 30, 0};
}
__device__ __forceinline__ void convert_layer(const Ctx& F, const int l, const int b0, const int nb) {
    CParams& P = *F.p; unsigned char* ws = P.ws; const int bi = F.bid - b0;
    {
        LAS float* sv = (LAS float*)F.lds;
        LAS float* red = (LAS float*)(F.lds + 32768);
        for (int i = F.tid; i < 3 * 2048; i += NTHR) { const int v = i >> 11, k = i & 2047; const float x = (v == 0) ? P.in[I_CCTX][k] : P.in[I_C][(v - 1) * 2048 + k]; sv[i] = siluf_(x); }
        __syncthreads();
        float* MOD = (float*)(ws + WS_MOD);
        const int c4 = F.tid & 15, kq = F.tid >> 4;
        for (int cg = bi; cg < 192; cg += nb) {
            const float* w = P.in[I_WMOD] + (size_t)l * 2048 * 12288 + cg * 64 + c4 * 4;
            f32x4 a0 = {0, 0, 0, 0}, a1 = a0, a2 = a0;
#pragma unroll 8
            for (int kk = 0; kk < 64; ++kk) { const int k = kq + 32 * kk; const f32x4 wv = *(const f32x4*)(w + (size_t)k * 12288);
                a0 += wv * sv[k]; a1 += wv * sv[2048 + k]; a2 += wv * sv[4096 + k]; }
#pragma unroll
            for (int j = 0; j < 4; ++j) { red[(kq * 3 + 0) * 64 + c4 * 4 + j] = a0[j]; red[(kq * 3 + 1) * 64 + c4 * 4 + j] = a1[j]; red[(kq * 3 + 2) * 64 + c4 * 4 + j] = a2[j]; }
            __syncthreads();
            if (F.tid < 192) { const int v = F.tid >> 6, col = F.tid & 63; float s = 0.f;
#pragma unroll 8
                for (int q = 0; q < 32; ++q) s += red[(q * 3 + v) * 64 + col];
                MOD[((size_t)l * 3 + v) * 12288 + cg * 64 + col] = s + P.in[I_BMOD][(size_t)l * 12288 + cg * 64 + col]; }
            __syncthreads();
        }
    }
    {
        LAS float* scr = (LAS float*)(F.lds + F.wave * 16384);
        const int gw = bi * NWAVES + F.wave, NGW = nb * NWAVES;
        constexpr int PER_L = 32 * 362 + 8 * 48 + 4 * 64 + 3 * 16 * 64 + 32 * 64 + 32 * 256 + 128 * 64;
        f32x4 va[8], vb[8], vc[8];
#define TI_LOAD(buf, itx) do { if ((itx) < PER_L) { int r_ = (itx); const TItem t_ = ti_decode(P, ws, l, r_); ti_load(buf, t_, r_, F.lane); } } while (0)
#define TI_STORE(buf, itx) do { if ((itx) < PER_L) { int r_ = (itx); const TItem t_ = ti_decode(P, ws, l, r_); ti_store(buf, t_, r_, F.lane, scr); } } while (0)
        TI_LOAD(va, gw); TI_LOAD(vb, gw + NGW);
        for (int it = gw; it < PER_L; it += 3 * NGW) {
            TI_LOAD(vc, it + 2 * NGW); TI_STORE(va, it);
            TI_LOAD(va, it + 3 * NGW); TI_STORE(vb, it + NGW);
            TI_LOAD(vb, it + 4 * NGW); TI_STORE(vc, it + 2 * NGW);
        }
#undef TI_LOAD
#undef TI_STORE
    }
}

__device__ __forceinline__ void norm_phase(const Ctx& F, const float* xin_ctx, const float* xin_lat, const bf16_t* o0, const bf16_t* o1, float* X, bf16_t* H,
                                           const float* modA, int gate_off, const float* gA, const float* modB, int scale_off, int shift_off, const float* gB) {
    const int gw = F.bid * NWAVES + F.wave, NGW = F.G * NWAVES;
    for (int r = gw; r < NTOK; r += NGW) {
        const int v = r < NCTX ? 0 : 1 + ((r - NCTX) >> 12);
        const float* xr = r < NCTX ? xin_ctx + (size_t)r * DM : xin_lat + (size_t)(r - NCTX) * DM;
        f32x4 x[8];
#pragma unroll
        for (int j = 0; j < 8; ++j) x[j] = *(const f32x4*)(xr + (F.lane + 64 * j) * 4);
        if (o0) {
            f32x4 o[8]; float ss = 0.f;
#pragma unroll
            for (int j = 0; j < 8; ++j) { const u32x2 pa = *(const u32x2*)(o0 + (size_t)r * DM + (F.lane + 64 * j) * 4), pb = *(const u32x2*)(o1 + (size_t)r * DM + (F.lane + 64 * j) * 4);
                o[j] = (f32x4){bf_lo(pa.x) + bf_lo(pb.x), bf_hi(pa.x) + bf_hi(pb.x), bf_lo(pa.y) + bf_lo(pb.y), bf_hi(pa.y) + bf_hi(pb.y)};
                ss += (o[j][0] * o[j][0] + o[j][1] * o[j][1]) + (o[j][2] * o[j][2] + o[j][3] * o[j][3]); }
            const float rs = 1.0f / sqrtf(wave_sum(ss) * (1.0f / DM) + EPS);
#pragma unroll
            for (int j = 0; j < 8; ++j) { const int c = (F.lane + 64 * j) * 4; const f32x4 ga = *(const f32x4*)(gA + c), gt = *(const f32x4*)(modA + (size_t)v * 12288 + gate_off + c);
                x[j] += gt * (o[j] * rs * ga); }
        }
#pragma unroll
        for (int j = 0; j < 8; ++j) *(f32x4*)(X + (size_t)r * DM + (F.lane + 64 * j) * 4) = x[j];
        if (gB) {
            float ss = 0.f;
#pragma unroll
            for (int j = 0; j < 8; ++j) ss += (x[j][0] * x[j][0] + x[j][1] * x[j][1]) + (x[j][2] * x[j][2] + x[j][3] * x[j][3]);
            const float rs = 1.0f / sqrtf(wave_sum(ss) * (1.0f / DM) + EPS);
#pragma unroll
            for (int j = 0; j < 8; ++j) { const int c = (F.lane + 64 * j) * 4; const f32x4 gb = *(const f32x4*)(gB + c);
                const f32x4 sc = *(const f32x4*)(modB + (size_t)v * 12288 + scale_off + c), sh = *(const f32x4*)(modB + (size_t)v * 12288 + shift_off + c);
                const f32x4 h = (x[j] * rs * gb) * (sc + 1.0f) + sh;
                u32x2 w; w.x = cvt_pk_bf16(h[0], h[1]); w.y = cvt_pk_bf16(h[2], h[3]);
                *(u32x2*)(H + (size_t)r * LDH + c) = w; }
        }
    }
}

struct RopeCS { float c0, s0, c1, s1; };
__device__ __forceinline__ RopeCS rope_cs128(int lane, int prow, int pcol) {
    const int i0 = (2 * lane) & 31; const float pos = (float)((lane >> 5) ? pcol : prow);
    const float r0 = pos * __builtin_amdgcn_exp2f(-(float)i0 * (13.287712379549449f / 32.0f)) * 0.15915494309189535f;
    const float r1 = pos * __builtin_amdgcn_exp2f(-(float)(i0 + 1) * (13.287712379549449f / 32.0f)) * 0.15915494309189535f;
    RopeCS t; t.c0 = __builtin_amdgcn_cosf(r0); t.s0 = __builtin_amdgcn_sinf(r0); t.c1 = __builtin_amdgcn_cosf(r1); t.s1 = __builtin_amdgcn_sinf(r1);
    if ((lane & 16) == 0) { t.s0 = -t.s0; t.s1 = -t.s1; }
    return t;
}
__device__ __forceinline__ RopeCS rope_cs64(int g, int prow, int pcol) {
    const int i0 = (2 * g) & 15; const float pos = (float)((g >> 4) ? pcol : prow);
    const float r0 = pos * __builtin_amdgcn_exp2f(-(float)i0 * (13.287712379549449f / 16.0f)) * 0.15915494309189535f;
    const float r1 = pos * __builtin_amdgcn_exp2f(-(float)(i0 + 1) * (13.287712379549449f / 16.0f)) * 0.15915494309189535f;
    RopeCS t; t.c0 = __builtin_amdgcn_cosf(r0); t.s0 = __builtin_amdgcn_sinf(r0); t.c1 = __builtin_amdgcn_cosf(r1); t.s1 = __builtin_amdgcn_sinf(r1);
    if ((g & 8) == 0) { t.s0 = -t.s0; t.s1 = -t.s1; }
    return t;
}
__device__ __forceinline__ void rope128(float& y0, float& y1, const RopeCS& t) { const float p0 = swz_xor<16>(y0), p1 = swz_xor<16>(y1); y0 = y0 * t.c0 + p0 * t.s0; y1 = y1 * t.c1 + p1 * t.s1; }
__device__ __forceinline__ void rope64(float& y0, float& y1, const RopeCS& t) { const float p0 = swz_xor<8>(y0), p1 = swz_xor<8>(y1); y0 = y0 * t.c0 + p0 * t.s0; y1 = y1 * t.c1 + p1 * t.s1; }
struct PPRow { unsigned uq[10], uv[2], ub[8], ukr; u32x4 ucq; u32x2 ukv; };
__device__ __forceinline__ void pp_load(PPRow& R, const unsigned* P32, int lane) {
#pragma unroll
    for (int hd = 0; hd < 10; ++hd) R.uq[hd] = P32[hd * 64 + lane];
#pragma unroll
    for (int j = 0; j < 2; ++j) R.uv[j] = P32[C_AV / 2 + j * 64 + lane];
#pragma unroll
    for (int hd = 0; hd < 8; ++hd) R.ub[hd] = P32[C_BQ / 2 + hd * 64 + lane];
    R.ucq = *(const u32x4*)(P32 + C_CQL / 2 + 4 * lane); R.ukv = *(const u32x2*)(P32 + C_CKV / 2 + 2 * lane); R.ukr = P32[C_CKR / 2 + (lane & 31)];
}
template <bool DRY>
__device__ __forceinline__ void phase_postproj(const Ctx& F, int l) {
    CParams& P = *F.p; unsigned char* ws = P.ws;
    bf16_t* PROJ = (bf16_t*)(ws + WS_PROJ); bf16_t* KA = (bf16_t*)(ws + WS_KA); bf16_t* VA = (bf16_t*)(ws + WS_VA); bf16_t* CKV = (bf16_t*)(ws + WS_CKV); bf16_t* KR = (bf16_t*)(ws + WS_KROPE);
    const int gw = F.bid * NWAVES + F.wave, NGW = F.G * NWAVES, lane = F.lane;
    const f32x2 qn = *(const f32x2*)(P.in[I_AQN] + l * 128 + 2 * lane), kn = *(const f32x2*)(P.in[I_AKN] + l * 128 + 2 * lane);
    const f32x4 mq0 = *(const f32x4*)(P.in[I_MQN] + l * 512 + 8 * lane), mq1 = *(const f32x4*)(P.in[I_MQN] + l * 512 + 8 * lane + 4), mkv = *(const f32x4*)(P.in[I_MKVN] + l * 256 + 4 * lane);
    PPRow cur, nxt;
    if (gw < NTOK) pp_load(cur, (const unsigned*)(PROJ + (size_t)gw * LDP), lane);
    for (int r = gw; r < NTOK; r += NGW) {
        if (r + NGW < NTOK) pp_load(nxt, (const unsigned*)(PROJ + (size_t)(r + NGW) * LDP), lane);
        const bool lat = r >= NCTX; const int lr = r - NCTX, b = lr >> 12, n = lr & 4095, prow = n >> 6, pcol = n & 63;
        const int arow = lat ? NCTX + b * KVL + n : r;
        const int cb = r >> 8, cs = r & 255;
        unsigned* P32 = DRY ? (unsigned*)((bf16_t*)(ws + WS_PART) + (size_t)r * 5632) : (unsigned*)(PROJ + (size_t)r * LDP);
        RopeCS t128, t64;
        if (lat) { t128 = rope_cs128(lane, prow, pcol); t64 = rope_cs64(lane & 31, prow, pcol); }
        float y0[10], y1[10], ss[10];
#pragma unroll
        for (int hd = 0; hd < 10; ++hd) { y0[hd] = bf_lo(cur.uq[hd]); y1[hd] = bf_hi(cur.uq[hd]); ss[hd] = y0[hd] * y0[hd] + y1[hd] * y1[hd]; }
#pragma unroll
        for (int hd = 0; hd < 10; ++hd) ss[hd] = wave_sum(ss[hd]);
#pragma unroll
        for (int hd = 0; hd < 10; ++hd) {
            const float rs = 1.0f / sqrtf(ss[hd] * (1.0f / 128.0f) + EPS); const f32x2 gn = hd < 8 ? qn : kn;
            float a0 = y0[hd] * rs * gn[0], a1 = y1[hd] * rs * gn[1];
            if (lat) rope128(a0, a1, t128);
            if (hd < 8) P32[hd * 64 + lane] = cvt_pk_bf16(a0, a1);
            else { const int kvh = hd - 8; ((unsigned*)(KA + (size_t)arow * 256))[kvh * 64 + lane] = cvt_pk_bf16(a0, a1);
                if (!lat) *(f32x2*)(P.out + O_NAK + (((size_t)cb * 4 + l) * 256 + cs) * 256 + kvh * 128 + 2 * lane) = (f32x2){a0, a1}; }
        }
#pragma unroll
        for (int j = 0; j < 2; ++j) { const unsigned u = cur.uv[j]; ((unsigned*)(VA + (size_t)arow * 256))[j * 64 + lane] = u;
            if (!lat) *(f32x2*)(P.out + O_NAV + (((size_t)cb * 4 + l) * 256 + cs) * 256 + j * 128 + 2 * lane) = (f32x2){bf_lo(u), bf_hi(u)}; }
#pragma unroll
        for (int hd = 0; hd < 8; ++hd) {
            if (!lat && hd < 4) continue;
            float a0 = bf_lo(cur.ub[hd]), a1 = bf_hi(cur.ub[hd]);
            if (lat) rope128(a0, a1, t128);
            if (hd >= 4) { a0 *= 0.08838834764831845f; a1 *= 0.08838834764831845f; }
            P32[C_BQ / 2 + hd * 64 + lane] = cvt_pk_bf16(a0, a1);
        }
        { u32x4 u = cur.ucq;
          float y[8] = {bf_lo(u.x), bf_hi(u.x), bf_lo(u.y), bf_hi(u.y), bf_lo(u.z), bf_hi(u.z), bf_lo(u.w), bf_hi(u.w)}; float s2 = 0.f;
#pragma unroll
          for (int i = 0; i < 8; ++i) s2 += y[i] * y[i];
          const float rs = 1.0f / sqrtf(wave_sum(s2) * (1.0f / 512.0f) + EPS);
          u.x = cvt_pk_bf16(y[0] * rs * mq0[0], y[1] * rs * mq0[1]); u.y = cvt_pk_bf16(y[2] * rs * mq0[2], y[3] * rs * mq0[3]);
          u.z = cvt_pk_bf16(y[4] * rs * mq1[0], y[5] * rs * mq1[1]); u.w = cvt_pk_bf16(y[6] * rs * mq1[2], y[7] * rs * mq1[3]);
          *(u32x4*)(P32 + C_CQL / 2 + 4 * lane) = u; }
        { const u32x2 u = cur.ukv;
          float y[4] = {bf_lo(u.x), bf_hi(u.x), bf_lo(u.y), bf_hi(u.y)};
          const float rs = 1.0f / sqrtf(wave_sum((y[0] * y[0] + y[1] * y[1]) + (y[2] * y[2] + y[3] * y[3])) * (1.0f / 256.0f) + EPS);
#pragma unroll
          for (int i = 0; i < 4; ++i) y[i] *= rs * mkv[i];
          u32x2 w; w.x = cvt_pk_bf16(y[0], y[1]); w.y = cvt_pk_bf16(y[2], y[3]);
          *(u32x2*)(CKV + (size_t)arow * 256 + 4 * lane) = w;
          if (!lat) *(f32x4*)(P.out + O_NCKV + (((size_t)cb * 4 + l) * 256 + cs) * 256 + 4 * lane) = (f32x4){y[0], y[1], y[2], y[3]}; }
        { float a0 = bf_lo(cur.ukr), a1 = bf_hi(cur.ukr);
          if (lat) rope64(a0, a1, t64);
          if (lane < 32) { ((unsigned*)(KR + (size_t)arow * 64))[lane] = cvt_pk_bf16(a0, a1);
              if (!lat) *(f32x2*)(P.out + O_NKR + (((size_t)cb * 4 + l) * 256 + cs) * 64 + 2 * lane) = (f32x2){a0, a1}; } }
        cur = nxt;
    }
    for (int r = gw; r < 1024; r += NGW) {
        const int b = r >> 9, j = r & 511; const size_t arow = NCTX + (size_t)b * KVL + 4096 + j; const size_t src = ((size_t)b * 4 + l) * 512 + j;
        { const f32x4 k = *(const f32x4*)(P.in[I_CAK] + src * 256 + 4 * lane), v = *(const f32x4*)(P.in[I_CAV] + src * 256 + 4 * lane), c = *(const f32x4*)(P.in[I_CCKV] + src * 256 + 4 * lane);
          u32x2 w; w.x = cvt_pk_bf16(k[0], k[1]); w.y = cvt_pk_bf16(k[2], k[3]); *(u32x2*)(KA + arow * 256 + 4 * lane) = w;
          w.x = cvt_pk_bf16(v[0], v[1]); w.y = cvt_pk_bf16(v[2], v[3]); *(u32x2*)(VA + arow * 256 + 4 * lane) = w;
          w.x = cvt_pk_bf16(c[0], c[1]); w.y = cvt_pk_bf16(c[2], c[3]); *(u32x2*)(CKV + arow * 256 + 4 * lane) = w; }
        if (lane < 16) { const f32x4 k = *(const f32x4*)(P.in[I_CKR] + src * 64 + 4 * lane); u32x2 w; w.x = cvt_pk_bf16(k[0], k[1]); w.y = cvt_pk_bf16(k[2], k[3]); *(u32x2*)(KR + arow * 64 + 4 * lane) = w; }
    }
}

__device__ __forceinline__ float log_sigmoid_(float x) { return -__logf(1.0f + __expf(-x)); }
template <int SCALE_MODE>
__device__ __forceinline__ void stage_vtile(LAS char* dst, const bf16_t* src, int ld, int tid, float lg2, int jbase) {
#pragma unroll
    for (int i = 0; i < 2; ++i) { const int p = tid + 512 * i, k = p >> 4, c8 = (p & 15) * 8;
        u32x4 u = *(const u32x4*)(src + (size_t)k * ld + c8);
        if (SCALE_MODE != 0) { const float jj = (float)(jbase + k); const float f = __builtin_amdgcn_exp2f(lg2 * (SCALE_MODE == 1 ? (127.0f - jj) : jj));
            u.x = cvt_pk_bf16(bf_lo(u.x) * f, bf_hi(u.x) * f); u.y = cvt_pk_bf16(bf_lo(u.y) * f, bf_hi(u.y) * f); u.z = cvt_pk_bf16(bf_lo(u.z) * f, bf_hi(u.z) * f); u.w = cvt_pk_bf16(bf_lo(u.w) * f, bf_hi(u.w) * f); }
        *(LAS u32x4*)(dst + att::v_st(k, c8)) = u; }
}
__device__ __forceinline__ void ret_kv_unit(const Ctx& F, int l, int u) {
    CParams& P = *F.p; unsigned char* ws = P.ws;
    const int c = u >> 2, h = u & 3, row0 = c * 128, tid = F.tid, lane = F.lane, w = F.wave;
    const bf16_t* PROJ = (const bf16_t*)(ws + WS_PROJ);
    const float lgf2 = log_sigmoid_(P.in[I_RDF][l * 4 + h]) * 1.4426950408889634f, lgb2 = log_sigmoid_(P.in[I_RDB][l * 4 + h]) * 1.4426950408889634f;
    LAS char* lds = (LAS char*)F.lds;
#pragma nounroll
    for (int jt = 0; jt < 2; ++jt) {
        const bf16_t* ksrc = PROJ + (size_t)(row0 + jt * 64) * LDP + C_BK + h * 128;
        stage_vtile<1>(lds + jt * 16384, ksrc, LDP, tid, lgf2, jt * 64);
        stage_vtile<2>(lds + 32768 + jt * 16384, ksrc, LDP, tid, lgb2, jt * 64);
#pragma nounroll
        for (int eh = 0; eh < 2; ++eh) stage_vtile<0>(lds + 65536 + (jt * 2 + eh) * 16384, PROJ + (size_t)(row0 + jt * 64) * LDP + C_BV + h * 256 + eh * 128, LDP, tid, 0.f, 0);
    }
    __syncthreads();
    const int dblk = w & 3, eh = w >> 2;
    f32x16 accF[4] = {}, accB[4] = {};
#pragma nounroll
    for (int jt = 0; jt < 2; ++jt) {
        const int vbF = (int)(uintptr_t)lds + jt * 16384 + att::v_rd_base(lane) + dblk * 512, vbB = 32768 + vbF, vbV = 65536 + (jt * 2 + eh) * 16384 + att::v_rd_base(lane);
#define KVSTEP(KS) do { \
        const s16x4 fl = att::tr_read<att::v_rd_off(0, KS, 0)>(vbF), fh = att::tr_read<att::v_rd_off(0, KS, 1)>(vbF), bl = att::tr_read<att::v_rd_off(0, KS, 0)>(vbB), bh = att::tr_read<att::v_rd_off(0, KS, 1)>(vbB); \
        const s16x4 v0l = att::tr_read<att::v_rd_off(0, KS, 0)>(vbV), v0h = att::tr_read<att::v_rd_off(0, KS, 1)>(vbV), v1l = att::tr_read<att::v_rd_off(1, KS, 0)>(vbV), v1h = att::tr_read<att::v_rd_off(1, KS, 1)>(vbV); \
        const s16x4 v2l = att::tr_read<att::v_rd_off(2, KS, 0)>(vbV), v2h = att::tr_read<att::v_rd_off(2, KS, 1)>(vbV), v3l = att::tr_read<att::v_rd_off(3, KS, 0)>(vbV), v3h = att::tr_read<att::v_rd_off(3, KS, 1)>(vbV); \
        asm volatile("s_waitcnt lgkmcnt(0)" ::: "memory"); SBAR(); \
        const bf16x8 af = PKLH(fl, fh), ab = PKLH(bl, bh), b0 = PKLH(v0l, v0h), b1 = PKLH(v1l, v1h), b2 = PKLH(v2l, v2h), b3 = PKLH(v3l, v3h); \
        accF[0] = __builtin_amdgcn_mfma_f32_32x32x16_bf16(af, b0, accF[0], 0, 0, 0); accB[0] = __builtin_amdgcn_mfma_f32_32x32x16_bf16(ab, b0, accB[0], 0, 0, 0); \
        accF[1] = __builtin_amdgcn_mfma_f32_32x32x16_bf16(af, b1, accF[1], 0, 0, 0); accB[1] = __builtin_amdgcn_mfma_f32_32x32x16_bf16(ab, b1, accB[1], 0, 0, 0); \
        accF[2] = __builtin_amdgcn_mfma_f32_32x32x16_bf16(af, b2, accF[2], 0, 0, 0); accB[2] = __builtin_amdgcn_mfma_f32_32x32x16_bf16(ab, b2, accB[2], 0, 0, 0); \
        accF[3] = __builtin_amdgcn_mfma_f32_32x32x16_bf16(af, b3, accF[3], 0, 0, 0); accB[3] = __builtin_amdgcn_mfma_f32_32x32x16_bf16(ab, b3, accB[3], 0, 0, 0); } while (0)
        KVSTEP(0); KVSTEP(1); KVSTEP(2); KVSTEP(3);
#undef KVSTEP
    }
    float* RKV = (float*)(ws + WS_RKV) + ((size_t)(c * 4 + h) * 2) * RET_ST;
    const int r32 = lane & 31, hi = lane >> 5;
#pragma unroll
    for (int r = 0; r < 16; ++r) { const int d = dblk * 32 + att::crow(r, hi);
#pragma unroll
        for (int eb = 0; eb < 4; ++eb) { const int e = eh * 128 + eb * 32 + r32; RKV[(size_t)d * 256 + e] = accF[eb][r]; RKV[RET_ST + (size_t)d * 256 + e] = accB[eb][r]; } }
    __syncthreads();
}
__device__ __forceinline__ void phase_scan(const Ctx& F, int l, bool do_rope) {
    CParams& P = *F.p; unsigned char* ws = P.ws;
    float* RKV = (float*)(ws + WS_RKV); bf16_t* RS = (bf16_t*)(ws + WS_RS);
    for (int it = F.bid; it < 2304; it += F.G) {
        const bool lat = it < 256; const int q = lat ? it : it - 256; const int combo = q >> 4, slab = q & 15;
        const int dir = combo & 1, h = (combo >> 1) & 3, sb = combo >> 3; const size_t e0 = (size_t)slab * 2048 + F.tid * 4;
        const float cd = __expf(128.0f * log_sigmoid_(P.in[dir ? I_RDB : I_RDF][l * 4 + h]));
        if (lat) {
            f32x4 s = *(const f32x4*)(P.in[dir ? I_SRB : I_SRF] + (((size_t)sb * 4 + l) * 4 + h) * RET_ST + e0);
            for (int t = 0; t < 32; ++t) { const int n = dir ? 31 - t : t; const size_t base = ((size_t)((32 + sb * 32 + n) * 4 + h) * 2 + dir) * RET_ST + e0;
                u32x2 w; w.x = cvt_pk_bf16(s[0], s[1]); w.y = cvt_pk_bf16(s[2], s[3]); *(u32x2*)(RS + base) = w;
                s = s * cd + *(const f32x4*)(RKV + base); }
        } else {
            f32x4 s = {0.f, 0.f, 0.f, 0.f};
#pragma unroll
            for (int t = 0; t < 2; ++t) { const int n = dir ? 1 - t : t; const size_t base = ((size_t)((sb * 2 + n) * 4 + h) * 2 + dir) * RET_ST + e0;
                u32x2 w; w.x = cvt_pk_bf16(s[0], s[1]); w.y = cvt_pk_bf16(s[2], s[3]); *(u32x2*)(RS + base) = w;
                s = s * cd + *(const f32x4*)(RKV + base); }
            *(f32x4*)(P.out + (dir ? O_NRB : O_NRF) + (((size_t)sb * 4 + l) * 4 + h) * RET_ST + e0) = s;
        }
    }
    bf16_t* CQ = (bf16_t*)(ws + WS_CQ);
    const int gw = F.bid * NWAVES + F.wave, NGW = F.G * NWAVES, lane = F.lane;
    if (do_rope) for (int r = NCTX + gw; r < NTOK; r += NGW) {
        const int n = (r - NCTX) & 4095, prow = n >> 6, pcol = n & 63; const RopeCS t64 = rope_cs64(lane & 31, prow, pcol);
        unsigned uu[4];
#pragma unroll
        for (int j = 0; j < 4; ++j) uu[j] = *((const unsigned*)(CQ + (size_t)r * LDCQ + ((lane >> 5) + 2 * j) * 192 + 128) + (lane & 31));
#pragma unroll
        for (int j = 0; j < 4; ++j) { float y0 = bf_lo(uu[j]), y1 = bf_hi(uu[j]); rope64(y0, y1, t64); *((unsigned*)(CQ + (size_t)r * LDCQ + ((lane >> 5) + 2 * j) * 192 + 128) + (lane & 31)) = cvt_pk_bf16(y0, y1); }
    }
}
__device__ __forceinline__ void ret_out_unit(const Ctx& F, int l, int u) {
    CParams& P = *F.p; unsigned char* ws = P.ws;
    const int c = u >> 2, h = u & 3, row0 = c * 128, tid = F.tid, lane = F.lane, w = F.wave, r32 = lane & 31, hi = lane >> 5;
    const bf16_t* PROJ = (const bf16_t*)(ws + WS_PROJ); const bf16_t* RS = (const bf16_t*)(ws + WS_RS) + ((size_t)(c * 4 + h) * 2) * RET_ST;
    const float lgf2 = log_sigmoid_(P.in[I_RDF][l * 4 + h]) * 1.4426950408889634f, lgb2 = log_sigmoid_(P.in[I_RDB][l * 4 + h]) * 1.4426950408889634f;
    LAS char* lds = (LAS char*)F.lds;
    const int qblk = w & 3, eh = w >> 2, qi = qblk * 32 + r32;
    const int ldsb = (int)(uintptr_t)lds;
    const bf16_t* Qw = PROJ + (size_t)(row0 + qi) * LDP + C_BQ + h * 128 + hi * 8;
#pragma nounroll
    for (int jt = 0; jt < 2; ++jt) {
        const int sr = tid >> 4, sc = (tid & 15) * 8;
        const bf16_t* ksrc = PROJ + (size_t)(row0 + jt * 64) * LDP + C_BK + h * 128;
        *(LAS bf16x8*)(lds + jt * 16384 + KSWZ(sr, sc * 2)) = *reinterpret_cast<const bf16x8*>(ksrc + (size_t)sr * LDP + sc);
        *(LAS bf16x8*)(lds + jt * 16384 + KSWZ(32 + sr, sc * 2)) = *reinterpret_cast<const bf16x8*>(ksrc + (size_t)(32 + sr) * LDP + sc);
#pragma nounroll
        for (int e2 = 0; e2 < 2; ++e2) stage_vtile<0>(lds + 32768 + (jt * 2 + e2) * 16384, PROJ + (size_t)(row0 + jt * 64) * LDP + C_BV + h * 256 + e2 * 128, LDP, tid, 0.f, 0);
    }
    __syncthreads();
    f32x16 o[4] = {};
    {
        bf16x8 qr[8];
#pragma unroll
        for (int d0 = 0; d0 < 8; ++d0) qr[d0] = *reinterpret_cast<const bf16x8*>(Qw + d0 * 16);
#pragma nounroll
        for (int jt = 0; jt < 2; ++jt) {
            f32x16 p0, p1; att::qkt<128>(p0, p1, lds + jt * 16384, lds, qr, r32, hi);
#pragma unroll
            for (int r = 0; r < 16; ++r) {
                const int j0 = jt * 64 + att::crow(r, hi), j1 = j0 + 32; const int d0 = qi - j0, d1 = qi - j1;
                const float w0 = d0 > 0 ? __builtin_amdgcn_exp2f(lgf2 * (float)d0) : (d0 < 0 ? __builtin_amdgcn_exp2f(lgb2 * (float)(-d0)) : 2.0f);
                const float w1 = d1 > 0 ? __builtin_amdgcn_exp2f(lgf2 * (float)d1) : (d1 < 0 ? __builtin_amdgcn_exp2f(lgb2 * (float)(-d1)) : 2.0f);
                p0[r] *= w0; p1[r] *= w1; }
            bf16x8 pa0, pa1, pa2, pa3; att::p_to_frags(p0, p1, pa0, pa1, pa2, pa3);
            att::pv_d0(o, ldsb + 32768 + (jt * 2 + eh) * 16384 + att::v_rd_base(lane), pa0, pa1, pa2, pa3);
        }
    }
    __syncthreads();
#pragma nounroll
    for (int t = 0; t < 8; ++t) stage_vtile<0>(lds + t * 16384, RS + (size_t)(t >> 2) * RET_ST + (size_t)(((t >> 1) & 1) * 64) * 256 + (t & 1) * 128, 256, tid, 0.f, 0);
    __syncthreads();
    {
        const float ff = __builtin_amdgcn_exp2f(lgf2 * (float)(qi + 1)), fb = __builtin_amdgcn_exp2f(lgb2 * (float)(128 - qi));
#pragma nounroll
        for (int sd = 0; sd < 4; ++sd) { const float f = (sd >> 1) ? fb : ff; const int dt = sd & 1; bf16x8 pa[4];
#pragma unroll
            for (int k = 0; k < 4; ++k) { const u32x4 q4 = *reinterpret_cast<const u32x4*>(Qw + (dt * 4 + k) * 16); u32x4 s4;
                s4.x = cvt_pk_bf16(bf_lo(q4.x) * f, bf_hi(q4.x) * f); s4.y = cvt_pk_bf16(bf_lo(q4.y) * f, bf_hi(q4.y) * f); s4.z = cvt_pk_bf16(bf_lo(q4.z) * f, bf_hi(q4.z) * f); s4.w = cvt_pk_bf16(bf_lo(q4.w) * f, bf_hi(q4.w) * f);
                pa[k] = *reinterpret_cast<const bf16x8*>(&s4); }
            att::pv_d0(o, ldsb + (sd * 2 + eh) * 16384 + att::v_rd_base(lane), pa[0], pa[1], pa[2], pa[3]); }
    }
    LAS float* rsum = (LAS float*)(F.lds + LDS_RS_OFF);
    float ss[16];
#pragma unroll
    for (int r = 0; r < 16; ++r) { float s = 0.f;
#pragma unroll
        for (int d0 = 0; d0 < 4; ++d0) s += o[d0][r] * o[d0][r];
        s += swz_xor<1>(s); s += swz_xor<2>(s); s += swz_xor<4>(s); s += swz_xor<8>(s); s += swz_xor<16>(s); ss[r] = s; }
    if (r32 == 0) {
#pragma unroll
        for (int r = 0; r < 16; ++r) rsum[eh * 128 + qblk * 32 + att::crow(r, hi)] = ss[r]; }
    __syncthreads();
    const float* gn = P.in[I_RGN] + l * 1024 + h * 256; bf16_t* OB = (bf16_t*)(ws + WS_OABC + SZ_O1);
#pragma unroll
    for (int r = 0; r < 16; ++r) { const int i = qblk * 32 + att::crow(r, hi);
        const float rs = 1.0f / sqrtf((rsum[i] + rsum[128 + i]) * (1.0f / 256.0f) + EPS);
#pragma unroll
        for (int d0 = 0; d0 < 4; ++d0) { const int e = eh * 128 + d0 * 32 + r32;
            const float g = __uint_as_float((unsigned)PROJ[(size_t)(row0 + i) * LDP + C_BG + h * 256 + e] << 16);
            OB[(size_t)(row0 + i) * LDO + h * 256 + e] = (bf16_t)(cvt_pk_bf16(o[d0][r] * rs * gn[e] * siluf_(g), 0.f) & 0xffffu); } }
    __syncthreads();
}

constexpr int NPH_L = 11, NPH = 2 + DEPTH * NPH_L;
__global__ void __launch_bounds__(NTHR, 2) mega(Params prm) {
    extern __shared__ __attribute__((aligned(16))) unsigned char lds_raw[];
    Ctx F; F.lds = (LAS unsigned char*)lds_raw; F.tid = threadIdx.x; F.lane = F.tid & 63; F.wave = __builtin_amdgcn_readfirstlane(F.tid >> 6); F.bid = blockIdx.x; F.G = gridDim.x; F.p = (CParams*)__builtin_amdgcn_kernarg_segment_ptr();
    unsigned char* ws = F.p->ws;
    for (int u = F.tid; u < 128; u += NTHR) ((LAS unsigned*)(F.lds + LDSCTL_OFF))[u] = 0u;
    __syncthreads();
    const int lo = F.p->ph_lo, hi = F.p->ph_hi; const bool multi = (hi - lo) > 1;
    XcdBarrier bar; bar.bar = (unsigned*)(ws + WS_CTL); bar.x = 0; bar.st = nullptr;
    if (multi) bar = xcd_barrier_post((unsigned*)(ws + WS_CTL), (volatile LAS unsigned*)(F.lds + LDSCTL_OFF + 32));
#ifndef SUB_MASK
#define SUB_MASK 15
#endif
#ifndef PH_MASK
#define PH_MASK 0xFFFF
#endif
#ifndef DUP_MASK
#define DUP_MASK 0
#endif
#define REPS(bit) ((DUP_MASK & (bit)) ? 2 : 1)
#define IN(k) (lo <= (k) && (k) < hi)
#define RELANE() do { int l_; asm volatile("v_mbcnt_lo_u32_b32 %0, -1, 0\n\tv_mbcnt_hi_u32_b32 %0, -1, %0" : "=v"(l_)); F.lane = l_; F.tid = F.wave * 64 + l_; } while (0)
#define FRESH() do { int l_; asm volatile("v_mbcnt_lo_u32_b32 %0, -1, 0\n\tv_mbcnt_hi_u32_b32 %0, -1, %0" : "=v"(l_)); F.lane = l_; F.tid = F.wave * 64 + l_; CParams* kp_ = (CParams*)__builtin_amdgcn_kernarg_segment_ptr(); asm volatile("" : "+s"(kp_)); F.p = kp_; } while (0)
#define SEAM(k) do { if (IN(k) && IN((k) + 1)) xcd_barrier(bar, F.tid == 0); } while (0)
    float* X = F.p->out;
    const float* MOD = (const float*)(ws + WS_MOD);
    bf16_t* H = (bf16_t*)(ws + WS_H); bf16_t* PROJ = (bf16_t*)(ws + WS_PROJ);
    float* PART = (float*)(ws + WS_PART);

    if ((PH_MASK & 1) && IN(0)) _Pragma("nounroll") for (int rp = 0; rp < REPS(1); ++rp) { FRESH(); convert_layer(F, 0, 0, F.G); SEAM(0); }
    if ((PH_MASK & 2) && IN(1)) { FRESH(); norm_phase(F, F.p->in[I_XP], F.p->in[I_XS], nullptr, nullptr, X, H, nullptr, 0, nullptr, MOD, 2048, 0, F.p->in[I_GPMIX]); SEAM(1); }

    for (int l = 0; l < DEPTH; ++l) {
        const int pb = 2 + l * NPH_L; const float* MODL = MOD + (size_t)l * 3 * 12288;
        if ((PH_MASK & 4) && IN(pb + 0)) _Pragma("nounroll") for (int rp = 0; rp < REPS(4); ++rp) { FRESH();
            pg8::EpiBf16<0> E{PROJ, LDP, 0};
            pg8::gemm_phase<pg8::EpiBf16<0>, NTOK, NPROJ, LDH, LDH, DM, 1, false, 0, 0>(F.lds, F.tid, H, ws + WS_WIN + l * SZ_WIN, F.G, F.bid, E);
            SEAM(pb + 0);
        }
        if ((PH_MASK & 8) && IN(pb + 1)) _Pragma("nounroll") for (int rp = 0; rp < REPS(8); ++rp) { FRESH(); if (REPS(8) == 2 && rp == 0) phase_postproj<true>(F, l); else phase_postproj<false>(F, l); SEAM(pb + 1); }
        if ((PH_MASK & 16) && IN(pb + 2)) _Pragma("nounroll") for (int rp = 0; rp < REPS(16); ++rp) { FRESH();
            if (SUB_MASK & 1) { pg8::EpiBf16<0> E{(bf16_t*)(ws + WS_CQ), LDCQ, 0};
              pg8::gemm_phase<pg8::EpiBf16<0>, NTOK, 1536, LDP, 512, 512, 1, false, 0, 0>(F.lds, F.tid, PROJ + C_CQL, ws + WS_WUQ + l * SZ_WUQ, F.G, F.bid, E); }
            if (SUB_MASK & 2) { FRESH(); pg8::EpiBf16<0> E{(bf16_t*)(ws + WS_KVUP), LDKV, 0};
              pg8::gemm_phase<pg8::EpiBf16<0>, NALL, 2048, 256, 256, 256, 1, false, 0, 0>(F.lds, F.tid, ws + WS_CKV, ws + WS_WUKV + l * SZ_WUKV, F.G, F.G - 1 - F.bid, E); }
            if (SUB_MASK & 4) { FRESH(); for (int u = F.bid; u < 384; u += F.G) { RELANE(); ret_kv_unit(F, l, u); } }
            FRESH();
            if (SUB_MASK & 8) for (int u = F.bid; u < 384; u += F.G) {
                RELANE(); int row0, kv0, seq, h;
                if (u < 256) { const int b = u >> 7; h = (u >> 4) & 7; row0 = NCTX + b * 4096 + (u & 15) * 256; kv0 = NCTX + b * KVL; seq = KVL; }
                else { const int s = (u - 256) >> 3; h = (u - 256) & 7; row0 = s * 256; kv0 = s * 256; seq = 256; }
                att::attn_dma<128, LDP, 256, 256, LDO>(PROJ + (size_t)row0 * LDP + C_AQ + h * 128, (const bf16_t*)(ws + WS_KA) + (size_t)kv0 * 256 + (h >> 2) * 128, nullptr,
                    (const bf16_t*)(ws + WS_VA) + (size_t)kv0 * 256 + (h >> 2) * 128, (bf16_t*)(ws + WS_OABC) + (size_t)row0 * LDO + h * 128, seq, (LAS char*)F.lds, (LAS float*)(F.lds + LDS_WSCR_OFF), F.tid);
            }
            SEAM(pb + 2);
        }
        if ((PH_MASK & 32) && IN(pb + 3)) _Pragma("nounroll") for (int rp = 0; rp < REPS(32); ++rp) { FRESH(); phase_scan(F, l, rp == 0); SEAM(pb + 3); }
        if ((PH_MASK & 64) && IN(pb + 4)) _Pragma("nounroll") for (int rp = 0; rp < REPS(64); ++rp) { FRESH();
            FRESH();
            if (SUB_MASK & 2) for (int u = (F.bid + F.G / 2) % F.G; u < 384; u += F.G) {
                RELANE(); int row0, kv0, seq, h;
                if (u < 256) { const int b = u >> 7; h = (u >> 4) & 7; row0 = NCTX + b * 4096 + (u & 15) * 256; kv0 = NCTX + b * KVL; seq = KVL; }
                else { const int s = (u - 256) >> 3; h = (u - 256) & 7; row0 = s * 256; kv0 = s * 256; seq = 256; }
                att::attn_dma<192, LDCQ, LDKV, LDKV, LDO>((const bf16_t*)(ws + WS_CQ) + (size_t)row0 * LDCQ + h * 192, (const bf16_t*)(ws + WS_KVUP) + (size_t)kv0 * LDKV + h * 256,
                    (const bf16_t*)(ws + WS_KROPE) + (size_t)kv0 * 64, (const bf16_t*)(ws + WS_KVUP) + (size_t)kv0 * LDKV + h * 256 + 128,
                    (bf16_t*)(ws + WS_OABC + 2 * SZ_O1) + (size_t)row0 * LDO + h * 128, seq, (LAS char*)F.lds, (LAS float*)(F.lds + LDS_WSCR_OFF), F.tid);
            }
            FRESH();
            if (SUB_MASK & 4) for (int u = (F.bid + F.G / 2) % F.G; u < 384; u += F.G) { RELANE(); ret_out_unit(F, l, u); }
            SEAM(pb + 4);
        }
        if ((PH_MASK & 128) && IN(pb + 5)) _Pragma("nounroll") for (int rp = 0; rp < REPS(128); ++rp) { FRESH();
            pg8::EpiBranch E{PROJ + C_GATE, LDP, (bf16_t*)PART, (bf16_t*)(ws + WS_MERGED)};
            pg8::gemm_phase<pg8::EpiBranch, NTOK, DM, LDO, LDO, 1024, 3, true, SZ_O1, SZ_WBR1>(F.lds, F.tid, ws + WS_OABC, ws + WS_WBR + (size_t)l * 3 * SZ_WBR1, F.G, F.bid, E);
            if (l + 1 < DEPTH && rp == 0) { FRESH(); const int first = (F.G > 192 && F.G < 384) ? 384 - F.G : 0; if (F.bid >= first) convert_layer(F, l + 1, first, F.G - first); }
            SEAM(pb + 5);
        }
        if ((PH_MASK & 256) && IN(pb + 6)) _Pragma("nounroll") for (int rp = 0; rp < REPS(256); ++rp) { FRESH();
            pg8::EpiBf16<0> E{(bf16_t*)PART, DM, (size_t)NTOK * DM};
            pg8::gemm_phase<pg8::EpiBf16<0>, NTOK, DM, LDH, LDH, 1024, 2, false, 2048, 2048>(F.lds, F.tid, ws + WS_MERGED, ws + WS_WOUT + l * SZ_WOUT, F.G, F.bid, E);
            SEAM(pb + 6);
        }
        if ((PH_MASK & 512) && IN(pb + 7)) _Pragma("nounroll") for (int rp = 0; rp < REPS(512); ++rp) { FRESH();
            norm_phase(F, X, X + (size_t)NCTX * DM, (const bf16_t*)PART, (const bf16_t*)PART + (size_t)NTOK * DM, (REPS(512) == 2 && rp == 0) ? (float*)PROJ : X, (REPS(512) == 2 && rp == 0) ? (bf16_t*)(ws + WS_PROJ + SZ_PART1) : H, MODL, 4096, F.p->in[I_GPOMIX] + l * DM, MODL, 8192, 6144, F.p->in[I_GPMLP] + l * DM);
            SEAM(pb + 7);
        }
        if ((PH_MASK & 1024) && IN(pb + 8)) _Pragma("nounroll") for (int rp = 0; rp < REPS(1024); ++rp) { FRESH();
            pg8::EpiBf16<1> E{PROJ, LDU, 0};
            pg8::gemm_phase<pg8::EpiBf16<1>, NTOK, DFF, LDH, LDH, DM, 1, false, 0, 0>(F.lds, F.tid, H, ws + WS_WUP + l * SZ_WUP, F.G, F.bid, E);
            SEAM(pb + 8);
        }
        if ((PH_MASK & 2048) && IN(pb + 9)) _Pragma("nounroll") for (int rp = 0; rp < REPS(2048); ++rp) { FRESH();
            pg8::EpiBf16<0> E{(bf16_t*)PART, DM, (size_t)NTOK * DM};
            pg8::gemm_phase<pg8::EpiBf16<0>, NTOK, DM, LDU, LDU, 4096, 2, false, 8192, 8192>(F.lds, F.tid, PROJ, ws + WS_WDN + l * SZ_WDN, F.G, F.bid, E);
            SEAM(pb + 9);
        }
        if ((PH_MASK & 4096) && IN(pb + 10)) _Pragma("nounroll") for (int rp = 0; rp < REPS(4096); ++rp) { FRESH();
            const bool more = (l + 1 < DEPTH);
            norm_phase(F, X, X + (size_t)NCTX * DM, (const bf16_t*)PART, (const bf16_t*)PART + (size_t)NTOK * DM, (REPS(4096) == 2 && rp == 0) ? (float*)PROJ : X, (REPS(4096) == 2 && rp == 0) ? (bf16_t*)(ws + WS_PROJ + SZ_PART1) : H, MODL, 10240, F.p->in[I_GPOMLP] + l * DM,
                       MODL + 3 * 12288, 2048, 0, more ? F.p->in[I_GPMIX] + (l + 1) * DM : nullptr);
            SEAM(pb + 10);
        }
    }
#undef IN
#undef SEAM
}

#ifndef MK_MULTI
#define MK_MULTI 0
#endif
extern "C" void kernel_launch(void* const* d_in, const int* in_sizes, int n_in, void* d_out, int out_size, void* d_ws, size_t ws_size, hipStream_t stream) {
    static int grid = 0;
    if (grid == 0) {
        if (n_in != 32 || out_size != (int)O_END || ws_size < WS_END) { fprintf(stderr, "kernel_launch: unexpected shapes: n_in %d out %d ws %zu (need %zu)\n", n_in, out_size, ws_size, (size_t)WS_END); grid = -1; return; }
        int dev = 0, cus = 0, per_cu = 0;
        if (hipGetDevice(&dev) != hipSuccess || hipDeviceGetAttribute(&cus, hipDeviceAttributeMultiprocessorCount, dev) != hipSuccess) { grid = -1; return; }
        if (hipFuncSetAttribute((const void*)mega, hipFuncAttributeMaxDynamicSharedMemorySize, LDS_BYTES) != hipSuccess) { fprintf(stderr, "kernel_launch: hipFuncSetAttribute failed\n"); grid = -1; return; }
        if (hipOccupancyMaxActiveBlocksPerMultiprocessor(&per_cu, (const void*)mega, NTHR, LDS_BYTES) != hipSuccess || per_cu < 1) fprintf(stderr, "kernel_launch: occupancy query says %d\n", per_cu);
        (void)hipGetLastError();
        grid = cus;
    }
    if (grid < 0) return;
    (void)hipMemsetAsync((char*)d_ws + WS_CTL, 0, CTL_BYTES, stream);
    Params p{};
    for (int i = 0; i < 32; ++i) p.in[i] = (const float*)d_in[i];
    p.out = (float*)d_out; p.ws = (unsigned char*)d_ws;
#if MK_MULTI
    for (int k = 0; k < NPH; ++k) { p.ph_lo = k; p.ph_hi = k + 1; hipLaunchKernelGGL(mega, dim3(grid), dim3(NTHR), LDS_BYTES, stream, p); }
#else
    p.ph_lo = 0; p.ph_hi = NPH;
    hipLaunchKernelGGL(mega, dim3(grid), dim3(NTHR), LDS_BYTES, stream, p);
#endif
    const hipError_t le = hipPeekAtLastError();
    if (le != hipSuccess) fprintf(stderr, "kernel_launch: launch failed: %s\n", hipGetErrorName(le));
}
```

```cpp
#include <hip/hip_runtime.h>
#include <cstdio>
#include <cstdint>

#define LAS __attribute__((address_space(3)))
#define GAS __attribute__((address_space(1)))
typedef unsigned short bf16_t;
typedef short bf16x8 __attribute__((ext_vector_type(8)));
typedef short s16x4 __attribute__((ext_vector_type(4)));
typedef float f32x4 __attribute__((ext_vector_type(4)));
typedef float f32x2 __attribute__((ext_vector_type(2)));
typedef float f32x16 __attribute__((ext_vector_type(16)));
typedef unsigned u32x4 __attribute__((ext_vector_type(4)));
typedef unsigned u32x2 __attribute__((ext_vector_type(2)));

constexpr int DM = 2048, NCTX = 4096, NLAT = 8192, NTOK = 12288, DEPTH = 4, DFF = 8192;
constexpr int NPROJ = 11776;
constexpr int PADE = 64;
constexpr int LDP = NPROJ + PADE, LDH = DM + PADE, LDU = DFF + PADE, LDO = 1024 + PADE, LDCQ = 1536 + PADE, LDKV = 2048 + PADE;
constexpr int C_AQ = 0, C_AK = 1024, C_AV = 1280, C_BQ = 1536, C_BK = 2048, C_BV = 2560, C_BG = 3584, C_CQL = 4608, C_CKV = 5120, C_CKR = 5376, C_GATE = 5632;
constexpr int NALL = 13312;
constexpr int KVL = 4608;
constexpr float EPS = 1e-6f;
constexpr int NWAVES = 8, NTHR = 512;

constexpr size_t WS_CTL = 0, CTL_BYTES = 1u << 20;
constexpr size_t WS_MOD = CTL_BYTES;
constexpr size_t WS_WIN = 2u << 20;
constexpr size_t SZ_WIN = (size_t)NPROJ * LDH * 2;
constexpr size_t WS_WUQ = WS_WIN + 4 * SZ_WIN;
constexpr size_t SZ_WUQ = (size_t)1536 * 512 * 2;
constexpr size_t WS_WUKV = WS_WUQ + 4 * SZ_WUQ;
constexpr size_t SZ_WUKV = (size_t)2048 * 256 * 2;
constexpr size_t WS_WBR = WS_WUKV + 4 * SZ_WUKV;
constexpr size_t SZ_WBR1 = (size_t)2048 * LDO * 2;
constexpr size_t WS_WOUT = WS_WBR + 12 * SZ_WBR1;
constexpr size_t SZ_WOUT = (size_t)2048 * LDH * 2;
constexpr size_t WS_WUP = WS_WOUT + 4 * SZ_WOUT;
constexpr size_t SZ_WUP = (size_t)8192 * LDH * 2, SZ_WDN = (size_t)2048 * LDU * 2;
constexpr size_t WS_WDN = WS_WUP + 4 * SZ_WUP;
constexpr size_t WS_H = WS_WDN + 4 * SZ_WDN;
constexpr size_t WS_PROJ = WS_H + (size_t)NTOK * LDH * 2;
constexpr size_t WS_KA = WS_PROJ + (size_t)NTOK * LDP * 2;
constexpr size_t WS_VA = WS_KA + (size_t)NALL * 256 * 2;
constexpr size_t WS_CKV = WS_VA + (size_t)NALL * 256 * 2;
constexpr size_t WS_KROPE = WS_CKV + (size_t)NALL * 256 * 2;
constexpr size_t WS_CQ = WS_KROPE + (size_t)NALL * 64 * 2;
constexpr size_t WS_KVUP = WS_CQ + (size_t)NTOK * LDCQ * 2;
constexpr size_t WS_OABC = WS_KVUP + (size_t)NALL * LDKV * 2;
constexpr size_t SZ_O1 = (size_t)NTOK * LDO * 2;
constexpr size_t WS_MERGED = WS_OABC + 3 * SZ_O1;
constexpr size_t WS_PART = WS_MERGED + (size_t)NTOK * LDH * 2;
constexpr size_t SZ_PART1 = (size_t)NTOK * DM * 4;
constexpr size_t WS_END = WS_PART + 2 * SZ_PART1;
constexpr size_t RET_ST = 32768;
constexpr size_t WS_RKV = WS_PART;
constexpr size_t WS_RS = WS_PART + (size_t)96 * 4 * 2 * RET_ST * 4;
static_assert(WS_RS + (size_t)96 * 4 * 2 * RET_ST * 2 <= WS_END, "ws map");

constexpr int LDS_BYTES = 147456;
constexpr int LDSCTL_OFF = 131072;
constexpr int LDS_RS_OFF = 131072 + 1024;
constexpr int LDS_WSCR_OFF = 131072 + 2048;

__device__ __forceinline__ unsigned cvt_pk_bf16(float lo, float hi) { unsigned r; asm volatile("v_cvt_pk_bf16_f32 %0, %1, %2" : "=v"(r) : "v"(lo), "v"(hi)); return r; }
__device__ __forceinline__ float bf_lo(unsigned u) { return __uint_as_float(u << 16); }
__device__ __forceinline__ float bf_hi(unsigned u) { return __uint_as_float(u & 0xffff0000u); }
template <int X> __device__ __forceinline__ float swz_xor(float v) { return __int_as_float(__builtin_amdgcn_ds_swizzle(__float_as_int(v), 0x1f | (X << 10))); }
__device__ __forceinline__ float wave_sum(float v) {
    v += swz_xor<1>(v); v += swz_xor<2>(v); v += swz_xor<4>(v); v += swz_xor<8>(v); v += swz_xor<16>(v);
    auto rr = __builtin_amdgcn_permlane32_swap(__float_as_uint(v), __float_as_uint(v), false, false);
    return __uint_as_float(rr[0]) + __uint_as_float(rr[1]);
}
__device__ __forceinline__ float fast_exp(float x) { return __builtin_amdgcn_exp2f(x * 1.4426950408889634f); }
__device__ __forceinline__ float sigmoidf_(float x) { return __builtin_amdgcn_rcpf(1.0f + fast_exp(-x)); }
__device__ __forceinline__ float siluf_(float x) { return x * sigmoidf_(x); }
#define LDS_WAIT() asm volatile("s_waitcnt lgkmcnt(0)" ::: "memory")
#define VM_WAIT() asm volatile("s_waitcnt vmcnt(0)" ::: "memory")

#define XB_TMO      128
#define XB_XCNT(j)  (256  + 64 * (j))
#define XB_XSUB(j)  (1280 + 64 * (j))
#define XB_XGEN(j)  (2304 + 64 * (j))
#define XB_TOP      3328
#define XB_TOPGEN   3392
#define XCD_BAR_WORDS 3456
#define XB_SPIN_CAP (1u << 22)
__device__ __forceinline__ unsigned xb_ld(unsigned* p)              { return __hip_atomic_load(p, __ATOMIC_RELAXED, __HIP_MEMORY_SCOPE_AGENT); }
__device__ __forceinline__ unsigned xb_add(unsigned* p, unsigned v) { return __hip_atomic_fetch_add(p, v, __ATOMIC_RELAXED, __HIP_MEMORY_SCOPE_AGENT); }
__device__ __forceinline__ unsigned xb_xcc_id() { return (unsigned)__builtin_amdgcn_s_getreg((3 << 11) | 20) & 0xFu; }
#define XB_SPIN(cond, bar) do { unsigned _sp = 0; while (cond) { __builtin_amdgcn_s_sleep(1); \
    if ((++_sp & 255u) == 0u) { if (xb_ld(&(bar)[XB_TMO])) break; if (_sp > XB_SPIN_CAP) { atomicAdd(&(bar)[XB_TMO], 1u); break; } } } } while (0)
struct XcdBarrier { unsigned* bar; unsigned x; volatile LAS unsigned* st; };
__device__ __forceinline__ XcdBarrier xcd_barrier_post(unsigned* bar, volatile LAS unsigned* st) {
    XcdBarrier b; b.bar = bar; b.x = xb_xcc_id(); b.st = st;
    if (threadIdx.x == 0) (void)xb_add(&bar[XB_XCNT(b.x)], 1u);
    return b;
}
__device__ __forceinline__ void xcd_barrier_complete(unsigned* bar, unsigned x, unsigned& nloc, unsigned& nx) {
    const unsigned G = gridDim.x * gridDim.y * gridDim.z;
    unsigned sum, cnt, mine, sp = 0u;
    for (;;) {
        sum = 0u; cnt = 0u; mine = 0u;
#pragma unroll
        for (unsigned j = 0; j < 16; ++j) { const unsigned c = xb_ld(&bar[XB_XCNT(j)]); sum += c; cnt += (c > 0u) ? 1u : 0u; mine = (j == x) ? c : mine; }
        if (sum == G) break;
        __builtin_amdgcn_s_sleep(1);
        if ((++sp & 255u) == 0u) { if (xb_ld(&bar[XB_TMO])) break; if (sp > XB_SPIN_CAP) { atomicAdd(&bar[XB_TMO], 1u); break; } }
    }
    nloc = mine > 0u ? mine : 1u; nx = cnt > 0u ? cnt : 1u;
}
__device__ __forceinline__ void xcd_barrier(const XcdBarrier& b, const bool leader) {
    asm volatile("s_waitcnt vmcnt(0)" ::: "memory");
    __syncthreads();
    if (leader) {
        unsigned* bar = b.bar;
        __builtin_amdgcn_s_waitcnt(0);
        unsigned nloc = b.st[0], nx = b.st[1];
        if (nloc == 0u) { xcd_barrier_complete(bar, b.x, nloc, nx); b.st[0] = nloc; b.st[1] = nx; }
        const unsigned old = xb_add(&bar[XB_XSUB(b.x)], 1u);
        const unsigned gen = old / nloc;
        if (old + 1u == (gen + 1u) * nloc) {
            __builtin_amdgcn_fence(__ATOMIC_RELEASE, "agent");
            asm volatile("s_waitcnt vmcnt(0)" ::: "memory");
            const unsigned og = xb_add(&bar[XB_TOP], 1u);
            const unsigned tg = og / nx;
            if (og + 1u == (tg + 1u) * nx) xb_add(&bar[XB_TOPGEN], 1u);
            else XB_SPIN(xb_ld(&bar[XB_TOPGEN]) == tg, bar);
            __builtin_amdgcn_fence(__ATOMIC_ACQUIRE, "agent");
            xb_add(&bar[XB_XGEN(b.x)], 1u);
            asm volatile("s_waitcnt vmcnt(0)" ::: "memory");
        } else {
            XB_SPIN(xb_ld(&bar[XB_XGEN(b.x)]) == gen, bar);
            __builtin_amdgcn_fence(__ATOMIC_ACQUIRE, "agent");
            asm volatile("s_waitcnt vmcnt(0)" ::: "memory");
        }
    }
    __syncthreads();
}

namespace pg8 {
constexpr int BM = 256, BK = 64, HALF = 128, HTB = HALF * BK * 2, STAGE_BYTES = 8 * HTB, NXCD = 8, WGM = 8;
__host__ __device__ __forceinline__ int lds_byte(int r, int c) { const int st = (r >> 4) * 2 + (c >> 5), rr = r & 15, cc = c & 31, ob = rr * 64 + cc * 2; return st * 1024 + (ob ^ (((ob >> 9) & 1) << 5)); }
__host__ __device__ __forceinline__ void stage_rc(int b, int& R, int& C) { const int st = b / 1024, sb = b % 1024, swz = sb ^ (((sb >> 9) & 1) << 5); R = (st >> 1) * 16 + swz / 64; C = (st & 1) * 32 + (swz % 64) / 2; }
__host__ __device__ __forceinline__ int perm32(int rho) { const int n = rho >> 4, i = rho & 15; return 8 * (i >> 2) + 4 * n + (i & 3); }

struct Unit { int pm, pn, z; };
template <int M, int N, int NZ, bool ZINNER>
__device__ __forceinline__ bool next_unit(int k, int G, int c, Unit& u) {
    constexpr int nM = M / BM, nN = N / BM, nNx = ZINNER ? nN : nN * NZ, nwg = nM * nNx;
    int i, z;
    if (ZINNER) { i = k / NZ; z = k - i * NZ; } else { i = k; z = 0; }
    const int L = i * G + c; if (L >= nwg) return false;
    int wgid = L; { constexpr int q = nwg / NXCD, r = nwg % NXCD; const int xcd = wgid % NXCD, off = wgid / NXCD; wgid = (xcd < r ? xcd * (q + 1) : r * (q + 1) + (xcd - r) * q) + off; }
    constexpr int nig = WGM * nNx; const int gid = wgid / nig, fm = gid * WGM, gsz = (nM - fm) < WGM ? (nM - fm) : WGM;
    u.pm = fm + ((wgid % nig) % gsz); const int pnx = (wgid % nig) / gsz;
    if (ZINNER) { u.pn = pnx; u.z = z; } else { u.z = pnx / nN; u.pn = pnx - u.z * nN; }
    return true;
}

template <int ACT  > struct EpiBf16 {
    static constexpr bool PERM = true, KEEP = false;
    bf16_t* O; int ldc; size_t zstride;
    __device__ __forceinline__ void operator()(f32x4 (&acc)[2][2][4][2], const Unit& u, int wr, int wc, int fr, int fq) const {
        const int row0 = u.pm * BM + wr * 64 + fr; const int col0 = u.pn * BM + wc * 32 + 8 * fq; bf16_t* Oz = O + (size_t)u.z * zstride;
#pragma unroll
        for (int ai = 0; ai < 2; ++ai)
#pragma unroll
            for (int m = 0; m < 4; ++m) { bf16_t* rowp = Oz + (size_t)(row0 + ai * HALF + m * 16) * ldc + col0;
#pragma unroll
                for (int bj = 0; bj < 2; ++bj) { f32x4 v0 = acc[ai][bj][m][0], v1 = acc[ai][bj][m][1];
                    if (ACT == 1) {
#pragma unroll
                        for (int j = 0; j < 4; ++j) { const float a = fmaxf(v0[j], 0.f), b = fmaxf(v1[j], 0.f); v0[j] = a * a; v1[j] = b * b; } }
                    u32x4 w; w.x = cvt_pk_bf16(v0[0], v0[1]); w.y = cvt_pk_bf16(v0[2], v0[3]); w.z = cvt_pk_bf16(v1[0], v1[1]); w.w = cvt_pk_bf16(v1[2], v1[3]);
                    *(u32x4*)(rowp + bj * HALF) = w; } }
    }
};
struct EpiF32Z {
    static constexpr bool PERM = false, KEEP = false;
    float* C; int ldc; size_t zstride;
    __device__ __forceinline__ void operator()(f32x4 (&acc)[2][2][4][2], const Unit& u, int wr, int wc, int fr, int fq) const {
        const int row0 = u.pm * BM + wr * 64 + fr, col0 = u.pn * BM + wc * 32 + 4 * fq; float* Cz = C + (size_t)u.z * zstride;
#pragma unroll
        for (int ai = 0; ai < 2; ++ai)
#pragma unroll
            for (int m = 0; m < 4; ++m) { float* rowp = Cz + (size_t)(row0 + ai * HALF + m * 16) * ldc + col0;
#pragma unroll
                for (int bj = 0; bj < 2; ++bj)
#pragma unroll
                    for (int n = 0; n < 2; ++n) *(f32x4*)(rowp + bj * HALF + n * 16) = acc[ai][bj][m][n]; }
    }
};
struct EpiBranch {
    static constexpr bool PERM = true, KEEP = true;
    const bf16_t* gates; int ldg;
    bf16_t* O;
    __device__ __forceinline__ void operator()(f32x4 (&acc)[2][2][4][2], const Unit& u, int wr, int wc, int fr, int fq) const {
        const int row0 = u.pm * BM + wr * 64 + fr; const int col0 = u.pn * BM + wc * 32 + 8 * fq; const bool last = (u.z == 2);
#pragma unroll
        for (int ai = 0; ai < 2; ++ai)
#pragma unroll
            for (int mp = 0; mp < 2; ++mp) {
                u32x4 g[2][2], gn[2][2];
#pragma unroll
                for (int mm = 0; mm < 2; ++mm)
#pragma unroll
                    for (int bj = 0; bj < 2; ++bj) { const size_t row = (size_t)(row0 + ai * HALF + (mp * 2 + mm) * 16); const int col = col0 + bj * HALF;
                        g[mm][bj] = *(const u32x4*)(gates + row * ldg + (size_t)u.z * 2048 + col);
                        if (!last) gn[mm][bj] = *(const u32x4*)(gates + row * ldg + (size_t)(u.z + 1) * 2048 + col); }
#pragma unroll
                for (int mm = 0; mm < 2; ++mm)
#pragma unroll
                    for (int bj = 0; bj < 2; ++bj) { const int m = mp * 2 + mm; const size_t row = (size_t)(row0 + ai * HALF + m * 16); const int col = col0 + bj * HALF;
                        const u32x4 gg = g[mm][bj]; f32x4 v0 = acc[ai][bj][m][0], v1 = acc[ai][bj][m][1];
                        float f[8] = {sigmoidf_(bf_lo(gg.x)), sigmoidf_(bf_hi(gg.x)), sigmoidf_(bf_lo(gg.y)), sigmoidf_(bf_hi(gg.y)), sigmoidf_(bf_lo(gg.z)), sigmoidf_(bf_hi(gg.z)), sigmoidf_(bf_lo(gg.w)), sigmoidf_(bf_hi(gg.w))};
                        if (!last) { const u32x4 nn = gn[mm][bj];
                            f[0] *= 1.0f + fast_exp(fminf(-bf_lo(nn.x), 40.f)); f[1] *= 1.0f + fast_exp(fminf(-bf_hi(nn.x), 40.f)); f[2] *= 1.0f + fast_exp(fminf(-bf_lo(nn.y), 40.f)); f[3] *= 1.0f + fast_exp(fminf(-bf_hi(nn.y), 40.f));
                            f[4] *= 1.0f + fast_exp(fminf(-bf_lo(nn.z), 40.f)); f[5] *= 1.0f + fast_exp(fminf(-bf_hi(nn.z), 40.f)); f[6] *= 1.0f + fast_exp(fminf(-bf_lo(nn.w), 40.f)); f[7] *= 1.0f + fast_exp(fminf(-bf_hi(nn.w), 40.f)); }
                        v0[0] *= f[0]; v0[1] *= f[1]; v0[2] *= f[2]; v0[3] *= f[3]; v1[0] *= f[4]; v1[1] *= f[5]; v1[2] *= f[6]; v1[3] *= f[7];
                        if (!last) { acc[ai][bj][m][0] = v0; acc[ai][bj][m][1] = v1; }
                        else { u32x4 w; w.x = cvt_pk_bf16(v0[0], v0[1]); w.y = cvt_pk_bf16(v0[2], v0[3]); w.z = cvt_pk_bf16(v1[0], v1[1]); w.w = cvt_pk_bf16(v1[2], v1[3]);
                            *(u32x4*)(O + row * LDH + col) = w; } }
            }
    }
};

template <class Epi, int M, int N, int LDA, int LDB, int KU, int NZ, bool ZINNER, size_t AZS, size_t BZS, bool ALIGN_EPI = true>
__device__ __forceinline__ void gemm_phase(LAS unsigned char* lds, const int tid, const void* Aptr, const void* Bptr, int G, int c, const Epi& E) {
    const char* const Abase = (const char*)Aptr; const char* const Bbase = (const char*)Bptr;
    const int wid = __builtin_amdgcn_readfirstlane(tid >> 6), lane = tid & 63, wr = wid >> 2, wc = wid & 3, fr = lane & 15, fq = lane >> 4;
    constexpr int nt = KU / BK;
    unsigned voffA[2], voffB[2];
#pragma unroll
    for (int i = 0; i < 2; ++i) { int R, C; stage_rc(tid * 16 + i * 8192, R, C); const int Rb = Epi::PERM ? ((R & ~31) + perm32(R & 31)) : R;
        voffA[i] = (unsigned)(R * LDA + C) * 2u; voffB[i] = (unsigned)(Rb * LDB + C) * 2u; }
    constexpr size_t kstep = (size_t)(BK * 2);
    constexpr size_t hstepA = (size_t)HALF * LDA * 2, hstepB = (size_t)HALF * LDB * 2;
    constexpr size_t tstepA = 2 * hstepA, tstepB = 2 * hstepB;
    const unsigned ldsw = (unsigned)wid * 1024u;
    const int aoff = lds_byte(wr * 64 + fr, fq * 8), boff = lds_byte(wc * 32 + fr, fq * 8);
#define PG8_SA(b, h) (((b) * 2 + (h)) * HTB)
#define PG8_SB(b, h) ((4 + (b) * 2 + (h)) * HTB)
#define PG8_STAGE(bufoff, gbase, voff) do { _Pragma("unroll") for (int _i = 0; _i < 2; ++_i) \
        __builtin_amdgcn_global_load_lds((const unsigned*)((const char*)(gbase) + (voff)[_i]), (LAS unsigned*)(lds + (bufoff) + ldsw + _i * 8192), 16, 0, 0); } while (0)
#define PG8_LDA(dst, b, h) do { _Pragma("unroll") for (int m = 0; m < 4; ++m) _Pragma("unroll") for (int k = 0; k < 2; ++k) dst[m][k] = *(const LAS bf16x8*)(lds + PG8_SA(b, h) + aoff + m * 2048 + k * 1024); } while (0)
#define PG8_LDB(dst, b, h) do { _Pragma("unroll") for (int n = 0; n < 2; ++n) _Pragma("unroll") for (int k = 0; k < 2; ++k) dst[n][k] = *(const LAS bf16x8*)(lds + PG8_SB(b, h) + boff + n * 2048 + k * 1024); } while (0)
#define PG8_MMA(ai, bj, At, Bt) do { __builtin_amdgcn_s_setprio(1); _Pragma("unroll") for (int m = 0; m < 4; ++m) _Pragma("unroll") for (int n = 0; n < 2; ++n) _Pragma("unroll") for (int k = 0; k < 2; ++k) \
        acc[ai][bj][m][n] = __builtin_amdgcn_mfma_f32_16x16x32_bf16(Bt[n][k], At[m][k], acc[ai][bj][m][n], 0, 0, 0); __builtin_amdgcn_s_setprio(0); } while (0)
#define PG8_WAIT_V(n) asm volatile("s_waitcnt vmcnt(" #n ")" ::: "memory")
#define PG8_WAIT_L(n) asm volatile("s_waitcnt lgkmcnt(" #n ")" ::: "memory")
#define PG8_BAR __builtin_amdgcn_s_barrier()
#define PG8_SCHED __builtin_amdgcn_sched_barrier(0)
    Unit cur, nxt; int ui = 0;
    if (!next_unit<M, N, NZ, ZINNER>(0, G, c, cur)) return;
    f32x4 acc[2][2][4][2];
#pragma unroll
    for (int a = 0; a < 2; ++a)
#pragma unroll
        for (int b = 0; b < 2; ++b)
#pragma unroll
            for (int m = 0; m < 4; ++m)
#pragma unroll
                for (int n = 0; n < 2; ++n) acc[a][b][m][n] = (f32x4){0.f, 0.f, 0.f, 0.f};
    bf16x8 At[4][2], B0[2][2], B1[2][2];
    const char* cA = Abase + (size_t)cur.z * AZS + (size_t)cur.pm * tstepA; const char* cB = Bbase + (size_t)cur.z * BZS + (size_t)cur.pn * tstepB;
    PG8_STAGE(PG8_SB(0, 0), cB, voffB); PG8_STAGE(PG8_SB(0, 1), cB + hstepB, voffB); PG8_STAGE(PG8_SA(0, 0), cA, voffA); PG8_STAGE(PG8_SA(0, 1), cA + hstepA, voffA);
    if (wr == 1) PG8_BAR;
    PG8_WAIT_V(2); PG8_BAR;
    PG8_STAGE(PG8_SB(1, 0), cB + kstep, voffB); PG8_STAGE(PG8_SA(1, 0), cA + kstep, voffA); PG8_STAGE(PG8_SB(1, 1), cB + hstepB + kstep, voffB);
    PG8_WAIT_V(6); PG8_BAR;
    for (;;) {
        const bool has_next = next_unit<M, N, NZ, ZINNER>(ui + 1, G, c, nxt);
        const char* nA = has_next ? Abase + (size_t)nxt.z * AZS + (size_t)nxt.pm * tstepA : cA; const char* nB = has_next ? Bbase + (size_t)nxt.z * BZS + (size_t)nxt.pn * tstepB : cB;
#pragma nounroll
        for (int t = 0; t < nt; t += 2) {
            const bool last = (t == nt - 2);
            const char* a1 = cA + (size_t)(t + 1) * kstep;
            const char* a2 = last ? nA : cA + (size_t)(t + 2) * kstep; const char* b2 = last ? nB : cB + (size_t)(t + 2) * kstep;
            const char* a3 = a2 + kstep; const char* b3 = b2 + kstep;
            PG8_LDB(B0, 0, 0); PG8_LDB(B1, 0, 1); PG8_SCHED; PG8_LDA(At, 0, 0); PG8_STAGE(PG8_SA(1, 1), a1 + hstepA, voffA);
            PG8_WAIT_V(8); PG8_WAIT_L(0); PG8_BAR; PG8_MMA(0, 0, At, B0); PG8_MMA(0, 1, At, B1); PG8_BAR; PG8_SCHED;
            PG8_LDA(At, 0, 1); PG8_STAGE(PG8_SB(0, 0), b2, voffB); PG8_STAGE(PG8_SB(0, 1), b2 + hstepB, voffB); PG8_STAGE(PG8_SA(0, 0), a2, voffA);
            PG8_WAIT_V(8); PG8_WAIT_L(0); PG8_BAR; PG8_MMA(1, 0, At, B0); PG8_MMA(1, 1, At, B1); PG8_BAR; PG8_SCHED;
            PG8_LDB(B0, 1, 0); PG8_LDB(B1, 1, 1); PG8_SCHED; PG8_LDA(At, 1, 0); PG8_STAGE(PG8_SA(0, 1), a2 + hstepA, voffA);
            PG8_WAIT_V(8); PG8_WAIT_L(0); PG8_BAR; PG8_MMA(0, 0, At, B0); PG8_MMA(0, 1, At, B1); PG8_BAR; PG8_SCHED;
            PG8_LDA(At, 1, 1); PG8_STAGE(PG8_SB(1, 0), b3, voffB); PG8_STAGE(PG8_SB(1, 1), b3 + hstepB, voffB); PG8_STAGE(PG8_SA(1, 0), a3, voffA);
            PG8_WAIT_V(8); PG8_WAIT_L(0); PG8_BAR; PG8_MMA(1, 0, At, B0); PG8_MMA(1, 1, At, B1); PG8_BAR; PG8_SCHED;
        }
        if constexpr (ALIGN_EPI) { if (wr == 0) PG8_BAR; }
        E(acc, cur, wr, wc, fr, fq);
        if (!has_next) break;
        if (!(Epi::KEEP && cur.z + 1 < NZ)) {
#pragma unroll
        for (int a = 0; a < 2; ++a)
#pragma unroll
            for (int b = 0; b < 2; ++b)
#pragma unroll
                for (int m = 0; m < 4; ++m)
#pragma unroll
                    for (int n = 0; n < 2; ++n) acc[a][b][m][n] = (f32x4){0.f, 0.f, 0.f, 0.f};
        }
        cur = nxt; cA = nA; cB = nB; ++ui;
        if constexpr (ALIGN_EPI) { if (wr == 1) PG8_BAR; }
    }
    PG8_WAIT_V(0);
    if constexpr (!ALIGN_EPI) { if (wr == 0) PG8_BAR; }
    PG8_BAR;
#undef PG8_SA
#undef PG8_SB
#undef PG8_STAGE
#undef PG8_LDA
#undef PG8_LDB
#undef PG8_MMA
#undef PG8_WAIT_V
#undef PG8_WAIT_L
#undef PG8_BAR
#undef PG8_SCHED
}
}

namespace att {
constexpr int NW = 8, QBLK = 32, KVBLK = 64;
constexpr int SHM_T = KVBLK * 128 * 2;
#define KSWZ(row, colB) ((row) * 256 + ((colB) ^ (((row) & 7) << 4)))
#define SBAR() __builtin_amdgcn_sched_barrier(0)
__device__ __forceinline__ int crow(int r, int hi) { return (r & 3) + 8 * (r >> 2) + 4 * hi; }
__device__ __forceinline__ int v_st(int k, int c) { const int kk = (k & ~0xC) | ((k & 4) << 1) | ((k & 8) >> 1); return ((kk >> 3) * 4 + (c >> 5)) * 512 + ((kk & 7) * 32 + (c & 31)) * 2; }
__device__ __forceinline__ int v_rd_base(int lane) { return ((lane & 3) << 3) | (((lane >> 2) & 3) << 6) | (((lane >> 4) & 1) << 5) | (((lane >> 5) & 1) << 8); }
constexpr int v_rd_off(int d0, int ks, int half) { return d0 * 512 + ks * 4096 + half * 2048; }
template <int OFF> __device__ __forceinline__ s16x4 tr_read(int vb) {
    s16x4 r; asm volatile("ds_read_b64_tr_b16 %0, %1 offset:%2" : "=&v"(r) : "v"(vb), "i"(OFF) : "memory"); return r;
}
#define PKLH(L, H) (bf16x8){L[0], L[1], L[2], L[3], H[0], H[1], H[2], H[3]}
template <int D0> __device__ __forceinline__ void pv_one(f32x16& od, int vb, bf16x8 pa0, bf16x8 pa1, bf16x8 pa2, bf16x8 pa3) {
    const s16x4 l0 = tr_read<v_rd_off(D0, 0, 0)>(vb), h0 = tr_read<v_rd_off(D0, 0, 1)>(vb), l1 = tr_read<v_rd_off(D0, 1, 0)>(vb), h1 = tr_read<v_rd_off(D0, 1, 1)>(vb);
    const s16x4 l2 = tr_read<v_rd_off(D0, 2, 0)>(vb), h2 = tr_read<v_rd_off(D0, 2, 1)>(vb), l3 = tr_read<v_rd_off(D0, 3, 0)>(vb), h3 = tr_read<v_rd_off(D0, 3, 1)>(vb);
    asm volatile("s_waitcnt lgkmcnt(0)" ::: "memory"); SBAR();
    od = __builtin_amdgcn_mfma_f32_32x32x16_bf16(pa0, PKLH(l0, h0), od, 0, 0, 0);
    od = __builtin_amdgcn_mfma_f32_32x32x16_bf16(pa1, PKLH(l1, h1), od, 0, 0, 0);
    od = __builtin_amdgcn_mfma_f32_32x32x16_bf16(pa2, PKLH(l2, h2), od, 0, 0, 0);
    od = __builtin_amdgcn_mfma_f32_32x32x16_bf16(pa3, PKLH(l3, h3), od, 0, 0, 0);
}
__device__ __forceinline__ void pv_d0(f32x16* o, int vb, bf16x8 pa0, bf16x8 pa1, bf16x8 pa2, bf16x8 pa3) {
    pv_one<0>(o[0], vb, pa0, pa1, pa2, pa3); pv_one<1>(o[1], vb, pa0, pa1, pa2, pa3); pv_one<2>(o[2], vb, pa0, pa1, pa2, pa3); pv_one<3>(o[3], vb, pa0, pa1, pa2, pa3);
}
__device__ __forceinline__ void p_to_frags(const f32x16& p0, const f32x16& p1, bf16x8& pa0, bf16x8& pa1, bf16x8& pa2, bf16x8& pa3) {
#define PK4(P, BASE, OUT) do { unsigned a0 = cvt_pk_bf16(P[BASE + 0], P[BASE + 1]), a1 = cvt_pk_bf16(P[BASE + 2], P[BASE + 3]);   \
    unsigned b0 = cvt_pk_bf16(P[BASE + 4], P[BASE + 5]), b1 = cvt_pk_bf16(P[BASE + 6], P[BASE + 7]);                              \
    auto r0 = __builtin_amdgcn_permlane32_swap(a0, b0, false, false); auto r1 = __builtin_amdgcn_permlane32_swap(a1, b1, false, false); \
    u32x4 w = {r0[0], r1[0], r0[1], r1[1]}; OUT = *reinterpret_cast<bf16x8*>(&w); } while (0)
    PK4(p0, 0, pa0); PK4(p0, 8, pa1); PK4(p1, 0, pa2); PK4(p1, 8, pa3);
#undef PK4
}
template <int DQK> struct Cfg { static constexpr float SCALE = DQK == 128 ? 0.088388347648318440f : 0.072168783648703220f; static constexpr float THR = 8.f; };
template <int DQK>
__device__ __forceinline__ void partialSM(f32x16& p0, f32x16& p1, float& m_reg, float& mn, float& alpha) {
    constexpr float SCALE = Cfg<DQK>::SCALE, THR = Cfg<DQK>::THR;
    constexpr float C = SCALE * 1.4426950408889634f;
    float pmax = p0[0];
#pragma unroll
    for (int r = 1; r < 16; ++r) pmax = fmaxf(pmax, p0[r]);
#pragma unroll
    for (int r = 0; r < 16; ++r) pmax = fmaxf(pmax, p1[r]);
    { auto rr = __builtin_amdgcn_permlane32_swap(__float_as_uint(pmax), __float_as_uint(pmax), false, false);
      pmax = fmaxf(__uint_as_float(rr[0]), __uint_as_float(rr[1])); }
    if (__builtin_expect(__all(pmax - m_reg <= THR / SCALE), 1)) { mn = m_reg; alpha = 1.f; }
    else { mn = fmaxf(m_reg, pmax); alpha = __builtin_amdgcn_exp2f((m_reg - mn) * C); m_reg = mn; }
    float mnC = -mn * C;
#pragma unroll
    for (int r = 0; r < 16; ++r) p0[r] = fmaf(p0[r], C, mnC);
#pragma unroll
    for (int r = 0; r < 16; ++r) p1[r] = fmaf(p1[r], C, mnC);
#pragma unroll
    for (int r = 0; r < 16; ++r) p0[r] = __builtin_amdgcn_exp2f(p0[r]);
}
__device__ __forceinline__ void finishSM(f32x16& p0, f32x16& p1, float alpha, float& l_reg, bf16x8& pa0, bf16x8& pa1, bf16x8& pa2, bf16x8& pa3) {
#pragma unroll
    for (int r = 0; r < 16; ++r) p1[r] = __builtin_amdgcn_exp2f(p1[r]);
    float ps = 0;
#pragma unroll
    for (int r = 0; r < 16; ++r) ps += p0[r];
#pragma unroll
    for (int r = 0; r < 16; ++r) ps += p1[r];
    { auto rr = __builtin_amdgcn_permlane32_swap(__float_as_uint(ps), __float_as_uint(ps), false, false);
      ps = __uint_as_float(rr[0]) + __uint_as_float(rr[1]); }
    l_reg = l_reg * alpha + ps;
    p_to_frags(p0, p1, pa0, pa1, pa2, pa3);
}
template <int DQK>
__device__ __forceinline__ void qkt(f32x16& p0, f32x16& p1, const LAS char* Ks, const LAS char* Rs, const bf16x8* qr, int r32, int hi) {
    p0 = f32x16{}; p1 = f32x16{};
#pragma unroll
    for (int d0 = 0; d0 < 8; ++d0) { const int cb = (d0 * 16 + hi * 8) * 2;
        const bf16x8 b0 = *reinterpret_cast<const LAS bf16x8*>(Ks + KSWZ(r32, cb));
        const bf16x8 b1 = *reinterpret_cast<const LAS bf16x8*>(Ks + KSWZ(32 + r32, cb));
        p0 = __builtin_amdgcn_mfma_f32_32x32x16_bf16(b0, qr[d0], p0, 0, 0, 0);
        p1 = __builtin_amdgcn_mfma_f32_32x32x16_bf16(b1, qr[d0], p1, 0, 0, 0); }
    if constexpr (DQK == 192) {
#pragma unroll
        for (int d0 = 0; d0 < 4; ++d0) { const int cb = (d0 * 16 + hi * 8) * 2;
            const bf16x8 b0 = *reinterpret_cast<const LAS bf16x8*>(Rs + KSWZ(r32, cb));
            const bf16x8 b1 = *reinterpret_cast<const LAS bf16x8*>(Rs + KSWZ(32 + r32, cb));
            p0 = __builtin_amdgcn_mfma_f32_32x32x16_bf16(b0, qr[8 + d0], p0, 0, 0, 0);
            p1 = __builtin_amdgcn_mfma_f32_32x32x16_bf16(b1, qr[8 + d0], p1, 0, 0, 0); }
    }
}
template <int DQK> constexpr int attn_lds_bytes() { return 4 * SHM_T + (DQK == 192 ? 2 * SHM_T : 0) + NW * 64 * 4; }

template <int DQK, int LDQ, int LDK, int LDV, int LDO>
__device__ __forceinline__ void attn_body(const bf16_t* __restrict__ Qb, const bf16_t* __restrict__ Kh, const bf16_t* __restrict__ Rh, const bf16_t* __restrict__ Vh,
                                          bf16_t* __restrict__ Ob, int seq, LAS char* lds, const int tid) {
    constexpr int ND = DQK / 16;
    const int wid = tid >> 6, lane = tid & 63, r32 = lane & 31, hi = lane >> 5;
    LAS char* V_lds = lds; LAS char* K_lds = lds + 2 * SHM_T; LAS char* R_lds = lds + 4 * SHM_T;
    LAS float* wsl = (LAS float*)(lds + 4 * SHM_T + (DQK == 192 ? 2 * SHM_T : 0)) + wid * 64; LAS float* li_l = wsl; LAS float* al_l = wsl + 32;
    float m_reg = -1e30f, l_reg = 0; f32x16 o[4] = {}; bf16x8 qr[ND];
    const bf16_t* Qw = Qb + (long)(wid * QBLK + r32) * LDQ + hi * 8;
#pragma unroll
    for (int d0 = 0; d0 < ND; ++d0) qr[d0] = *reinterpret_cast<const bf16x8*>(Qw + d0 * 16);
    const int sr = tid >> 4, sc = (tid & 15) * 8, vst0 = v_st(sr, sc), vst1 = v_st(32 + sr, sc);
    const int rr = tid >> 3, rc = (tid & 7) * 8;
    const int vb0 = (int)(uintptr_t)V_lds + v_rd_base(lane);
    struct { bf16x8 vs0, vs1, ks0, ks1, rs; } sr_[2];
#define SLOAD(i, k0) do { sr_[i].vs0 = *reinterpret_cast<const bf16x8*>(&Vh[(long)((k0) + sr) * LDV + sc]); sr_[i].vs1 = *reinterpret_cast<const bf16x8*>(&Vh[(long)((k0) + 32 + sr) * LDV + sc]); \
    sr_[i].ks0 = *reinterpret_cast<const bf16x8*>(&Kh[(long)((k0) + sr) * LDK + sc]); sr_[i].ks1 = *reinterpret_cast<const bf16x8*>(&Kh[(long)((k0) + 32 + sr) * LDK + sc]); \
    if constexpr (DQK == 192) sr_[i].rs = *reinterpret_cast<const bf16x8*>(&Rh[(long)((k0) + rr) * 64 + rc]); } while (0)
#define SWRITE(b, i) do { *(LAS bf16x8*)(V_lds + (b) * SHM_T + vst0) = sr_[i].vs0; *(LAS bf16x8*)(V_lds + (b) * SHM_T + vst1) = sr_[i].vs1; const int kc = sc * 2; \
    *(LAS bf16x8*)(K_lds + (b) * SHM_T + KSWZ(sr, kc)) = sr_[i].ks0; *(LAS bf16x8*)(K_lds + (b) * SHM_T + KSWZ(32 + sr, kc)) = sr_[i].ks1; \
    if constexpr (DQK == 192) *(LAS bf16x8*)(R_lds + (b) * SHM_T + KSWZ(rr, rc * 2)) = sr_[i].rs; } while (0)
#define SWAIT() do { if constexpr (DQK == 192) asm volatile("s_waitcnt vmcnt(5)" ::: "memory"); else asm volatile("s_waitcnt vmcnt(4)" ::: "memory"); } while (0)
#define RESC(a) do { if (__any((a) < 1.f)) { if (hi == 0) al_l[r32] = (a); asm volatile("s_waitcnt lgkmcnt(0)" ::: "memory"); \
    _Pragma("unroll") for (int d = 0; d < 4; ++d) _Pragma("unroll") for (int r = 0; r < 16; ++r) o[d][r] *= al_l[crow(r, hi)]; } } while (0)
    f32x16 pA0, pA1, pB0, pB1; float mnA, mnB, alA, alB; bf16x8 pa0, pa1, pa2, pa3; const int NT = seq / KVBLK;
    constexpr int SE = 0, SO = 1;
    SLOAD(SE, 0); asm volatile("s_waitcnt vmcnt(0)" ::: "memory"); SWRITE(0, SE); __syncthreads();
    qkt<DQK>(pA0, pA1, K_lds, R_lds, qr, r32, hi); partialSM<DQK>(pA0, pA1, m_reg, mnA, alA);
    SLOAD(SO, KVBLK); if (2 < NT) SLOAD(SE, 2 * KVBLK);
    SWAIT(); SWRITE(1, SO); __syncthreads();
    for (int j = 1; j + 1 < NT; j += 2) {
        SBAR(); qkt<DQK>(pB0, pB1, K_lds + SHM_T, R_lds + SHM_T, qr, r32, hi);
        finishSM(pA0, pA1, alA, l_reg, pa0, pa1, pa2, pa3); SBAR();
        SLOAD(SO, (j + 2) * KVBLK); SBAR();
        pv_d0(o, vb0, pa0, pa1, pa2, pa3); partialSM<DQK>(pB0, pB1, m_reg, mnB, alB);
        __syncthreads(); SWAIT(); SWRITE(0, SE);
        RESC(alB); __syncthreads();
        SBAR(); qkt<DQK>(pA0, pA1, K_lds, R_lds, qr, r32, hi);
        finishSM(pB0, pB1, alB, l_reg, pa0, pa1, pa2, pa3); SBAR();
        if (j + 3 < NT) SLOAD(SE, (j + 3) * KVBLK); SBAR();
        pv_d0(o, vb0 + SHM_T, pa0, pa1, pa2, pa3); partialSM<DQK>(pA0, pA1, m_reg, mnA, alA);
        __syncthreads(); SWAIT(); SWRITE(1, SO);
        RESC(alA); __syncthreads();
    }
    SBAR(); qkt<DQK>(pB0, pB1, K_lds + SHM_T, R_lds + SHM_T, qr, r32, hi);
    finishSM(pA0, pA1, alA, l_reg, pa0, pa1, pa2, pa3); SBAR();
    pv_d0(o, vb0, pa0, pa1, pa2, pa3); partialSM<DQK>(pB0, pB1, m_reg, mnB, alB);
    __syncthreads(); RESC(alB);
    finishSM(pB0, pB1, alB, l_reg, pa0, pa1, pa2, pa3); SBAR();
    pv_d0(o, vb0 + SHM_T, pa0, pa1, pa2, pa3);
    if (hi == 0) li_l[r32] = l_reg; asm volatile("s_waitcnt lgkmcnt(0)" ::: "memory");
    float rli[16];
#pragma unroll
    for (int r = 0; r < 16; ++r) rli[r] = __builtin_amdgcn_rcpf(li_l[crow(r, hi)]);
    bf16_t* Ow = Ob + (long)(wid * QBLK) * LDO;
#pragma unroll
    for (int r = 0; r < 16; ++r) { const int orow = crow(r, hi);
#pragma unroll
        for (int d0 = 0; d0 < 4; ++d0) Ow[(long)orow * LDO + d0 * 32 + r32] = (bf16_t)(cvt_pk_bf16(o[d0][r] * rli[r], 0.f) & 0xffffu); }
    __syncthreads();
#undef SLOAD
#undef SWRITE
#undef SWAIT
#undef RESC
}
template <int DQK, int LDQ, int LDK, int LDV, int LDO>
__device__ __forceinline__ void attn_simple(const bf16_t* __restrict__ Qb, const bf16_t* __restrict__ Kh, const bf16_t* __restrict__ Rh, const bf16_t* __restrict__ Vh,
                                            bf16_t* __restrict__ Ob, int seq, LAS char* lds, const int tid) {
    constexpr int ND = DQK / 16;
    const int wid = tid >> 6, lane = tid & 63, r32 = lane & 31, hi = lane >> 5;
    LAS char* V_lds = lds; LAS char* K_lds = lds + 2 * SHM_T; LAS char* R_lds = lds + 4 * SHM_T;
    LAS float* wsl = (LAS float*)(lds + 4 * SHM_T + (DQK == 192 ? 2 * SHM_T : 0)) + wid * 64; LAS float* li_l = wsl; LAS float* al_l = wsl + 32;
    float m_reg = -1e30f, l_reg = 0; f32x16 o[4] = {}; bf16x8 qr[ND];
    const bf16_t* Qw = Qb + (long)(wid * QBLK + r32) * LDQ + hi * 8;
#pragma unroll
    for (int d0 = 0; d0 < ND; ++d0) qr[d0] = *reinterpret_cast<const bf16x8*>(Qw + d0 * 16);
    const int sr = tid >> 4, sc = (tid & 15) * 8, vst0 = v_st(sr, sc), vst1 = v_st(32 + sr, sc);
    const int rr = tid >> 3, rc = (tid & 7) * 8;
    const int vb0 = (int)(uintptr_t)V_lds + v_rd_base(lane);
    bf16x8 vs0, vs1, ks0, ks1, rs;
#define SLOAD(k0) do { vs0 = *reinterpret_cast<const bf16x8*>(&Vh[(long)((k0) + sr) * LDV + sc]); vs1 = *reinterpret_cast<const bf16x8*>(&Vh[(long)((k0) + 32 + sr) * LDV + sc]); \
    ks0 = *reinterpret_cast<const bf16x8*>(&Kh[(long)((k0) + sr) * LDK + sc]); ks1 = *reinterpret_cast<const bf16x8*>(&Kh[(long)((k0) + 32 + sr) * LDK + sc]); \
    if constexpr (DQK == 192) rs = *reinterpret_cast<const bf16x8*>(&Rh[(long)((k0) + rr) * 64 + rc]); } while (0)
#define SWRITE(b) do { *(LAS bf16x8*)(V_lds + (b) * SHM_T + vst0) = vs0; *(LAS bf16x8*)(V_lds + (b) * SHM_T + vst1) = vs1; const int kc = sc * 2; \
    *(LAS bf16x8*)(K_lds + (b) * SHM_T + KSWZ(sr, kc)) = ks0; *(LAS bf16x8*)(K_lds + (b) * SHM_T + KSWZ(32 + sr, kc)) = ks1; \
    if constexpr (DQK == 192) *(LAS bf16x8*)(R_lds + (b) * SHM_T + KSWZ(rr, rc * 2)) = rs; } while (0)
    const int NT = seq / KVBLK;
    SLOAD(0); asm volatile("s_waitcnt vmcnt(0)" ::: "memory"); SWRITE(0); __syncthreads();
    if (1 < NT) SLOAD(KVBLK);
    for (int j = 0; j < NT; ++j) {
        const int b = j & 1;
        f32x16 p0, p1; float mn, alpha; bf16x8 pa0, pa1, pa2, pa3;
        qkt<DQK>(p0, p1, K_lds + b * SHM_T, R_lds + b * SHM_T, qr, r32, hi);
        partialSM<DQK>(p0, p1, m_reg, mn, alpha);
        if (__any(alpha < 1.f)) { if (hi == 0) al_l[r32] = alpha; asm volatile("s_waitcnt lgkmcnt(0)" ::: "memory");
#pragma unroll
            for (int d = 0; d < 4; ++d)
#pragma unroll
                for (int r = 0; r < 16; ++r) o[d][r] *= al_l[crow(r, hi)]; }
        finishSM(p0, p1, alpha, l_reg, pa0, pa1, pa2, pa3);
        if (j + 1 < NT) SWRITE(b ^ 1);
        if (j + 2 < NT) SLOAD((j + 2) * KVBLK);
        pv_d0(o, vb0 + b * SHM_T, pa0, pa1, pa2, pa3);
        __syncthreads();
    }
    if (hi == 0) li_l[r32] = l_reg; asm volatile("s_waitcnt lgkmcnt(0)" ::: "memory");
    float rli[16];
#pragma unroll
    for (int r = 0; r < 16; ++r) rli[r] = __builtin_amdgcn_rcpf(li_l[crow(r, hi)]);
    bf16_t* Ow = Ob + (long)(wid * QBLK) * LDO;
#pragma unroll
    for (int r = 0; r < 16; ++r) { const int orow = crow(r, hi);
#pragma unroll
        for (int d0 = 0; d0 < 4; ++d0) Ow[(long)orow * LDO + d0 * 32 + r32] = (bf16_t)(cvt_pk_bf16(o[d0][r] * rli[r], 0.f) & 0xffffu); }
    __syncthreads();
#undef SLOAD
#undef SWRITE
}
#define RSWZ(row, colB) ((row) * 128 + ((colB) ^ ((((row) >> 1) & 7) << 4)))
template <int DQK>
__device__ __forceinline__ void qkt_dma(f32x16& p0, f32x16& p1, const LAS char* Ks, const LAS char* Rs, const bf16x8* qr, int r32, int hi) {
    p0 = f32x16{}; p1 = f32x16{};
#pragma unroll
    for (int d0 = 0; d0 < 8; ++d0) { const int cb = (d0 * 16 + hi * 8) * 2;
        const bf16x8 b0 = *reinterpret_cast<const LAS bf16x8*>(Ks + KSWZ(r32, cb));
        const bf16x8 b1 = *reinterpret_cast<const LAS bf16x8*>(Ks + KSWZ(32 + r32, cb));
        p0 = __builtin_amdgcn_mfma_f32_32x32x16_bf16(b0, qr[d0], p0, 0, 0, 0);
        p1 = __builtin_amdgcn_mfma_f32_32x32x16_bf16(b1, qr[d0], p1, 0, 0, 0); }
    if constexpr (DQK == 192) {
#pragma unroll
        for (int d0 = 0; d0 < 4; ++d0) { const int cb = (d0 * 16 + hi * 8) * 2;
            const bf16x8 b0 = *reinterpret_cast<const LAS bf16x8*>(Rs + RSWZ(r32, cb));
            const bf16x8 b1 = *reinterpret_cast<const LAS bf16x8*>(Rs + RSWZ(32 + r32, cb));
            p0 = __builtin_amdgcn_mfma_f32_32x32x16_bf16(b0, qr[8 + d0], p0, 0, 0, 0);
            p1 = __builtin_amdgcn_mfma_f32_32x32x16_bf16(b1, qr[8 + d0], p1, 0, 0, 0); }
    }
}
template <int DQK, int LDQ, int LDK, int LDV, int LDO>
__device__ __forceinline__ void attn_dma(const bf16_t* __restrict__ Qb, const bf16_t* __restrict__ Kh, const bf16_t* __restrict__ Rh, const bf16_t* __restrict__ Vh,
                                         bf16_t* __restrict__ Ob, int seq, LAS char* lds, LAS float* wscr, const int tid) {
    constexpr int ND = DQK / 16, KOFF = 0, VOFF = 3 * SHM_T, ROFF = 6 * SHM_T;
    const int wid = __builtin_amdgcn_readfirstlane(tid >> 6), lane = tid & 63, r32 = lane & 31, hi = lane >> 5;
    LAS float* li_l = wscr + wid * 64; LAS float* al_l = li_l + 32;
    float m_reg = -1e30f, l_reg = 0; f32x16 o[4] = {}; bf16x8 qr[ND];
    const bf16_t* Qw = Qb + (long)(wid * QBLK + r32) * LDQ + hi * 8;
#pragma unroll
    for (int d0 = 0; d0 < ND; ++d0) qr[d0] = *reinterpret_cast<const bf16x8*>(Qw + d0 * 16);
    unsigned voK[2], voV[2], voR;
#pragma unroll
    for (int i = 0; i < 2; ++i) { const int B = i * 8192 + wid * 1024 + lane * 16;
        { const int row = B >> 8, colB = (B & 255) ^ ((row & 7) << 4); voK[i] = (unsigned)(row * LDK * 2 + colB); }
        { const int sub = B >> 9, kk = (sub >> 2) * 8 + ((B & 511) >> 6), c = (sub & 3) * 32 + ((B & 63) >> 1); const int k = (kk & ~0xC) | ((kk & 4) << 1) | ((kk & 8) >> 1);
          voV[i] = (unsigned)((k * LDV + c) * 2); } }
    { const int B = wid * 1024 + lane * 16, row = B >> 7, colB = (B & 127) ^ (((row >> 1) & 7) << 4); voR = (unsigned)(row * 128 + colB); }
    const int vb0 = (int)(uintptr_t)lds + VOFF + v_rd_base(lane);
    const int NT = seq / KVBLK;
#define GLDS(gp, lp) __builtin_amdgcn_global_load_lds((const unsigned*)(gp), (LAS unsigned*)(lp), 16, 0, 0)
#define ISSUE(t, b) do { const char* kg_ = (const char*)Kh + (size_t)(t) * (KVBLK * LDK * 2); const char* vg_ = (const char*)Vh + (size_t)(t) * (KVBLK * LDV * 2); \
    LAS char* kl_ = lds + KOFF + (b) * SHM_T + wid * 1024; LAS char* vl_ = lds + VOFF + (b) * SHM_T + wid * 1024; \
    GLDS(kg_ + voK[0], kl_); GLDS(kg_ + voK[1], kl_ + 8192); GLDS(vg_ + voV[0], vl_); GLDS(vg_ + voV[1], vl_ + 8192); \
    if constexpr (DQK == 192) GLDS((const char*)Rh + (size_t)(t) * (KVBLK * 128) + voR, lds + ROFF + (b) * 8192 + wid * 1024); } while (0)
#define WAITV(n) asm volatile("s_waitcnt vmcnt(" #n ")" ::: "memory")
#define BARX() do { asm volatile("s_waitcnt lgkmcnt(0)" ::: "memory"); __builtin_amdgcn_s_barrier(); asm volatile("" ::: "memory"); SBAR(); } while (0)
#define RESC(a) do { if (__any((a) < 1.f)) { if (hi == 0) al_l[r32] = (a); asm volatile("s_waitcnt lgkmcnt(0)" ::: "memory"); \
    _Pragma("unroll") for (int d = 0; d < 4; ++d) _Pragma("unroll") for (int r = 0; r < 16; ++r) o[d][r] *= al_l[crow(r, hi)]; } } while (0)
    f32x16 pA0, pA1, pB0, pB1; float mnA, mnB, alA, alB; bf16x8 pa0, pa1, pa2, pa3;
    ISSUE(0, 0); ISSUE(1, 1); if (2 < NT) ISSUE(2, 2);
    if (2 < NT) { if constexpr (DQK == 192) WAITV(10); else WAITV(8); } else { if constexpr (DQK == 192) WAITV(5); else WAITV(4); }
    BARX();
    qkt_dma<DQK>(pA0, pA1, lds + KOFF, lds + ROFF, qr, r32, hi); partialSM<DQK>(pA0, pA1, m_reg, mnA, alA);
    if (2 < NT) { if constexpr (DQK == 192) WAITV(5); else WAITV(4); } else WAITV(0);
    BARX();
    int bp = 0, bc = 1;
#define STEP(j, C0, C1, mnC, alC, P0, P1, alP) do { \
    SBAR(); qkt_dma<DQK>(C0, C1, lds + KOFF + bc * SHM_T, lds + ROFF + bc * 8192, qr, r32, hi); \
    finishSM(P0, P1, alP, l_reg, pa0, pa1, pa2, pa3); SBAR(); \
    pv_d0(o, vb0 + bp * SHM_T, pa0, pa1, pa2, pa3); partialSM<DQK>(C0, C1, m_reg, mnC, alC); \
    WAITV(0); BARX(); \
    if ((j) + 2 < NT) ISSUE((j) + 2, bp); \
    RESC(alC); \
    bp = bc; bc = (bc == 2) ? 0 : bc + 1; } while (0)
    for (int j = 1; j + 1 < NT; j += 2) {
        STEP(j, pB0, pB1, mnB, alB, pA0, pA1, alA);
        STEP(j + 1, pA0, pA1, mnA, alA, pB0, pB1, alB);
    }
    STEP(NT - 1, pB0, pB1, mnB, alB, pA0, pA1, alA);
    finishSM(pB0, pB1, alB, l_reg, pa0, pa1, pa2, pa3); SBAR();
    pv_d0(o, vb0 + bp * SHM_T, pa0, pa1, pa2, pa3);
    if (hi == 0) li_l[r32] = l_reg; asm volatile("s_waitcnt lgkmcnt(0)" ::: "memory");
    float rli[16];
#pragma unroll
    for (int r = 0; r < 16; ++r) rli[r] = __builtin_amdgcn_rcpf(li_l[crow(r, hi)]);
    bf16_t* Ow = Ob + (long)(wid * QBLK) * LDO;
#pragma unroll
    for (int r = 0; r < 16; ++r) { const int orow = crow(r, hi);
#pragma unroll
        for (int d0 = 0; d0 < 4; ++d0) Ow[(long)orow * LDO + d0 * 32 + r32] = (bf16_t)(cvt_pk_bf16(o[d0][r] * rli[r], 0.f) & 0xffffu); }
    BARX();
#undef GLDS
#undef ISSUE
#undef WAITV
#undef BARX
#undef RESC
#undef STEP
}
}

struct Params {
    const float* in[32];
    float* out; unsigned char* ws;
    int ph_lo, ph_hi;
};
enum { I_XP = 0, I_XS, I_C, I_CAK, I_CAV, I_SRF, I_SRB, I_CCKV, I_CKR, I_CCTX, I_WMOD, I_BMOD, I_GPMIX, I_GPOMIX, I_GPMLP, I_GPOMLP, I_WIN, I_AQN, I_AKN, I_RDF, I_RDB, I_RGN,
       I_MQN, I_MKVN, I_WUQ, I_WUKV, I_WBA, I_WBB, I_WBC, I_WOUT, I_WUP, I_WDN };
constexpr size_t O_YP = 0, O_YS = 8388608, O_NAK = 25165824, O_NAV = O_NAK + 4194304, O_NRF = O_NAV + 4194304, O_NRB = O_NRF + 8388608, O_NCKV = O_NRB + 8388608, O_NKR = O_NCKV + 4194304, O_END = O_NKR + 1048576;

typedef const __attribute__((address_space(4))) Params CParams;
struct Ctx {
    LAS unsigned char* lds; int tid, lane, wave, bid, G;
    CParams* p;
};

struct TItem { const float* W; bf16_t* WT; int K, N, ldw, shift_from, shift; };
__device__ __forceinline__ void ti_load(f32x4 (&v)[8], const TItem& t, int item, int lane) {
    const int nblk = t.N / 32, kb = item / nblk, nb = item - kb * nblk, k0 = 64 * kb, n0 = 32 * nb;
    const float* p = t.W + (size_t)(k0 + (lane >> 3)) * t.N + n0 + (lane & 7) * 4;
#pragma unroll
    for (int i = 0; i < 8; ++i) v[i] = *(const f32x4*)(p + (size_t)(8 * i) * t.N);
}
__device__ __forceinline__ void ti_store(const f32x4 (&v)[8], const TItem& t, int item, int lane, LAS float* scr) {
    const int nblk = t.N / 32, kb = item / nblk, nb = item - kb * nblk, k0 = 64 * kb, n0 = 32 * nb;
#pragma unroll
    for (int i = 0; i < 8; ++i) { LAS float* s = scr + (8 * i + (lane >> 3)) * 33 + (lane & 7) * 4; s[0] = v[i][0]; s[1] = v[i][1]; s[2] = v[i][2]; s[3] = v[i][3]; }
    LDS_WAIT(); asm volatile("" ::: "memory");
    const int c = lane & 7; const int r0 = n0 + (n0 >= t.shift_from ? t.shift : 0);
#pragma unroll
    for (int j = 0; j < 4; ++j) { const int n = (lane >> 3) + 8 * j; const LAS float* s = scr + (8 * c) * 33 + n;
        u32x4 o; o.x = cvt_pk_bf16(s[0 * 33], s[1 * 33]); o.y = cvt_pk_bf16(s[2 * 33], s[3 * 33]); o.z = cvt_pk_bf16(s[4 * 33], s[5 * 33]); o.w = cvt_pk_bf16(s[6 * 33], s[7 * 33]);
        *(u32x4*)(t.WT + (size_t)(r0 + n) * t.ldw + k0 + 8 * c) = o; }
    LDS_WAIT(); asm volatile("" ::: "memory");
}
__device__ __forceinline__ TItem ti_decode(CParams& P, unsigned char* ws, int l, int& r) {
    constexpr int I_IN = 32 * 362, I_UQ = 8 * 48, I_UKV = 4 * 64, I_BR = 16 * 64, I_OUT = 32 * 64, I_UP = 32 * 256;
    if (r < I_IN) return TItem{P.in[I_WIN] + (size_t)l * 2048 * 11584, (bf16_t*)(ws + WS_WIN + l * SZ_WIN), 2048, 11584, LDH, 5440, 192}; r -= I_IN;
    if (r < I_UQ) return TItem{P.in[I_WUQ] + (size_t)l * 512 * 1536, (bf16_t*)(ws + WS_WUQ + l * SZ_WUQ), 512, 1536, 512, 1 << 30, 0}; r -= I_UQ;
    if (r < I_UKV) return TItem{P.in[I_WUKV] + (size_t)l * 256 * 2048, (bf16_t*)(ws + WS_WUKV + l * SZ_WUKV), 256, 2048, 256, 1 << 30, 0}; r -= I_UKV;
    if (r < 3 * I_BR) { const int z = r / I_BR; r -= z * I_BR; return TItem{P.in[I_WBA + z] + (size_t)l * 1024 * 2048, (bf16_t*)(ws + WS_WBR + (l * 3 + z) * SZ_WBR1), 1024, 2048, LDO, 1 << 30, 0}; } r -= 3 * I_BR;
    if (r < I_OUT) return TItem{P.in[I_WOUT] + (size_t)l * 2048 * 2048, (bf16_t*)(ws + WS_WOUT + l * SZ_WOUT), 2048, 2048, LDH, 1 << 30, 0}; r -= I_OUT;
    if (r < I_UP) return TItem{P.in[I_WUP] + (size_t)l * 2048 * 8192, (bf16_t*)(ws + WS_WUP + l * SZ_WUP), 2048, 8192, LDH, 1 << 30, 0}; r -= I_UP;
    return TItem{P.in[I_WDN] + (size_t)l * 8192 * 2048, (bf16_t*)(ws + WS_WDN + l * SZ_WDN), 8192, 2048, LDU, 1 << 30, 0};
}
__device__ __forceinline__ void convert_layer(const Ctx& F, const int l, const int b0, const int nb, const bool do_mod, const int it_lo, const int it_hi) {
    CParams& P = *F.p; unsigned char* ws = P.ws; const int bi = F.bid - b0;
    if (do_mod) {
        LAS float* sv = (LAS float*)F.lds;
        LAS float* red = (LAS float*)(F.lds + 32768);
        for (int i = F.tid; i < 3 * 2048; i += NTHR) { const int v = i >> 11, k = i & 2047; const float x = (v == 0) ? P.in[I_CCTX][k] : P.in[I_C][(v - 1) * 2048 + k]; sv[i] = siluf_(x); }
        __syncthreads();
        float* MOD = (float*)(ws + WS_MOD);
        const int c4 = F.tid & 15, kq = F.tid >> 4;
        for (int cg = bi; cg < 192; cg += nb) {
            const float* w = P.in[I_WMOD] + (size_t)l * 2048 * 12288 + cg * 64 + c4 * 4;
            f32x4 a0 = {0, 0, 0, 0}, a1 = a0, a2 = a0;
#pragma unroll 8
            for (int kk = 0; kk < 64; ++kk) { const int k = kq + 32 * kk; const f32x4 wv = *(const f32x4*)(w + (size_t)k * 12288);
                a0 += wv * sv[k]; a1 += wv * sv[2048 + k]; a2 += wv * sv[4096 + k]; }
#pragma unroll
            for (int j = 0; j < 4; ++j) { red[(kq * 3 + 0) * 64 + c4 * 4 + j] = a0[j]; red[(kq * 3 + 1) * 64 + c4 * 4 + j] = a1[j]; red[(kq * 3 + 2) * 64 + c4 * 4 + j] = a2[j]; }
            __syncthreads();
            if (F.tid < 192) { const int v = F.tid >> 6, col = F.tid & 63; float s = 0.f;
#pragma unroll 8
                for (int q = 0; q < 32; ++q) s += red[(q * 3 + v) * 64 + col];
                MOD[((size_t)l * 3 + v) * 12288 + cg * 64 + col] = s + P.in[I_BMOD][(size_t)l * 12288 + cg * 64 + col]; }
            __syncthreads();
        }
    }
    {
        LAS float* scr = (LAS float*)(F.lds + F.wave * 16384);
        const int gw = bi * NWAVES + F.wave, NGW = nb * NWAVES;
        const int PER_L = it_hi;
        f32x4 va[8], vb[8], vc[8];
#define TI_LOAD(buf, itx) do { if ((itx) < PER_L) { int r_ = (itx); const TItem t_ = ti_decode(P, ws, l, r_); ti_load(buf, t_, r_, F.lane); } } while (0)
#define TI_STORE(buf, itx) do { if ((itx) < PER_L) { int r_ = (itx); const TItem t_ = ti_decode(P, ws, l, r_); ti_store(buf, t_, r_, F.lane, scr); } } while (0)
        TI_LOAD(va, it_lo + gw); TI_LOAD(vb, it_lo + gw + NGW);
        for (int it = it_lo + gw; it < PER_L; it += 3 * NGW) {
            TI_LOAD(vc, it + 2 * NGW); TI_STORE(va, it);
            TI_LOAD(va, it + 3 * NGW); TI_STORE(vb, it + NGW);
            TI_LOAD(vb, it + 4 * NGW); TI_STORE(vc, it + 2 * NGW);
        }
#undef TI_LOAD
#undef TI_STORE
    }
}

struct NRow { f32x4 x[8]; u32x2 pa[8], pb[8]; };
__device__ __forceinline__ void nrow_load(NRow& R, int r, int lane, const float* xin_ctx, const float* xin_lat, const bf16_t* o0, const bf16_t* o1) {
    const float* xr = r < NCTX ? xin_ctx + (size_t)r * DM : xin_lat + (size_t)(r - NCTX) * DM;
#pragma unroll
    for (int j = 0; j < 8; ++j) R.x[j] = *(const f32x4*)(xr + (lane + 64 * j) * 4);
    if (o0) {
#pragma unroll
        for (int j = 0; j < 8; ++j) { R.pa[j] = *(const u32x2*)(o0 + (size_t)r * DM + (lane + 64 * j) * 4); R.pb[j] = *(const u32x2*)(o1 + (size_t)r * DM + (lane + 64 * j) * 4); }
    }
}
__device__ __forceinline__ void norm_phase(const Ctx& F, const float* xin_ctx, const float* xin_lat, const bf16_t* o0, const bf16_t* o1, float* X, bf16_t* H,
                                           const float* modA, int gate_off, const float* gA, const float* modB, int scale_off, int shift_off, const float* gB) {
    const int gw = F.bid * NWAVES + F.wave, NGW = F.G * NWAVES;
    NRow cur, nxt;
    if (gw < NTOK) nrow_load(cur, gw, F.lane, xin_ctx, xin_lat, o0, o1);
    for (int r = gw; r < NTOK; r += NGW) {
        if (r + NGW < NTOK) nrow_load(nxt, r + NGW, F.lane, xin_ctx, xin_lat, o0, o1);
        const int v = r < NCTX ? 0 : 1 + ((r - NCTX) >> 12);
        f32x4 x[8];
#pragma unroll
        for (int j = 0; j < 8; ++j) x[j] = cur.x[j];
        if (o0) {
            f32x4 o[8]; float ss = 0.f;
#pragma unroll
            for (int j = 0; j < 8; ++j) { const u32x2 pa = cur.pa[j], pb = cur.pb[j];
                o[j] = (f32x4){bf_lo(pa.x) + bf_lo(pb.x), bf_hi(pa.x) + bf_hi(pb.x), bf_lo(pa.y) + bf_lo(pb.y), bf_hi(pa.y) + bf_hi(pb.y)};
                ss += (o[j][0] * o[j][0] + o[j][1] * o[j][1]) + (o[j][2] * o[j][2] + o[j][3] * o[j][3]); }
            const float rs = 1.0f / sqrtf(wave_sum(ss) * (1.0f / DM) + EPS);
#pragma unroll
            for (int j = 0; j < 8; ++j) { const int c = (F.lane + 64 * j) * 4; const f32x4 ga = *(const f32x4*)(gA + c), gt = *(const f32x4*)(modA + (size_t)v * 12288 + gate_off + c);
                x[j] += gt * (o[j] * rs * ga); }
        }
        if (X) {
#pragma unroll
            for (int j = 0; j < 8; ++j) *(f32x4*)(X + (size_t)r * DM + (F.lane + 64 * j) * 4) = x[j]; }
        if (gB) {
            float ss = 0.f;
#pragma unroll
            for (int j = 0; j < 8; ++j) ss += (x[j][0] * x[j][0] + x[j][1] * x[j][1]) + (x[j][2] * x[j][2] + x[j][3] * x[j][3]);
            const float rs = 1.0f / sqrtf(wave_sum(ss) * (1.0f / DM) + EPS);
#pragma unroll
            for (int j = 0; j < 8; ++j) { const int c = (F.lane + 64 * j) * 4; const f32x4 gb = *(const f32x4*)(gB + c);
                const f32x4 sc = *(const f32x4*)(modB + (size_t)v * 12288 + scale_off + c), sh = *(const f32x4*)(modB + (size_t)v * 12288 + shift_off + c);
                const f32x4 h = (x[j] * rs * gb) * (sc + 1.0f) + sh;
                u32x2 w; w.x = cvt_pk_bf16(h[0], h[1]); w.y = cvt_pk_bf16(h[2], h[3]);
                *(u32x2*)(H + (size_t)r * LDH + c) = w; }
        }
        cur = nxt;
    }
}

struct RopeCS { float c0, s0, c1, s1; };
__device__ __forceinline__ RopeCS rope_cs128(int lane, int prow, int pcol) {
    const int i0 = (2 * lane) & 31; const float pos = (float)((lane >> 5) ? pcol : prow);
    const float r0 = pos * __builtin_amdgcn_exp2f(-(float)i0 * (13.287712379549449f / 32.0f)) * 0.15915494309189535f;
    const float r1 = pos * __builtin_amdgcn_exp2f(-(float)(i0 + 1) * (13.287712379549449f / 32.0f)) * 0.15915494309189535f;
    RopeCS t; t.c0 = __builtin_amdgcn_cosf(r0); t.s0 = __builtin_amdgcn_sinf(r0); t.c1 = __builtin_amdgcn_cosf(r1); t.s1 = __builtin_amdgcn_sinf(r1);
    if ((lane & 16) == 0) { t.s0 = -t.s0; t.s1 = -t.s1; }
    return t;
}
__device__ __forceinline__ RopeCS rope_cs64(int g, int prow, int pcol) {
    const int i0 = (2 * g) & 15; const float pos = (float)((g >> 4) ? pcol : prow);
    const float r0 = pos * __builtin_amdgcn_exp2f(-(float)i0 * (13.287712379549449f / 16.0f)) * 0.15915494309189535f;
    const float r1 = pos * __builtin_amdgcn_exp2f(-(float)(i0 + 1) * (13.287712379549449f / 16.0f)) * 0.15915494309189535f;
    RopeCS t; t.c0 = __builtin_amdgcn_cosf(r0); t.s0 = __builtin_amdgcn_sinf(r0); t.c1 = __builtin_amdgcn_cosf(r1); t.s1 = __builtin_amdgcn_sinf(r1);
    if ((g & 8) == 0) { t.s0 = -t.s0; t.s1 = -t.s1; }
    return t;
}
__device__ __forceinline__ void rope128(float& y0, float& y1, const RopeCS& t) { const float p0 = swz_xor<16>(y0), p1 = swz_xor<16>(y1); y0 = y0 * t.c0 + p0 * t.s0; y1 = y1 * t.c1 + p1 * t.s1; }
__device__ __forceinline__ void rope64(float& y0, float& y1, const RopeCS& t) { const float p0 = swz_xor<8>(y0), p1 = swz_xor<8>(y1); y0 = y0 * t.c0 + p0 * t.s0; y1 = y1 * t.c1 + p1 * t.s1; }
struct PPRow { unsigned uq[10], uv[2], ub[8], ukr; u32x4 ucq; u32x2 ukv; };
__device__ __forceinline__ void pp_load(PPRow& R, const unsigned* P32, int lane) {
#pragma unroll
    for (int hd = 0; hd < 10; ++hd) R.uq[hd] = P32[hd * 64 + lane];
#pragma unroll
    for (int j = 0; j < 2; ++j) R.uv[j] = P32[C_AV / 2 + j * 64 + lane];
#pragma unroll
    for (int hd = 0; hd < 8; ++hd) R.ub[hd] = P32[C_BQ / 2 + hd * 64 + lane];
    R.ucq = *(const u32x4*)(P32 + C_CQL / 2 + 4 * lane); R.ukv = *(const u32x2*)(P32 + C_CKV / 2 + 2 * lane); R.ukr = P32[C_CKR / 2 + (lane & 31)];
}
template <bool DRY>
__device__ __forceinline__ void phase_postproj(const Ctx& F, int l) {
    CParams& P = *F.p; unsigned char* ws = P.ws;
    bf16_t* PROJ = (bf16_t*)(ws + WS_PROJ); bf16_t* KA = (bf16_t*)(ws + WS_KA); bf16_t* VA = (bf16_t*)(ws + WS_VA); bf16_t* CKV = (bf16_t*)(ws + WS_CKV); bf16_t* KR = (bf16_t*)(ws + WS_KROPE);
    const int gw = F.bid * NWAVES + F.wave, NGW = F.G * NWAVES, lane = F.lane;
    const f32x2 qn = *(const f32x2*)(P.in[I_AQN] + l * 128 + 2 * lane), kn = *(const f32x2*)(P.in[I_AKN] + l * 128 + 2 * lane);
    const f32x4 mq0 = *(const f32x4*)(P.in[I_MQN] + l * 512 + 8 * lane), mq1 = *(const f32x4*)(P.in[I_MQN] + l * 512 + 8 * lane + 4), mkv = *(const f32x4*)(P.in[I_MKVN] + l * 256 + 4 * lane);
    PPRow cur, nxt;
    if (gw < NTOK) pp_load(cur, (const unsigned*)(PROJ + (size_t)gw * LDP), lane);
    for (int r = gw; r < NTOK; r += NGW) {
        if (r + NGW < NTOK) pp_load(nxt, (const unsigned*)(PROJ + (size_t)(r + NGW) * LDP), lane);
        const bool lat = r >= NCTX; const int lr = r - NCTX, b = lr >> 12, n = lr & 4095, prow = n >> 6, pcol = n & 63;
        const int arow = lat ? NCTX + b * KVL + n : r;
        const int cb = r >> 8, cs = r & 255;
        unsigned* P32 = DRY ? (unsigned*)((bf16_t*)(ws + WS_PART) + (size_t)r * 5632) : (unsigned*)(PROJ + (size_t)r * LDP);
        RopeCS t128, t64;
        if (lat) { t128 = rope_cs128(lane, prow, pcol); t64 = rope_cs64(lane & 31, prow, pcol); }
        float y0[10], y1[10], ss[10];
#pragma unroll
        for (int hd = 0; hd < 10; ++hd) { y0[hd] = bf_lo(cur.uq[hd]); y1[hd] = bf_hi(cur.uq[hd]); ss[hd] = y0[hd] * y0[hd] + y1[hd] * y1[hd]; }
#pragma unroll
        for (int hd = 0; hd < 10; ++hd) ss[hd] = wave_sum(ss[hd]);
#pragma unroll
        for (int hd = 0; hd < 10; ++hd) {
            const float rs = 1.0f / sqrtf(ss[hd] * (1.0f / 128.0f) + EPS); const f32x2 gn = hd < 8 ? qn : kn;
            float a0 = y0[hd] * rs * gn[0], a1 = y1[hd] * rs * gn[1];
            if (lat) rope128(a0, a1, t128);
            if (hd < 8) P32[hd * 64 + lane] = cvt_pk_bf16(a0, a1);
            else { const int kvh = hd - 8; ((unsigned*)(KA + (size_t)arow * 256))[kvh * 64 + lane] = cvt_pk_bf16(a0, a1);
                if (!lat) *(f32x2*)(P.out + O_NAK + (((size_t)cb * 4 + l) * 256 + cs) * 256 + kvh * 128 + 2 * lane) = (f32x2){a0, a1}; }
        }
#pragma unroll
        for (int j = 0; j < 2; ++j) { const unsigned u = cur.uv[j]; ((unsigned*)(VA + (size_t)arow * 256))[j * 64 + lane] = u;
            if (!lat) *(f32x2*)(P.out + O_NAV + (((size_t)cb * 4 + l) * 256 + cs) * 256 + j * 128 + 2 * lane) = (f32x2){bf_lo(u), bf_hi(u)}; }
#pragma unroll
        for (int hd = 0; hd < 8; ++hd) {
            if (!lat && hd < 4) continue;
            float a0 = bf_lo(cur.ub[hd]), a1 = bf_hi(cur.ub[hd]);
            if (lat) rope128(a0, a1, t128);
            if (hd >= 4) { a0 *= 0.08838834764831845f; a1 *= 0.08838834764831845f; }
            P32[C_BQ / 2 + hd * 64 + lane] = cvt_pk_bf16(a0, a1);
        }
        { u32x4 u = cur.ucq;
          float y[8] = {bf_lo(u.x), bf_hi(u.x), bf_lo(u.y), bf_hi(u.y), bf_lo(u.z), bf_hi(u.z), bf_lo(u.w), bf_hi(u.w)}; float s2 = 0.f;
#pragma unroll
          for (int i = 0; i < 8; ++i) s2 += y[i] * y[i];
          const float rs = 1.0f / sqrtf(wave_sum(s2) * (1.0f / 512.0f) + EPS);
          u.x = cvt_pk_bf16(y[0] * rs * mq0[0], y[1] * rs * mq0[1]); u.y = cvt_pk_bf16(y[2] * rs * mq0[2], y[3] * rs * mq0[3]);
          u.z = cvt_pk_bf16(y[4] * rs * mq1[0], y[5] * rs * mq1[1]); u.w = cvt_pk_bf16(y[6] * rs * mq1[2], y[7] * rs * mq1[3]);
          *(u32x4*)(P32 + C_CQL / 2 + 4 * lane) = u; }
        { const u32x2 u = cur.ukv;
          float y[4] = {bf_lo(u.x), bf_hi(u.x), bf_lo(u.y), bf_hi(u.y)};
          const float rs = 1.0f / sqrtf(wave_sum((y[0] * y[0] + y[1] * y[1]) + (y[2] * y[2] + y[3] * y[3])) * (1.0f / 256.0f) + EPS);
#pragma unroll
          for (int i = 0; i < 4; ++i) y[i] *= rs * mkv[i];
          u32x2 w; w.x = cvt_pk_bf16(y[0], y[1]); w.y = cvt_pk_bf16(y[2], y[3]);
          *(u32x2*)(CKV + (size_t)arow * 256 + 4 * lane) = w;
          if (!lat) *(f32x4*)(P.out + O_NCKV + (((size_t)cb * 4 + l) * 256 + cs) * 256 + 4 * lane) = (f32x4){y[0], y[1], y[2], y[3]}; }
        { float a0 = bf_lo(cur.ukr), a1 = bf_hi(cur.ukr);
          if (lat) rope64(a0, a1, t64);
          if (lane < 32) { ((unsigned*)(KR + (size_t)arow * 64))[lane] = cvt_pk_bf16(a0, a1);
              if (!lat) *(f32x2*)(P.out + O_NKR + (((size_t)cb * 4 + l) * 256 + cs) * 64 + 2 * lane) = (f32x2){a0, a1}; } }
        cur = nxt;
    }
    for (int r = gw; r < 1024; r += NGW) {
        const int b = r >> 9, j = r & 511; const size_t arow = NCTX + (size_t)b * KVL + 4096 + j; const size_t src = ((size_t)b * 4 + l) * 512 + j;
        { const f32x4 k = *(const f32x4*)(P.in[I_CAK] + src * 256 + 4 * lane), v = *(const f32x4*)(P.in[I_CAV] + src * 256 + 4 * lane), c = *(const f32x4*)(P.in[I_CCKV] + src * 256 + 4 * lane);
          u32x2 w; w.x = cvt_pk_bf16(k[0], k[1]); w.y = cvt_pk_bf16(k[2], k[3]); *(u32x2*)(KA + arow * 256 + 4 * lane) = w;
          w.x = cvt_pk_bf16(v[0], v[1]); w.y = cvt_pk_bf16(v[2], v[3]); *(u32x2*)(VA + arow * 256 + 4 * lane) = w;
          w.x = cvt_pk_bf16(c[0], c[1]); w.y = cvt_pk_bf16(c[2], c[3]); *(u32x2*)(CKV + arow * 256 + 4 * lane) = w; }
        if (lane < 16) { const f32x4 k = *(const f32x4*)(P.in[I_CKR] + src * 64 + 4 * lane); u32x2 w; w.x = cvt_pk_bf16(k[0], k[1]); w.y = cvt_pk_bf16(k[2], k[3]); *(u32x2*)(KR + arow * 64 + 4 * lane) = w; }
    }
}

__device__ __forceinline__ float log_sigmoid_(float x) { return -__logf(1.0f + __expf(-x)); }
template <int SCALE_MODE>
__device__ __forceinline__ void stage_vtile(LAS char* dst, const bf16_t* src, int ld, int tid, float lg2, int jbase) {
#pragma unroll
    for (int i = 0; i < 2; ++i) { const int p = tid + 512 * i, k = p >> 4, c8 = (p & 15) * 8;
        u32x4 u = *(const u32x4*)(src + (size_t)k * ld + c8);
        if (SCALE_MODE != 0) { const float jj = (float)(jbase + k); const float f = __builtin_amdgcn_exp2f(lg2 * (SCALE_MODE == 1 ? (127.0f - jj) : jj));
            u.x = cvt_pk_bf16(bf_lo(u.x) * f, bf_hi(u.x) * f); u.y = cvt_pk_bf16(bf_lo(u.y) * f, bf_hi(u.y) * f); u.z = cvt_pk_bf16(bf_lo(u.z) * f, bf_hi(u.z) * f); u.w = cvt_pk_bf16(bf_lo(u.w) * f, bf_hi(u.w) * f); }
        *(LAS u32x4*)(dst + att::v_st(k, c8)) = u; }
}
__device__ __forceinline__ void ret_kv_unit(const Ctx& F, int l, int u) {
    CParams& P = *F.p; unsigned char* ws = P.ws;
    const int c = u >> 2, h = u & 3, row0 = c * 128, tid = F.tid, lane = F.lane, w = F.wave;
    const bf16_t* PROJ = (const bf16_t*)(ws + WS_PROJ);
    const float lgf2 = log_sigmoid_(P.in[I_RDF][l * 4 + h]) * 1.4426950408889634f, lgb2 = log_sigmoid_(P.in[I_RDB][l * 4 + h]) * 1.4426950408889634f;
    LAS char* lds = (LAS char*)F.lds;
#pragma nounroll
    for (int jt = 0; jt < 2; ++jt) {
        const bf16_t* ksrc = PROJ + (size_t)(row0 + jt * 64) * LDP + C_BK + h * 128;
        stage_vtile<1>(lds + jt * 16384, ksrc, LDP, tid, lgf2, jt * 64);
        stage_vtile<2>(lds + 32768 + jt * 16384, ksrc, LDP, tid, lgb2, jt * 64);
#pragma nounroll
        for (int eh = 0; eh < 2; ++eh) stage_vtile<0>(lds + 65536 + (jt * 2 + eh) * 16384, PROJ + (size_t)(row0 + jt * 64) * LDP + C_BV + h * 256 + eh * 128, LDP, tid, 0.f, 0);
    }
    __syncthreads();
    const int dblk = w & 3, eh = w >> 2;
    f32x16 accF[4] = {}, accB[4] = {};
#pragma nounroll
    for (int jt = 0; jt < 2; ++jt) {
        const int vbF = (int)(uintptr_t)lds + jt * 16384 + att::v_rd_base(lane) + dblk * 512, vbB = 32768 + vbF, vbV = 65536 + (jt * 2 + eh) * 16384 + att::v_rd_base(lane);
#define KVSTEP(KS) do { \
        const s16x4 fl = att::tr_read<att::v_rd_off(0, KS, 0)>(vbF), fh = att::tr_read<att::v_rd_off(0, KS, 1)>(vbF), bl = att::tr_read<att::v_rd_off(0, KS, 0)>(vbB), bh = att::tr_read<att::v_rd_off(0, KS, 1)>(vbB); \
        const s16x4 v0l = att::tr_read<att::v_rd_off(0, KS, 0)>(vbV), v0h = att::tr_read<att::v_rd_off(0, KS, 1)>(vbV), v1l = att::tr_read<att::v_rd_off(1, KS, 0)>(vbV), v1h = att::tr_read<att::v_rd_off(1, KS, 1)>(vbV); \
        const s16x4 v2l = att::tr_read<att::v_rd_off(2, KS, 0)>(vbV), v2h = att::tr_read<att::v_rd_off(2, KS, 1)>(vbV), v3l = att::tr_read<att::v_rd_off(3, KS, 0)>(vbV), v3h = att::tr_read<att::v_rd_off(3, KS, 1)>(vbV); \
        asm volatile("s_waitcnt lgkmcnt(0)" ::: "memory"); SBAR(); \
        const bf16x8 af = PKLH(fl, fh), ab = PKLH(bl, bh), b0 = PKLH(v0l, v0h), b1 = PKLH(v1l, v1h), b2 = PKLH(v2l, v2h), b3 = PKLH(v3l, v3h); \
        accF[0] = __builtin_amdgcn_mfma_f32_32x32x16_bf16(af, b0, accF[0], 0, 0, 0); accB[0] = __builtin_amdgcn_mfma_f32_32x32x16_bf16(ab, b0, accB[0], 0, 0, 0); \
        accF[1] = __builtin_amdgcn_mfma_f32_32x32x16_bf16(af, b1, accF[1], 0, 0, 0); accB[1] = __builtin_amdgcn_mfma_f32_32x32x16_bf16(ab, b1, accB[1], 0, 0, 0); \
        accF[2] = __builtin_amdgcn_mfma_f32_32x32x16_bf16(af, b2, accF[2], 0, 0, 0); accB[2] = __builtin_amdgcn_mfma_f32_32x32x16_bf16(ab, b2, accB[2], 0, 0, 0); \
        accF[3] = __builtin_amdgcn_mfma_f32_32x32x16_bf16(af, b3, accF[3], 0, 0, 0); accB[3] = __builtin_amdgcn_mfma_f32_32x32x16_bf16(ab, b3, accB[3], 0, 0, 0); } while (0)
        KVSTEP(0); KVSTEP(1); KVSTEP(2); KVSTEP(3);
#undef KVSTEP
    }
    float* RKV = (float*)(ws + WS_RKV) + ((size_t)(c * 4 + h) * 2) * RET_ST;
    const int r32 = lane & 31, hi = lane >> 5;
#pragma unroll
    for (int r = 0; r < 16; ++r) { const int d = dblk * 32 + att::crow(r, hi);
#pragma unroll
        for (int eb = 0; eb < 4; ++eb) { const int e = eh * 128 + eb * 32 + r32; RKV[(size_t)d * 256 + e] = accF[eb][r]; RKV[RET_ST + (size_t)d * 256 + e] = accB[eb][r]; } }
    __syncthreads();
}
__device__ __forceinline__ void phase_scan(const Ctx& F, int l, bool do_rope) {
    CParams& P = *F.p; unsigned char* ws = P.ws;
    float* RKV = (float*)(ws + WS_RKV); bf16_t* RS = (bf16_t*)(ws + WS_RS);
    for (int it = F.bid; it < 2304; it += F.G) {
        const bool lat = it < 256; const int q = lat ? it : it - 256; const int combo = q >> 4, slab = q & 15;
        const int dir = combo & 1, h = (combo >> 1) & 3, sb = combo >> 3; const size_t e0 = (size_t)slab * 2048 + F.tid * 4;
        const float cd = __expf(128.0f * log_sigmoid_(P.in[dir ? I_RDB : I_RDF][l * 4 + h]));
        if (lat) {
            f32x4 s = *(const f32x4*)(P.in[dir ? I_SRB : I_SRF] + (((size_t)sb * 4 + l) * 4 + h) * RET_ST + e0);
#pragma nounroll
            for (int t0 = 0; t0 < 32; t0 += 8) { f32x4 kv[8];
#pragma unroll
                for (int q = 0; q < 8; ++q) { const int n = dir ? 31 - (t0 + q) : (t0 + q); kv[q] = *(const f32x4*)(RKV + ((size_t)((32 + sb * 32 + n) * 4 + h) * 2 + dir) * RET_ST + e0); }
#pragma unroll
                for (int q = 0; q < 8; ++q) { const int n = dir ? 31 - (t0 + q) : (t0 + q); const size_t base = ((size_t)((32 + sb * 32 + n) * 4 + h) * 2 + dir) * RET_ST + e0;
                    u32x2 w; w.x = cvt_pk_bf16(s[0], s[1]); w.y = cvt_pk_bf16(s[2], s[3]); *(u32x2*)(RS + base) = w;
                    s = s * cd + kv[q]; } }
        } else {
            f32x4 s = {0.f, 0.f, 0.f, 0.f};
#pragma unroll
            for (int t = 0; t < 2; ++t) { const int n = dir ? 1 - t : t; const size_t base = ((size_t)((sb * 2 + n) * 4 + h) * 2 + dir) * RET_ST + e0;
                u32x2 w; w.x = cvt_pk_bf16(s[0], s[1]); w.y = cvt_pk_bf16(s[2], s[3]); *(u32x2*)(RS + base) = w;
                s = s * cd + *(const f32x4*)(RKV + base); }
            *(f32x4*)(P.out + (dir ? O_NRB : O_NRF) + (((size_t)sb * 4 + l) * 4 + h) * RET_ST + e0) = s;
        }
    }
    bf16_t* CQ = (bf16_t*)(ws + WS_CQ);
    const int gw = F.bid * NWAVES + F.wave, NGW = F.G * NWAVES, lane = F.lane;
    if (do_rope) for (int r = NCTX + gw; r < NTOK; r += NGW) {
        const int n = (r - NCTX) & 4095, prow = n >> 6, pcol = n & 63; const RopeCS t64 = rope_cs64(lane & 31, prow, pcol);
        unsigned uu[4];
#pragma unroll
        for (int j = 0; j < 4; ++j) uu[j] = *((const unsigned*)(CQ + (size_t)r * LDCQ + ((lane >> 5) + 2 * j) * 192 + 128) + (lane & 31));
#pragma unroll
        for (int j = 0; j < 4; ++j) { float y0 = bf_lo(uu[j]), y1 = bf_hi(uu[j]); rope64(y0, y1, t64); *((unsigned*)(CQ + (size_t)r * LDCQ + ((lane >> 5) + 2 * j) * 192 + 128) + (lane & 31)) = cvt_pk_bf16(y0, y1); }
    }
}
__device__ __forceinline__ void ret_out_unit(const Ctx& F, int l, int u) {
    CParams& P = *F.p; unsigned char* ws = P.ws;
    const int c = u >> 2, h = u & 3, row0 = c * 128, tid = F.tid, lane = F.lane, w = F.wave, r32 = lane & 31, hi = lane >> 5;
    const bf16_t* PROJ = (const bf16_t*)(ws + WS_PROJ); const bf16_t* RS = (const bf16_t*)(ws + WS_RS) + ((size_t)(c * 4 + h) * 2) * RET_ST;
    const float lgf2 = log_sigmoid_(P.in[I_RDF][l * 4 + h]) * 1.4426950408889634f, lgb2 = log_sigmoid_(P.in[I_RDB][l * 4 + h]) * 1.4426950408889634f;
    LAS char* lds = (LAS char*)F.lds;
    const int qblk = w & 3, eh = w >> 2, qi = qblk * 32 + r32;
    const int ldsb = (int)(uintptr_t)lds;
    const bf16_t* Qw = PROJ + (size_t)(row0 + qi) * LDP + C_BQ + h * 128 + hi * 8;
#pragma nounroll
    for (int jt = 0; jt < 2; ++jt) {
        const int sr = tid >> 4, sc = (tid & 15) * 8;
        const bf16_t* ksrc = PROJ + (size_t)(row0 + jt * 64) * LDP + C_BK + h * 128;
        *(LAS bf16x8*)(lds + jt * 16384 + KSWZ(sr, sc * 2)) = *reinterpret_cast<const bf16x8*>(ksrc + (size_t)sr * LDP + sc);
        *(LAS bf16x8*)(lds + jt * 16384 + KSWZ(32 + sr, sc * 2)) = *reinterpret_cast<const bf16x8*>(ksrc + (size_t)(32 + sr) * LDP + sc);
#pragma nounroll
        for (int e2 = 0; e2 < 2; ++e2) stage_vtile<0>(lds + 32768 + (jt * 2 + e2) * 16384, PROJ + (size_t)(row0 + jt * 64) * LDP + C_BV + h * 256 + e2 * 128, LDP, tid, 0.f, 0);
    }
    __syncthreads();
    f32x16 o[4] = {};
    {
        bf16x8 qr[8];
#pragma unroll
        for (int d0 = 0; d0 < 8; ++d0) qr[d0] = *reinterpret_cast<const bf16x8*>(Qw + d0 * 16);
#pragma nounroll
        for (int jt = 0; jt < 2; ++jt) {
            f32x16 p0, p1; att::qkt<128>(p0, p1, lds + jt * 16384, lds, qr, r32, hi);
#pragma unroll
            for (int r = 0; r < 16; ++r) {
                const int j0 = jt * 64 + att::crow(r, hi), j1 = j0 + 32; const int d0 = qi - j0, d1 = qi - j1;
                const float w0 = d0 > 0 ? __builtin_amdgcn_exp2f(lgf2 * (float)d0) : (d0 < 0 ? __builtin_amdgcn_exp2f(lgb2 * (float)(-d0)) : 2.0f);
                const float w1 = d1 > 0 ? __builtin_amdgcn_exp2f(lgf2 * (float)d1) : (d1 < 0 ? __builtin_amdgcn_exp2f(lgb2 * (float)(-d1)) : 2.0f);
                p0[r] *= w0; p1[r] *= w1; }
            bf16x8 pa0, pa1, pa2, pa3; att::p_to_frags(p0, p1, pa0, pa1, pa2, pa3);
            att::pv_d0(o, ldsb + 32768 + (jt * 2 + eh) * 16384 + att::v_rd_base(lane), pa0, pa1, pa2, pa3);
        }
    }
    __syncthreads();
#pragma nounroll
    for (int t = 0; t < 8; ++t) stage_vtile<0>(lds + t * 16384, RS + (size_t)(t >> 2) * RET_ST + (size_t)(((t >> 1) & 1) * 64) * 256 + (t & 1) * 128, 256, tid, 0.f, 0);
    __syncthreads();
    {
        const float ff = __builtin_amdgcn_exp2f(lgf2 * (float)(qi + 1)), fb = __builtin_amdgcn_exp2f(lgb2 * (float)(128 - qi));
#pragma nounroll
        for (int sd = 0; sd < 4; ++sd) { const float f = (sd >> 1) ? fb : ff; const int dt = sd & 1; bf16x8 pa[4];
#pragma unroll
            for (int k = 0; k < 4; ++k) { const u32x4 q4 = *reinterpret_cast<const u32x4*>(Qw + (dt * 4 + k) * 16); u32x4 s4;
                s4.x = cvt_pk_bf16(bf_lo(q4.x) * f, bf_hi(q4.x) * f); s4.y = cvt_pk_bf16(bf_lo(q4.y) * f, bf_hi(q4.y) * f); s4.z = cvt_pk_bf16(bf_lo(q4.z) * f, bf_hi(q4.z) * f); s4.w = cvt_pk_bf16(bf_lo(q4.w) * f, bf_hi(q4.w) * f);
                pa[k] = *reinterpret_cast<const bf16x8*>(&s4); }
            att::pv_d0(o, ldsb + (sd * 2 + eh) * 16384 + att::v_rd_base(lane), pa[0], pa[1], pa[2], pa[3]); }
    }
    LAS float* rsum = (LAS float*)(F.lds + LDS_RS_OFF);
    float ss[16];
#pragma unroll
    for (int r = 0; r < 16; ++r) { float s = 0.f;
#pragma unroll
        for (int d0 = 0; d0 < 4; ++d0) s += o[d0][r] * o[d0][r];
        s += swz_xor<1>(s); s += swz_xor<2>(s); s += swz_xor<4>(s); s += swz_xor<8>(s); s += swz_xor<16>(s); ss[r] = s; }
    if (r32 == 0) {
#pragma unroll
        for (int r = 0; r < 16; ++r) rsum[eh * 128 + qblk * 32 + att::crow(r, hi)] = ss[r]; }
    __syncthreads();
    const float* gn = P.in[I_RGN] + l * 1024 + h * 256; bf16_t* OB = (bf16_t*)(ws + WS_OABC + SZ_O1);
#pragma unroll
    for (int r = 0; r < 16; ++r) { const int i = qblk * 32 + att::crow(r, hi);
        const float rs = 1.0f / sqrtf((rsum[i] + rsum[128 + i]) * (1.0f / 256.0f) + EPS);
#pragma unroll
        for (int d0 = 0; d0 < 4; ++d0) { const int e = eh * 128 + d0 * 32 + r32;
            const float g = __uint_as_float((unsigned)PROJ[(size_t)(row0 + i) * LDP + C_BG + h * 256 + e] << 16);
            OB[(size_t)(row0 + i) * LDO + h * 256 + e] = (bf16_t)(cvt_pk_bf16(o[d0][r] * rs * gn[e] * siluf_(g), 0.f) & 0xffffu); } }
    __syncthreads();
}

constexpr int CONV_PER_L = 32 * 362 + 8 * 48 + 4 * 64 + 3 * 16 * 64 + 32 * 64 + 32 * 256 + 128 * 64, CONV_SPLIT = (CONV_PER_L * 42) / 100, CONV_SPLIT2 = (CONV_PER_L * 64) / 100;
constexpr int NPH_L = 11, NPH = 2 + DEPTH * NPH_L;
__global__ void __launch_bounds__(NTHR, 2) mega(Params prm) {
    extern __shared__ __attribute__((aligned(16))) unsigned char lds_raw[];
    Ctx F; F.lds = (LAS unsigned char*)lds_raw; F.tid = threadIdx.x; F.lane = F.tid & 63; F.wave = __builtin_amdgcn_readfirstlane(F.tid >> 6); F.bid = blockIdx.x; F.G = gridDim.x; F.p = (CParams*)__builtin_amdgcn_kernarg_segment_ptr();
    unsigned char* ws = F.p->ws;
    for (int u = F.tid; u < 128; u += NTHR) ((LAS unsigned*)(F.lds + LDSCTL_OFF))[u] = 0u;
    __syncthreads();
    const int lo = F.p->ph_lo, hi = F.p->ph_hi; const bool multi = (hi - lo) > 1;
    XcdBarrier bar; bar.bar = (unsigned*)(ws + WS_CTL); bar.x = 0; bar.st = nullptr;
    if (multi) bar = xcd_barrier_post((unsigned*)(ws + WS_CTL), (volatile LAS unsigned*)(F.lds + LDSCTL_OFF + 32));
#ifndef SUB_MASK
#define SUB_MASK 15
#endif
#ifndef PH_MASK
#define PH_MASK 0xFFFF
#endif
#ifndef DUP_MASK
#define DUP_MASK 0
#endif
#define REPS(bit) ((DUP_MASK & (bit)) ? 2 : 1)
#define IN(k) (lo <= (k) && (k) < hi)
#define RELANE() do { int l_; asm volatile("v_mbcnt_lo_u32_b32 %0, -1, 0\n\tv_mbcnt_hi_u32_b32 %0, -1, %0" : "=v"(l_)); F.lane = l_; F.tid = F.wave * 64 + l_; } while (0)
#define FRESH() do { int l_; asm volatile("v_mbcnt_lo_u32_b32 %0, -1, 0\n\tv_mbcnt_hi_u32_b32 %0, -1, %0" : "=v"(l_)); F.lane = l_; F.tid = F.wave * 64 + l_; CParams* kp_ = (CParams*)__builtin_amdgcn_kernarg_segment_ptr(); asm volatile("" : "+s"(kp_)); F.p = kp_; } while (0)
#define SEAM(k) do { if (IN(k) && IN((k) + 1)) xcd_barrier(bar, F.tid == 0); } while (0)
    float* X = F.p->out;
    const float* MOD = (const float*)(ws + WS_MOD);
    bf16_t* H = (bf16_t*)(ws + WS_H); bf16_t* PROJ = (bf16_t*)(ws + WS_PROJ);
    float* PART = (float*)(ws + WS_PART);

    if ((PH_MASK & 1) && IN(0)) _Pragma("nounroll") for (int rp = 0; rp < REPS(1); ++rp) { FRESH(); convert_layer(F, 0, 0, F.G, true, 0, CONV_PER_L);
        _Pragma("nounroll") for (int l2 = 1; l2 < DEPTH; ++l2) { FRESH(); convert_layer(F, l2, 0, F.G, false, CONV_SPLIT2, CONV_PER_L); }
        SEAM(0); }
    if ((PH_MASK & 2) && IN(1)) { FRESH(); norm_phase(F, F.p->in[I_XP], F.p->in[I_XS], nullptr, nullptr, nullptr, H, nullptr, 0, nullptr, MOD, 2048, 0, F.p->in[I_GPMIX]); SEAM(1); }

    for (int l = 0; l < DEPTH; ++l) {
        const int pb = 2 + l * NPH_L; const float* MODL = MOD + (size_t)l * 3 * 12288;
        if ((PH_MASK & 4) && IN(pb + 0)) _Pragma("nounroll") for (int rp = 0; rp < REPS(4); ++rp) { FRESH();
            pg8::EpiBf16<0> E{PROJ, LDP, 0};
            pg8::gemm_phase<pg8::EpiBf16<0>, NTOK, NPROJ, LDH, LDH, DM, 1, false, 0, 0>(F.lds, F.tid, H, ws + WS_WIN + l * SZ_WIN, F.G, F.bid, E);
            if (l + 1 < DEPTH && rp == 0) { constexpr int NU = (NTOK / 256) * (NPROJ / 256); const int first = NU % F.G;
                if (first > 0 && F.bid >= first) { FRESH(); convert_layer(F, l + 1, first, F.G - first, false, CONV_SPLIT, CONV_SPLIT2); } }
            SEAM(pb + 0);
        }
        if ((PH_MASK & 8) && IN(pb + 1)) _Pragma("nounroll") for (int rp = 0; rp < REPS(8); ++rp) { FRESH(); if (REPS(8) == 2 && rp == 0) phase_postproj<true>(F, l); else phase_postproj<false>(F, l); SEAM(pb + 1); }
        if ((PH_MASK & 16) && IN(pb + 2)) _Pragma("nounroll") for (int rp = 0; rp < REPS(16); ++rp) { FRESH();
            if (SUB_MASK & 1) { pg8::EpiBf16<0> E{(bf16_t*)(ws + WS_CQ), LDCQ, 0};
              pg8::gemm_phase<pg8::EpiBf16<0>, NTOK, 1536, LDP, 512, 512, 1, false, 0, 0>(F.lds, F.tid, PROJ + C_CQL, ws + WS_WUQ + l * SZ_WUQ, F.G, F.bid, E); }
            if (SUB_MASK & 2) { FRESH(); pg8::EpiBf16<0> E{(bf16_t*)(ws + WS_KVUP), LDKV, 0};
              pg8::gemm_phase<pg8::EpiBf16<0>, NALL, 2048, 256, 256, 256, 1, false, 0, 0>(F.lds, F.tid, ws + WS_CKV, ws + WS_WUKV + l * SZ_WUKV, F.G, F.G - 1 - F.bid, E); }
            if (SUB_MASK & 4) { FRESH(); for (int u = F.bid; u < 384; u += F.G) { RELANE(); ret_kv_unit(F, l, u); } }
            FRESH();
            if (SUB_MASK & 8) for (int u = F.bid; u < 384; u += F.G) {
                RELANE(); int row0, kv0, seq, h;
                if (u < 256) { const int uu = (F.G == 256) ? ((u & 7) * 32 + (u >> 3)) : u; const int b = uu >> 7; h = (uu >> 4) & 7; row0 = NCTX + b * 4096 + (uu & 15) * 256; kv0 = NCTX + b * KVL; seq = KVL; }
                else { const int s = (u - 256) >> 3; h = (u - 256) & 7; row0 = s * 256; kv0 = s * 256; seq = 256; }
                att::attn_dma<128, LDP, 256, 256, LDO>(PROJ + (size_t)row0 * LDP + C_AQ + h * 128, (const bf16_t*)(ws + WS_KA) + (size_t)kv0 * 256 + (h >> 2) * 128, nullptr,
                    (const bf16_t*)(ws + WS_VA) + (size_t)kv0 * 256 + (h >> 2) * 128, (bf16_t*)(ws + WS_OABC) + (size_t)row0 * LDO + h * 128, seq, (LAS char*)F.lds, (LAS float*)(F.lds + LDS_WSCR_OFF), F.tid);
            }
            SEAM(pb + 2);
        }
        if ((PH_MASK & 32) && IN(pb + 3)) _Pragma("nounroll") for (int rp = 0; rp < REPS(32); ++rp) { FRESH(); phase_scan(F, l, rp == 0); SEAM(pb + 3); }
        if ((PH_MASK & 64) && IN(pb + 4)) _Pragma("nounroll") for (int rp = 0; rp < REPS(64); ++rp) { FRESH();
            FRESH();
            if (SUB_MASK & 2) for (int u = F.bid; u < 384; u += F.G) {
                RELANE(); int row0, kv0, seq, h;
                if (u < 256) { const int uu = (F.G == 256) ? ((u & 7) * 32 + (u >> 3)) : u; const int b = uu >> 7; h = (uu >> 4) & 7; row0 = NCTX + b * 4096 + (uu & 15) * 256; kv0 = NCTX + b * KVL; seq = KVL; }
                else { const int s = (u - 256) >> 3; h = (u - 256) & 7; row0 = s * 256; kv0 = s * 256; seq = 256; }
                att::attn_dma<192, LDCQ, LDKV, LDKV, LDO>((const bf16_t*)(ws + WS_CQ) + (size_t)row0 * LDCQ + h * 192, (const bf16_t*)(ws + WS_KVUP) + (size_t)kv0 * LDKV + h * 256,
                    (const bf16_t*)(ws + WS_KROPE) + (size_t)kv0 * 64, (const bf16_t*)(ws + WS_KVUP) + (size_t)kv0 * LDKV + h * 256 + 128,
                    (bf16_t*)(ws + WS_OABC + 2 * SZ_O1) + (size_t)row0 * LDO + h * 128, seq, (LAS char*)F.lds, (LAS float*)(F.lds + LDS_WSCR_OFF), F.tid);
            }
            FRESH();
            if (SUB_MASK & 4) for (int u = (F.bid + F.G / 2) % F.G; u < 384; u += F.G) { RELANE(); ret_out_unit(F, l, u); }
            SEAM(pb + 4);
        }
        if ((PH_MASK & 128) && IN(pb + 5)) _Pragma("nounroll") for (int rp = 0; rp < REPS(128); ++rp) { FRESH();
            pg8::EpiBranch E{PROJ + C_GATE, LDP, (bf16_t*)(ws + WS_MERGED)};
            pg8::gemm_phase<pg8::EpiBranch, NTOK, DM, LDO, LDO, 1024, 3, true, SZ_O1, SZ_WBR1>(F.lds, F.tid, ws + WS_OABC, ws + WS_WBR + (size_t)l * 3 * SZ_WBR1, F.G, F.bid, E);
            if (l + 1 < DEPTH && rp == 0) { FRESH(); const int first = (F.G > 192 && F.G < 384) ? 384 - F.G : 0; if (F.bid >= first) convert_layer(F, l + 1, first, F.G - first, true, 0, CONV_SPLIT); }
            SEAM(pb + 5);
        }
        if ((PH_MASK & 256) && IN(pb + 6)) _Pragma("nounroll") for (int rp = 0; rp < REPS(256); ++rp) { FRESH();
            pg8::EpiBf16<0> E{(bf16_t*)PART, DM, (size_t)NTOK * DM};
            pg8::gemm_phase<pg8::EpiBf16<0>, NTOK, DM, LDH, LDH, 1024, 2, false, 2048, 2048>(F.lds, F.tid, ws + WS_MERGED, ws + WS_WOUT + l * SZ_WOUT, F.G, F.bid, E);
            SEAM(pb + 6);
        }
        if ((PH_MASK & 512) && IN(pb + 7)) _Pragma("nounroll") for (int rp = 0; rp < REPS(512); ++rp) { FRESH();
            norm_phase(F, l == 0 ? F.p->in[I_XP] : X, l == 0 ? F.p->in[I_XS] : X + (size_t)NCTX * DM, (const bf16_t*)PART, (const bf16_t*)PART + (size_t)NTOK * DM, (REPS(512) == 2 && rp == 0) ? (float*)PROJ : X, (REPS(512) == 2 && rp == 0) ? (bf16_t*)(ws + WS_PROJ + SZ_PART1) : H, MODL, 4096, F.p->in[I_GPOMIX] + l * DM, MODL, 8192, 6144, F.p->in[I_GPMLP] + l * DM);
            SEAM(pb + 7);
        }
        if ((PH_MASK & 1024) && IN(pb + 8)) _Pragma("nounroll") for (int rp = 0; rp < REPS(1024); ++rp) { FRESH();
            pg8::EpiBf16<1> E{PROJ, LDU, 0};
            pg8::gemm_phase<pg8::EpiBf16<1>, NTOK, DFF, LDH, LDH, DM, 1, false, 0, 0>(F.lds, F.tid, H, ws + WS_WUP + l * SZ_WUP, F.G, F.bid, E);
            SEAM(pb + 8);
        }
        if ((PH_MASK & 2048) && IN(pb + 9)) _Pragma("nounroll") for (int rp = 0; rp < REPS(2048); ++rp) { FRESH();
            pg8::EpiBf16<0> E{(bf16_t*)PART, DM, (size_t)NTOK * DM};
            pg8::gemm_phase<pg8::EpiBf16<0>, NTOK, DM, LDU, LDU, 4096, 2, false, 8192, 8192>(F.lds, F.tid, PROJ, ws + WS_WDN + l * SZ_WDN, F.G, F.bid, E);
            SEAM(pb + 9);
        }
        if ((PH_MASK & 4096) && IN(pb + 10)) _Pragma("nounroll") for (int rp = 0; rp < REPS(4096); ++rp) { FRESH();
            const bool more = (l + 1 < DEPTH);
            norm_phase(F, X, X + (size_t)NCTX * DM, (const bf16_t*)PART, (const bf16_t*)PART + (size_t)NTOK * DM, (REPS(4096) == 2 && rp == 0) ? (float*)PROJ : X, (REPS(4096) == 2 && rp == 0) ? (bf16_t*)(ws + WS_PROJ + SZ_PART1) : H, MODL, 10240, F.p->in[I_GPOMLP] + l * DM,
                       MODL + 3 * 12288, 2048, 0, more ? F.p->in[I_GPMIX] + (l + 1) * DM : nullptr);
            SEAM(pb + 10);
        }
    }
#undef IN
#undef SEAM
}

#ifndef MK_MULTI
#define MK_MULTI 0
#endif
extern "C" void kernel_launch(void* const* d_in, const int* in_sizes, int n_in, void* d_out, int out_size, void* d_ws, size_t ws_size, hipStream_t stream) {
    static int grid = 0;
    if (grid == 0) {
        if (n_in != 32 || out_size != (int)O_END || ws_size < WS_END) { fprintf(stderr, "kernel_launch: unexpected shapes: n_in %d out %d ws %zu (need %zu)\n", n_in, out_size, ws_size, (size_t)WS_END); grid = -1; return; }
        int dev = 0, cus = 0, per_cu = 0;
        if (hipGetDevice(&dev) != hipSuccess || hipDeviceGetAttribute(&cus, hipDeviceAttributeMultiprocessorCount, dev) != hipSuccess) { grid = -1; return; }
        if (hipFuncSetAttribute((const void*)mega, hipFuncAttributeMaxDynamicSharedMemorySize, LDS_BYTES) != hipSuccess) { fprintf(stderr, "kernel_launch: hipFuncSetAttribute failed\n"); grid = -1; return; }
        if (hipOccupancyMaxActiveBlocksPerMultiprocessor(&per_cu, (const void*)mega, NTHR, LDS_BYTES) != hipSuccess || per_cu < 1) fprintf(stderr, "kernel_launch: occupancy query says %d\n", per_cu);
        (void)hipGetLastError();
        grid = cus;
    }
    if (grid < 0) return;
    (void)hipMemsetAsync((char*)d_ws + WS_CTL, 0, CTL_BYTES, stream);
    Params p{};
    for (int i = 0; i < 32; ++i) p.in[i] = (const float*)d_in[i];
    p.out = (float*)d_out; p.ws = (unsigned char*)d_ws;
#if MK_MULTI
    for (int k = 0; k < NPH; ++k) { p.ph_lo = k; p.ph_hi = k + 1; hipLaunchKernelGGL(mega, dim3(grid), dim3(NTHR), LDS_BYTES, stream, p); }
#else
    p.ph_lo = 0; p.ph_hi = NPH;
    hipLaunchKernelGGL(mega, dim3(grid), dim3(NTHR), LDS_BYTES, stream, p);
#endif
    const hipError_t le = hipPeekAtLastError();
    if (le != hipSuccess) fprintf(stderr, "kernel_launch: launch failed: %s\n", hipGetErrorName(le));
}
```

```cpp
#include <hip/hip_runtime.h>
#include <cstdio>
#include <cstdint>

#define LAS __attribute__((address_space(3)))
#define GAS __attribute__((address_space(1)))
typedef unsigned short bf16_t;
typedef short bf16x8 __attribute__((ext_vector_type(8)));
typedef short s16x4 __attribute__((ext_vector_type(4)));
typedef float f32x4 __attribute__((ext_vector_type(4)));
typedef float f32x2 __attribute__((ext_vector_type(2)));
typedef float f32x16 __attribute__((ext_vector_type(16)));
typedef unsigned u32x4 __attribute__((ext_vector_type(4)));
typedef unsigned u32x2 __attribute__((ext_vector_type(2)));

constexpr int DM = 2048, NCTX = 4096, NLAT = 8192, NTOK = 12288, DEPTH = 4, DFF = 8192;
constexpr int NPROJ = 11776;
constexpr int PADE = 64;
constexpr int LDP = NPROJ + PADE, LDH = DM + PADE, LDU = DFF + PADE, LDO = 1024 + PADE, LDCQ = 1536 + PADE, LDKV = 2048 + PADE;
constexpr int C_AQ = 0, C_AK = 1024, C_AV = 1280, C_BQ = 1536, C_BK = 2048, C_BV = 2560, C_BG = 3584, C_CQL = 4608, C_CKV = 5120, C_CKR = 5376, C_GATE = 5632;
constexpr int NALL = 13312;
constexpr int KVL = 4608;
constexpr float EPS = 1e-6f;
constexpr int NWAVES = 8, NTHR = 512;

constexpr size_t WS_CTL = 0, CTL_BYTES = 1u << 20;
constexpr size_t WS_MOD = CTL_BYTES;
constexpr size_t WS_WIN = 2u << 20;
constexpr size_t SZ_WIN = (size_t)NPROJ * LDH * 2;
constexpr size_t WS_WUQ = WS_WIN + 4 * SZ_WIN;
constexpr size_t SZ_WUQ = (size_t)1536 * 512 * 2;
constexpr size_t WS_WUKV = WS_WUQ + 4 * SZ_WUQ;
constexpr size_t SZ_WUKV = (size_t)2048 * 256 * 2;
constexpr size_t WS_WBR = WS_WUKV + 4 * SZ_WUKV;
constexpr size_t SZ_WBR1 = (size_t)2048 * LDO * 2;
constexpr size_t WS_WOUT = WS_WBR + 12 * SZ_WBR1;
constexpr size_t SZ_WOUT = (size_t)2048 * LDH * 2;
constexpr size_t WS_WUP = WS_WOUT + 4 * SZ_WOUT;
constexpr size_t SZ_WUP = (size_t)8192 * LDH * 2, SZ_WDN = (size_t)2048 * LDU * 2;
constexpr size_t WS_WDN = WS_WUP + 4 * SZ_WUP;
constexpr size_t WS_H = WS_WDN + 4 * SZ_WDN;
constexpr size_t WS_PROJ = WS_H + (size_t)NTOK * LDH * 2;
constexpr size_t WS_KA = WS_PROJ + (size_t)NTOK * LDP * 2;
constexpr size_t WS_VA = WS_KA + (size_t)NALL * 256 * 2;
constexpr size_t WS_CKV = WS_VA + (size_t)NALL * 256 * 2;
constexpr size_t WS_KROPE = WS_CKV + (size_t)NALL * 256 * 2;
constexpr size_t WS_CQ = WS_KROPE + (size_t)NALL * 64 * 2;
constexpr size_t WS_KVUP = WS_CQ + (size_t)NTOK * LDCQ * 2;
constexpr size_t WS_OABC = WS_KVUP + (size_t)NALL * LDKV * 2;
constexpr size_t SZ_O1 = (size_t)NTOK * LDO * 2;
constexpr size_t WS_MERGED = WS_OABC + 3 * SZ_O1;
constexpr size_t WS_PART = WS_MERGED + (size_t)NTOK * LDH * 2;
constexpr size_t SZ_PART1 = (size_t)NTOK * DM * 4;
constexpr size_t WS_END = WS_PART + 2 * SZ_PART1;
constexpr size_t RET_ST = 32768;
constexpr size_t WS_RKV = WS_PART;
constexpr size_t WS_RS = WS_PART + (size_t)96 * 4 * 2 * RET_ST * 4;
static_assert(WS_RS + (size_t)96 * 4 * 2 * RET_ST * 2 <= WS_END, "ws map");

constexpr int LDS_BYTES = 147456;
constexpr int LDSCTL_OFF = 131072;
constexpr int LDS_RS_OFF = 131072 + 1024;
constexpr int LDS_WSCR_OFF = 131072 + 2048;

__device__ __forceinline__ unsigned cvt_pk_bf16(float lo, float hi) { unsigned r; asm volatile("v_cvt_pk_bf16_f32 %0, %1, %2" : "=v"(r) : "v"(lo), "v"(hi)); return r; }
__device__ __forceinline__ float bf_lo(unsigned u) { return __uint_as_float(u << 16); }
__device__ __forceinline__ float bf_hi(unsigned u) { return __uint_as_float(u & 0xffff0000u); }
template <int X> __device__ __forceinline__ float swz_xor(float v) { return __int_as_float(__builtin_amdgcn_ds_swizzle(__float_as_int(v), 0x1f | (X << 10))); }
__device__ __forceinline__ float wave_sum(float v) {
    v += swz_xor<1>(v); v += swz_xor<2>(v); v += swz_xor<4>(v); v += swz_xor<8>(v); v += swz_xor<16>(v);
    auto rr = __builtin_amdgcn_permlane32_swap(__float_as_uint(v), __float_as_uint(v), false, false);
    return __uint_as_float(rr[0]) + __uint_as_float(rr[1]);
}
__device__ __forceinline__ float fast_exp(float x) { return __builtin_amdgcn_exp2f(x * 1.4426950408889634f); }
__device__ __forceinline__ float sigmoidf_(float x) { return __builtin_amdgcn_rcpf(1.0f + fast_exp(-x)); }
__device__ __forceinline__ float siluf_(float x) { return x * sigmoidf_(x); }
#define LDS_WAIT() asm volatile("s_waitcnt lgkmcnt(0)" ::: "memory")
#define VM_WAIT() asm volatile("s_waitcnt vmcnt(0)" ::: "memory")

#define XB_TMO      128
#define XB_XCNT(j)  (256  + 64 * (j))
#define XB_XSUB(j)  (1280 + 64 * (j))
#define XB_XGEN(j)  (2304 + 64 * (j))
#define XB_TOP      3328
#define XB_TOPGEN   3392
#define XCD_BAR_WORDS 3456
#define XB_SPIN_CAP (1u << 22)
__device__ __forceinline__ unsigned xb_ld(unsigned* p)              { return __hip_atomic_load(p, __ATOMIC_RELAXED, __HIP_MEMORY_SCOPE_AGENT); }
__device__ __forceinline__ unsigned xb_add(unsigned* p, unsigned v) { return __hip_atomic_fetch_add(p, v, __ATOMIC_RELAXED, __HIP_MEMORY_SCOPE_AGENT); }
__device__ __forceinline__ unsigned xb_xcc_id() { return (unsigned)__builtin_amdgcn_s_getreg((3 << 11) | 20) & 0xFu; }
#define XB_SPIN(cond, bar) do { unsigned _sp = 0; while (cond) { __builtin_amdgcn_s_sleep(1); \
    if ((++_sp & 255u) == 0u) { if (xb_ld(&(bar)[XB_TMO])) break; if (_sp > XB_SPIN_CAP) { atomicAdd(&(bar)[XB_TMO], 1u); break; } } } } while (0)
struct XcdBarrier { unsigned* bar; unsigned x; volatile LAS unsigned* st; };
__device__ __forceinline__ XcdBarrier xcd_barrier_post(unsigned* bar, volatile LAS unsigned* st) {
    XcdBarrier b; b.bar = bar; b.x = xb_xcc_id(); b.st = st;
    if (threadIdx.x == 0) (void)xb_add(&bar[XB_XCNT(b.x)], 1u);
    return b;
}
__device__ __forceinline__ void xcd_barrier_complete(unsigned* bar, unsigned x, unsigned& nloc, unsigned& nx) {
    const unsigned G = gridDim.x * gridDim.y * gridDim.z;
    unsigned sum, cnt, mine, sp = 0u;
    for (;;) {
        sum = 0u; cnt = 0u; mine = 0u;
#pragma unroll
        for (unsigned j = 0; j < 16; ++j) { const unsigned c = xb_ld(&bar[XB_XCNT(j)]); sum += c; cnt += (c > 0u) ? 1u : 0u; mine = (j == x) ? c : mine; }
        if (sum == G) break;
        __builtin_amdgcn_s_sleep(1);
        if ((++sp & 255u) == 0u) { if (xb_ld(&bar[XB_TMO])) break; if (sp > XB_SPIN_CAP) { atomicAdd(&bar[XB_TMO], 1u); break; } }
    }
    nloc = mine > 0u ? mine : 1u; nx = cnt > 0u ? cnt : 1u;
}
__device__ __forceinline__ void xcd_barrier(const XcdBarrier& b, const bool leader) {
    asm volatile("s_waitcnt vmcnt(0)" ::: "memory");
    __syncthreads();
    if (leader) {
        unsigned* bar = b.bar;
        __builtin_amdgcn_s_waitcnt(0);
        unsigned nloc = b.st[0], nx = b.st[1];
        if (nloc == 0u) { xcd_barrier_complete(bar, b.x, nloc, nx); b.st[0] = nloc; b.st[1] = nx; }
        const unsigned old = xb_add(&bar[XB_XSUB(b.x)], 1u);
        const unsigned gen = old / nloc;
        if (old + 1u == (gen + 1u) * nloc) {
            __builtin_amdgcn_fence(__ATOMIC_RELEASE, "agent");
            asm volatile("s_waitcnt vmcnt(0)" ::: "memory");
            const unsigned og = xb_add(&bar[XB_TOP], 1u);
            const unsigned tg = og / nx;
            if (og + 1u == (tg + 1u) * nx) xb_add(&bar[XB_TOPGEN], 1u);
            else XB_SPIN(xb_ld(&bar[XB_TOPGEN]) == tg, bar);
            __builtin_amdgcn_fence(__ATOMIC_ACQUIRE, "agent");
            xb_add(&bar[XB_XGEN(b.x)], 1u);
            asm volatile("s_waitcnt vmcnt(0)" ::: "memory");
        } else {
            XB_SPIN(xb_ld(&bar[XB_XGEN(b.x)]) == gen, bar);
            __builtin_amdgcn_fence(__ATOMIC_ACQUIRE, "agent");
            asm volatile("s_waitcnt vmcnt(0)" ::: "memory");
        }
    }
    __syncthreads();
}

namespace pg8 {
constexpr int BM = 256, BK = 64, HALF = 128, HTB = HALF * BK * 2, STAGE_BYTES = 8 * HTB, NXCD = 8, WGM = 8;
__host__ __device__ __forceinline__ int lds_byte(int r, int c) { const int st = (r >> 4) * 2 + (c >> 5), rr = r & 15, cc = c & 31, ob = rr * 64 + cc * 2; return st * 1024 + (ob ^ (((ob >> 9) & 1) << 5)); }
__host__ __device__ __forceinline__ void stage_rc(int b, int& R, int& C) { const int st = b / 1024, sb = b % 1024, swz = sb ^ (((sb >> 9) & 1) << 5); R = (st >> 1) * 16 + swz / 64; C = (st & 1) * 32 + (swz % 64) / 2; }
__host__ __device__ __forceinline__ int perm32(int rho) { const int n = rho >> 4, i = rho & 15; return 8 * (i >> 2) + 4 * n + (i & 3); }

struct Unit { int pm, pn, z; };
template <int M, int N, int NZ, bool ZINNER>
__device__ __forceinline__ bool next_unit(int k, int G, int c, Unit& u) {
    constexpr int nM = M / BM, nN = N / BM, nNx = ZINNER ? nN : nN * NZ, nwg = nM * nNx;
    int i, z;
    if (ZINNER) { i = k / NZ; z = k - i * NZ; } else { i = k; z = 0; }
    const int L = i * G + c; if (L >= nwg) return false;
    int wgid = L; { constexpr int q = nwg / NXCD, r = nwg % NXCD; const int xcd = wgid % NXCD, off = wgid / NXCD; wgid = (xcd < r ? xcd * (q + 1) : r * (q + 1) + (xcd - r) * q) + off; }
    constexpr int nig = WGM * nNx; const int gid = wgid / nig, fm = gid * WGM, gsz = (nM - fm) < WGM ? (nM - fm) : WGM;
    u.pm = fm + ((wgid % nig) % gsz); const int pnx = (wgid % nig) / gsz;
    if (ZINNER) { u.pn = pnx; u.z = z; } else { u.z = pnx / nN; u.pn = pnx - u.z * nN; }
    return true;
}

template <int ACT  > struct EpiBf16 {
    static constexpr bool PERM = true, KEEP = false;
    bf16_t* O; int ldc; size_t zstride;
    __device__ __forceinline__ void operator()(f32x4 (&acc)[2][2][4][2], const Unit& u, int wr, int wc, int fr, int fq) const {
        const int row0 = u.pm * BM + wr * 64 + fr; const int col0 = u.pn * BM + wc * 32 + 8 * fq; bf16_t* Oz = O + (size_t)u.z * zstride;
#pragma unroll
        for (int ai = 0; ai < 2; ++ai)
#pragma unroll
            for (int m = 0; m < 4; ++m) { bf16_t* rowp = Oz + (size_t)(row0 + ai * HALF + m * 16) * ldc + col0;
#pragma unroll
                for (int bj = 0; bj < 2; ++bj) { f32x4 v0 = acc[ai][bj][m][0], v1 = acc[ai][bj][m][1];
                    if (ACT == 1) {
#pragma unroll
                        for (int j = 0; j < 4; ++j) { const float a = fmaxf(v0[j], 0.f), b = fmaxf(v1[j], 0.f); v0[j] = a * a; v1[j] = b * b; } }
                    u32x4 w; w.x = cvt_pk_bf16(v0[0], v0[1]); w.y = cvt_pk_bf16(v0[2], v0[3]); w.z = cvt_pk_bf16(v1[0], v1[1]); w.w = cvt_pk_bf16(v1[2], v1[3]);
                    *(u32x4*)(rowp + bj * HALF) = w; } }
    }
};
struct EpiF32Z {
    static constexpr bool PERM = false, KEEP = false;
    float* C; int ldc; size_t zstride;
    __device__ __forceinline__ void operator()(f32x4 (&acc)[2][2][4][2], const Unit& u, int wr, int wc, int fr, int fq) const {
        const int row0 = u.pm * BM + wr * 64 + fr, col0 = u.pn * BM + wc * 32 + 4 * fq; float* Cz = C + (size_t)u.z * zstride;
#pragma unroll
        for (int ai = 0; ai < 2; ++ai)
#pragma unroll
            for (int m = 0; m < 4; ++m) { float* rowp = Cz + (size_t)(row0 + ai * HALF + m * 16) * ldc + col0;
#pragma unroll
                for (int bj = 0; bj < 2; ++bj)
#pragma unroll
                    for (int n = 0; n < 2; ++n) *(f32x4*)(rowp + bj * HALF + n * 16) = acc[ai][bj][m][n]; }
    }
};
struct EpiBranch {
    static constexpr bool PERM = true, KEEP = true;
    const bf16_t* gates; int ldg;
    bf16_t* O;
    __device__ __forceinline__ void operator()(f32x4 (&acc)[2][2][4][2], const Unit& u, int wr, int wc, int fr, int fq) const {
        const int row0 = u.pm * BM + wr * 64 + fr; const int col0 = u.pn * BM + wc * 32 + 8 * fq; const bool last = (u.z == 2);
        u32x4 gA[2], nA[2], gB[2], nB[2];
#define EB_LOAD(G, N, k) do { _Pragma("unroll") for (int bj = 0; bj < 2; ++bj) { const size_t row = (size_t)(row0 + ((k) >> 2) * HALF + ((k) & 3) * 16); const int col = col0 + bj * HALF; \
            G[bj] = *(const u32x4*)(gates + row * ldg + (size_t)u.z * 2048 + col); if (!last) N[bj] = *(const u32x4*)(gates + row * ldg + (size_t)(u.z + 1) * 2048 + col); } } while (0)
#define EB_EVAL(G, N, k) do { _Pragma("unroll") for (int bj = 0; bj < 2; ++bj) { constexpr int ai = (k) >> 2, m = (k) & 3; const size_t row = (size_t)(row0 + ai * HALF + m * 16); const int col = col0 + bj * HALF; \
            const u32x4 gg = G[bj]; f32x4 v0 = acc[ai][bj][m][0], v1 = acc[ai][bj][m][1]; \
            float f[8] = {sigmoidf_(bf_lo(gg.x)), sigmoidf_(bf_hi(gg.x)), sigmoidf_(bf_lo(gg.y)), sigmoidf_(bf_hi(gg.y)), sigmoidf_(bf_lo(gg.z)), sigmoidf_(bf_hi(gg.z)), sigmoidf_(bf_lo(gg.w)), sigmoidf_(bf_hi(gg.w))}; \
            if (!last) { const u32x4 nn = N[bj];     \
                f[0] *= 1.0f + fast_exp(fminf(-bf_lo(nn.x), 40.f)); f[1] *= 1.0f + fast_exp(fminf(-bf_hi(nn.x), 40.f)); f[2] *= 1.0f + fast_exp(fminf(-bf_lo(nn.y), 40.f)); f[3] *= 1.0f + fast_exp(fminf(-bf_hi(nn.y), 40.f)); \
                f[4] *= 1.0f + fast_exp(fminf(-bf_lo(nn.z), 40.f)); f[5] *= 1.0f + fast_exp(fminf(-bf_hi(nn.z), 40.f)); f[6] *= 1.0f + fast_exp(fminf(-bf_lo(nn.w), 40.f)); f[7] *= 1.0f + fast_exp(fminf(-bf_hi(nn.w), 40.f)); } \
            v0[0] *= f[0]; v0[1] *= f[1]; v0[2] *= f[2]; v0[3] *= f[3]; v1[0] *= f[4]; v1[1] *= f[5]; v1[2] *= f[6]; v1[3] *= f[7]; \
            if (!last) { acc[ai][bj][m][0] = v0; acc[ai][bj][m][1] = v1; } \
            else { u32x4 w; w.x = cvt_pk_bf16(v0[0], v0[1]); w.y = cvt_pk_bf16(v0[2], v0[3]); w.z = cvt_pk_bf16(v1[0], v1[1]); w.w = cvt_pk_bf16(v1[2], v1[3]); \
                *(u32x4*)(O + row * LDH + col) = w; } } } while (0)
        EB_LOAD(gA, nA, 0); EB_LOAD(gB, nB, 1);
        EB_EVAL(gA, nA, 0); EB_LOAD(gA, nA, 2); EB_EVAL(gB, nB, 1); EB_LOAD(gB, nB, 3);
        EB_EVAL(gA, nA, 2); EB_LOAD(gA, nA, 4); EB_EVAL(gB, nB, 3); EB_LOAD(gB, nB, 5);
        EB_EVAL(gA, nA, 4); EB_LOAD(gA, nA, 6); EB_EVAL(gB, nB, 5); EB_LOAD(gB, nB, 7);
        EB_EVAL(gA, nA, 6); EB_EVAL(gB, nB, 7);
#undef EB_LOAD
#undef EB_EVAL
    }
};

template <class Epi, int M, int N, int LDA, int LDB, int KU, int NZ, bool ZINNER, size_t AZS, size_t BZS, bool ALIGN_EPI = true>
__device__ __forceinline__ void gemm_phase(LAS unsigned char* lds, const int tid, const void* Aptr, const void* Bptr, int G, int c, const Epi& E) {
    const char* const Abase = (const char*)Aptr; const char* const Bbase = (const char*)Bptr;
    const int wid = __builtin_amdgcn_readfirstlane(tid >> 6), lane = tid & 63, wr = wid >> 2, wc = wid & 3, fr = lane & 15, fq = lane >> 4;
    constexpr int nt = KU / BK;
    unsigned voffA[2], voffB[2];
#pragma unroll
    for (int i = 0; i < 2; ++i) { int R, C; stage_rc(tid * 16 + i * 8192, R, C); const int Rb = Epi::PERM ? ((R & ~31) + perm32(R & 31)) : R;
        voffA[i] = (unsigned)(R * LDA + C) * 2u; voffB[i] = (unsigned)(Rb * LDB + C) * 2u; }
    constexpr size_t kstep = (size_t)(BK * 2);
    constexpr size_t hstepA = (size_t)HALF * LDA * 2, hstepB = (size_t)HALF * LDB * 2;
    constexpr size_t tstepA = 2 * hstepA, tstepB = 2 * hstepB;
    const unsigned ldsw = (unsigned)wid * 1024u;
    const int aoff = lds_byte(wr * 64 + fr, fq * 8), boff = lds_byte(wc * 32 + fr, fq * 8);
#define PG8_SA(b, h) (((b) * 2 + (h)) * HTB)
#define PG8_SB(b, h) ((4 + (b) * 2 + (h)) * HTB)
#define PG8_STAGE(bufoff, gbase, voff) do { _Pragma("unroll") for (int _i = 0; _i < 2; ++_i) \
        __builtin_amdgcn_global_load_lds((const unsigned*)((const char*)(gbase) + (voff)[_i]), (LAS unsigned*)(lds + (bufoff) + ldsw + _i * 8192), 16, 0, 0); } while (0)
#define PG8_LDA(dst, b, h) do { _Pragma("unroll") for (int m = 0; m < 4; ++m) _Pragma("unroll") for (int k = 0; k < 2; ++k) dst[m][k] = *(const LAS bf16x8*)(lds + PG8_SA(b, h) + aoff + m * 2048 + k * 1024); } while (0)
#define PG8_LDB(dst, b, h) do { _Pragma("unroll") for (int n = 0; n < 2; ++n) _Pragma("unroll") for (int k = 0; k < 2; ++k) dst[n][k] = *(const LAS bf16x8*)(lds + PG8_SB(b, h) + boff + n * 2048 + k * 1024); } while (0)
#define PG8_MMA(ai, bj, At, Bt) do { __builtin_amdgcn_s_setprio(1); _Pragma("unroll") for (int m = 0; m < 4; ++m) _Pragma("unroll") for (int n = 0; n < 2; ++n) _Pragma("unroll") for (int k = 0; k < 2; ++k) \
        acc[ai][bj][m][n] = __builtin_amdgcn_mfma_f32_16x16x32_bf16(Bt[n][k], At[m][k], acc[ai][bj][m][n], 0, 0, 0); __builtin_amdgcn_s_setprio(0); } while (0)
#define PG8_WAIT_V(n) asm volatile("s_waitcnt vmcnt(" #n ")" ::: "memory")
#define PG8_WAIT_L(n) asm volatile("s_waitcnt lgkmcnt(" #n ")" ::: "memory")
#define PG8_BAR __builtin_amdgcn_s_barrier()
#define PG8_SCHED __builtin_amdgcn_sched_barrier(0)
    Unit cur, nxt; int ui = 0;
    if (!next_unit<M, N, NZ, ZINNER>(0, G, c, cur)) return;
    f32x4 acc[2][2][4][2];
#pragma unroll
    for (int a = 0; a < 2; ++a)
#pragma unroll
        for (int b = 0; b < 2; ++b)
#pragma unroll
            for (int m = 0; m < 4; ++m)
#pragma unroll
                for (int n = 0; n < 2; ++n) acc[a][b][m][n] = (f32x4){0.f, 0.f, 0.f, 0.f};
    bf16x8 At[4][2], B0[2][2], B1[2][2];
    const char* cA = Abase + (size_t)cur.z * AZS + (size_t)cur.pm * tstepA; const char* cB = Bbase + (size_t)cur.z * BZS + (size_t)cur.pn * tstepB;
    PG8_STAGE(PG8_SB(0, 0), cB, voffB); PG8_STAGE(PG8_SB(0, 1), cB + hstepB, voffB); PG8_STAGE(PG8_SA(0, 0), cA, voffA); PG8_STAGE(PG8_SA(0, 1), cA + hstepA, voffA);
    if (wr == 1) PG8_BAR;
    PG8_WAIT_V(2); PG8_BAR;
    PG8_STAGE(PG8_SB(1, 0), cB + kstep, voffB); PG8_STAGE(PG8_SA(1, 0), cA + kstep, voffA); PG8_STAGE(PG8_SB(1, 1), cB + hstepB + kstep, voffB);
    PG8_WAIT_V(6); PG8_BAR;
    for (;;) {
        const bool has_next = next_unit<M, N, NZ, ZINNER>(ui + 1, G, c, nxt);
        const char* nA = has_next ? Abase + (size_t)nxt.z * AZS + (size_t)nxt.pm * tstepA : cA; const char* nB = has_next ? Bbase + (size_t)nxt.z * BZS + (size_t)nxt.pn * tstepB : cB;
#pragma nounroll
        for (int t = 0; t < nt; t += 2) {
            const bool last = (t == nt - 2);
            const char* a1 = cA + (size_t)(t + 1) * kstep;
            const char* a2 = last ? nA : cA + (size_t)(t + 2) * kstep; const char* b2 = last ? nB : cB + (size_t)(t + 2) * kstep;
            const char* a3 = a2 + kstep; const char* b3 = b2 + kstep;
            PG8_LDB(B0, 0, 0); PG8_LDB(B1, 0, 1); PG8_SCHED; PG8_LDA(At, 0, 0); PG8_STAGE(PG8_SA(1, 1), a1 + hstepA, voffA);
            PG8_WAIT_V(8); PG8_WAIT_L(0); PG8_BAR; PG8_MMA(0, 0, At, B0); PG8_MMA(0, 1, At, B1); PG8_BAR; PG8_SCHED;
            PG8_LDA(At, 0, 1); PG8_STAGE(PG8_SB(0, 0), b2, voffB); PG8_STAGE(PG8_SB(0, 1), b2 + hstepB, voffB); PG8_STAGE(PG8_SA(0, 0), a2, voffA);
            PG8_WAIT_V(8); PG8_WAIT_L(0); PG8_BAR; PG8_MMA(1, 0, At, B0); PG8_MMA(1, 1, At, B1); PG8_BAR; PG8_SCHED;
            PG8_LDB(B0, 1, 0); PG8_LDB(B1, 1, 1); PG8_SCHED; PG8_LDA(At, 1, 0); PG8_STAGE(PG8_SA(0, 1), a2 + hstepA, voffA);
            PG8_WAIT_V(8); PG8_WAIT_L(0); PG8_BAR; PG8_MMA(0, 0, At, B0); PG8_MMA(0, 1, At, B1); PG8_BAR; PG8_SCHED;
            PG8_LDA(At, 1, 1); PG8_STAGE(PG8_SB(1, 0), b3, voffB); PG8_STAGE(PG8_SB(1, 1), b3 + hstepB, voffB); PG8_STAGE(PG8_SA(1, 0), a3, voffA);
            PG8_WAIT_V(8); PG8_WAIT_L(0); PG8_BAR; PG8_MMA(1, 0, At, B0); PG8_MMA(1, 1, At, B1); PG8_BAR; PG8_SCHED;
        }
        if constexpr (ALIGN_EPI) { if (wr == 0) PG8_BAR; }
        E(acc, cur, wr, wc, fr, fq);
        if (!has_next) break;
        if (!(Epi::KEEP && cur.z + 1 < NZ)) {
#pragma unroll
        for (int a = 0; a < 2; ++a)
#pragma unroll
            for (int b = 0; b < 2; ++b)
#pragma unroll
                for (int m = 0; m < 4; ++m)
#pragma unroll
                    for (int n = 0; n < 2; ++n) acc[a][b][m][n] = (f32x4){0.f, 0.f, 0.f, 0.f};
        }
        cur = nxt; cA = nA; cB = nB; ++ui;
        if constexpr (ALIGN_EPI) { if (wr == 1) PG8_BAR; }
    }
    PG8_WAIT_V(0);
    if constexpr (!ALIGN_EPI) { if (wr == 0) PG8_BAR; }
    PG8_BAR;
#undef PG8_SA
#undef PG8_SB
#undef PG8_STAGE
#undef PG8_LDA
#undef PG8_LDB
#undef PG8_MMA
#undef PG8_WAIT_V
#undef PG8_WAIT_L
#undef PG8_BAR
#undef PG8_SCHED
}
}

namespace att {
constexpr int NW = 8, QBLK = 32, KVBLK = 64;
constexpr int SHM_T = KVBLK * 128 * 2;
#define KSWZ(row, colB) ((row) * 256 + ((colB) ^ (((row) & 7) << 4)))
#define SBAR() __builtin_amdgcn_sched_barrier(0)
__device__ __forceinline__ int crow(int r, int hi) { return (r & 3) + 8 * (r >> 2) + 4 * hi; }
__device__ __forceinline__ int v_st(int k, int c) { const int kk = (k & ~0xC) | ((k & 4) << 1) | ((k & 8) >> 1); return ((kk >> 3) * 4 + (c >> 5)) * 512 + ((kk & 7) * 32 + (c & 31)) * 2; }
__device__ __forceinline__ int v_rd_base(int lane) { return ((lane & 3) << 3) | (((lane >> 2) & 3) << 6) | (((lane >> 4) & 1) << 5) | (((lane >> 5) & 1) << 8); }
constexpr int v_rd_off(int d0, int ks, int half) { return d0 * 512 + ks * 4096 + half * 2048; }
template <int OFF> __device__ __forceinline__ s16x4 tr_read(int vb) {
    s16x4 r; asm volatile("ds_read_b64_tr_b16 %0, %1 offset:%2" : "=&v"(r) : "v"(vb), "i"(OFF) : "memory"); return r;
}
#define PKLH(L, H) (bf16x8){L[0], L[1], L[2], L[3], H[0], H[1], H[2], H[3]}
template <int D0> __device__ __forceinline__ void pv_one(f32x16& od, int vb, bf16x8 pa0, bf16x8 pa1, bf16x8 pa2, bf16x8 pa3) {
    const s16x4 l0 = tr_read<v_rd_off(D0, 0, 0)>(vb), h0 = tr_read<v_rd_off(D0, 0, 1)>(vb), l1 = tr_read<v_rd_off(D0, 1, 0)>(vb), h1 = tr_read<v_rd_off(D0, 1, 1)>(vb);
    const s16x4 l2 = tr_read<v_rd_off(D0, 2, 0)>(vb), h2 = tr_read<v_rd_off(D0, 2, 1)>(vb), l3 = tr_read<v_rd_off(D0, 3, 0)>(vb), h3 = tr_read<v_rd_off(D0, 3, 1)>(vb);
    asm volatile("s_waitcnt lgkmcnt(0)" ::: "memory"); SBAR();
    od = __builtin_amdgcn_mfma_f32_32x32x16_bf16(pa0, PKLH(l0, h0), od, 0, 0, 0);
    od = __builtin_amdgcn_mfma_f32_32x32x16_bf16(pa1, PKLH(l1, h1), od, 0, 0, 0);
    od = __builtin_amdgcn_mfma_f32_32x32x16_bf16(pa2, PKLH(l2, h2), od, 0, 0, 0);
    od = __builtin_amdgcn_mfma_f32_32x32x16_bf16(pa3, PKLH(l3, h3), od, 0, 0, 0);
}
__device__ __forceinline__ void pv_d0(f32x16* o, int vb, bf16x8 pa0, bf16x8 pa1, bf16x8 pa2, bf16x8 pa3) {
    pv_one<0>(o[0], vb, pa0, pa1, pa2, pa3); pv_one<1>(o[1], vb, pa0, pa1, pa2, pa3); pv_one<2>(o[2], vb, pa0, pa1, pa2, pa3); pv_one<3>(o[3], vb, pa0, pa1, pa2, pa3);
}
__device__ __forceinline__ void p_to_frags(const f32x16& p0, const f32x16& p1, bf16x8& pa0, bf16x8& pa1, bf16x8& pa2, bf16x8& pa3) {
#define PK4(P, BASE, OUT) do { unsigned a0 = cvt_pk_bf16(P[BASE + 0], P[BASE + 1]), a1 = cvt_pk_bf16(P[BASE + 2], P[BASE + 3]);   \
    unsigned b0 = cvt_pk_bf16(P[BASE + 4], P[BASE + 5]), b1 = cvt_pk_bf16(P[BASE + 6], P[BASE + 7]);                              \
    auto r0 = __builtin_amdgcn_permlane32_swap(a0, b0, false, false); auto r1 = __builtin_amdgcn_permlane32_swap(a1, b1, false, false); \
    u32x4 w = {r0[0], r1[0], r0[1], r1[1]}; OUT = *reinterpret_cast<bf16x8*>(&w); } while (0)
    PK4(p0, 0, pa0); PK4(p0, 8, pa1); PK4(p1, 0, pa2); PK4(p1, 8, pa3);
#undef PK4
}
template <int DQK> struct Cfg { static constexpr float SCALE = DQK == 128 ? 0.088388347648318440f : 0.072168783648703220f; static constexpr float THR = 8.f; };
template <int DQK>
__device__ __forceinline__ void partialSM(f32x16& p0, f32x16& p1, float& m_reg, float& mn, float& alpha) {
    constexpr float SCALE = Cfg<DQK>::SCALE, THR = Cfg<DQK>::THR;
    constexpr float C = SCALE * 1.4426950408889634f;
    float pmax = p0[0];
#pragma unroll
    for (int r = 1; r < 16; ++r) pmax = fmaxf(pmax, p0[r]);
#pragma unroll
    for (int r = 0; r < 16; ++r) pmax = fmaxf(pmax, p1[r]);
    { auto rr = __builtin_amdgcn_permlane32_swap(__float_as_uint(pmax), __float_as_uint(pmax), false, false);
      pmax = fmaxf(__uint_as_float(rr[0]), __uint_as_float(rr[1])); }
    if (__builtin_expect(__all(pmax - m_reg <= THR / SCALE), 1)) { mn = m_reg; alpha = 1.f; }
    else { mn = fmaxf(m_reg, pmax); alpha = __builtin_amdgcn_exp2f((m_reg - mn) * C); m_reg = mn; }
    float mnC = -mn * C;
#pragma unroll
    for (int r = 0; r < 16; ++r) p0[r] = fmaf(p0[r], C, mnC);
#pragma unroll
    for (int r = 0; r < 16; ++r) p1[r] = fmaf(p1[r], C, mnC);
#pragma unroll
    for (int r = 0; r < 16; ++r) p0[r] = __builtin_amdgcn_exp2f(p0[r]);
}
__device__ __forceinline__ void finishSM(f32x16& p0, f32x16& p1, float alpha, float& l_reg, bf16x8& pa0, bf16x8& pa1, bf16x8& pa2, bf16x8& pa3) {
#pragma unroll
    for (int r = 0; r < 16; ++r) p1[r] = __builtin_amdgcn_exp2f(p1[r]);
    float ps = 0;
#pragma unroll
    for (int r = 0; r < 16; ++r) ps += p0[r];
#pragma unroll
    for (int r = 0; r < 16; ++r) ps += p1[r];
    { auto rr = __builtin_amdgcn_permlane32_swap(__float_as_uint(ps), __float_as_uint(ps), false, false);
      ps = __uint_as_float(rr[0]) + __uint_as_float(rr[1]); }
    l_reg = l_reg * alpha + ps;
    p_to_frags(p0, p1, pa0, pa1, pa2, pa3);
}
template <int DQK>
__device__ __forceinline__ void qkt(f32x16& p0, f32x16& p1, const LAS char* Ks, const LAS char* Rs, const bf16x8* qr, int r32, int hi) {
    p0 = f32x16{}; p1 = f32x16{};
#pragma unroll
    for (int d0 = 0; d0 < 8; ++d0) { const int cb = (d0 * 16 + hi * 8) * 2;
        const bf16x8 b0 = *reinterpret_cast<const LAS bf16x8*>(Ks + KSWZ(r32, cb));
        const bf16x8 b1 = *reinterpret_cast<const LAS bf16x8*>(Ks + KSWZ(32 + r32, cb));
        p0 = __builtin_amdgcn_mfma_f32_32x32x16_bf16(b0, qr[d0], p0, 0, 0, 0);
        p1 = __builtin_amdgcn_mfma_f32_32x32x16_bf16(b1, qr[d0], p1, 0, 0, 0); }
    if constexpr (DQK == 192) {
#pragma unroll
        for (int d0 = 0; d0 < 4; ++d0) { const int cb = (d0 * 16 + hi * 8) * 2;
            const bf16x8 b0 = *reinterpret_cast<const LAS bf16x8*>(Rs + KSWZ(r32, cb));
            const bf16x8 b1 = *reinterpret_cast<const LAS bf16x8*>(Rs + KSWZ(32 + r32, cb));
            p0 = __builtin_amdgcn_mfma_f32_32x32x16_bf16(b0, qr[8 + d0], p0, 0, 0, 0);
            p1 = __builtin_amdgcn_mfma_f32_32x32x16_bf16(b1, qr[8 + d0], p1, 0, 0, 0); }
    }
}
template <int DQK> constexpr int attn_lds_bytes() { return 4 * SHM_T + (DQK == 192 ? 2 * SHM_T : 0) + NW * 64 * 4; }

template <int DQK, int LDQ, int LDK, int LDV, int LDO>
__device__ __forceinline__ void attn_body(const bf16_t* __restrict__ Qb, const bf16_t* __restrict__ Kh, const bf16_t* __restrict__ Rh, const bf16_t* __restrict__ Vh,
                                          bf16_t* __restrict__ Ob, int seq, LAS char* lds, const int tid) {
    constexpr int ND = DQK / 16;
    const int wid = tid >> 6, lane = tid & 63, r32 = lane & 31, hi = lane >> 5;
    LAS char* V_lds = lds; LAS char* K_lds = lds + 2 * SHM_T; LAS char* R_lds = lds + 4 * SHM_T;
    LAS float* wsl = (LAS float*)(lds + 4 * SHM_T + (DQK == 192 ? 2 * SHM_T : 0)) + wid * 64; LAS float* li_l = wsl; LAS float* al_l = wsl + 32;
    float m_reg = -1e30f, l_reg = 0; f32x16 o[4] = {}; bf16x8 qr[ND];
    const bf16_t* Qw = Qb + (long)(wid * QBLK + r32) * LDQ + hi * 8;
#pragma unroll
    for (int d0 = 0; d0 < ND; ++d0) qr[d0] = *reinterpret_cast<const bf16x8*>(Qw + d0 * 16);
    const int sr = tid >> 4, sc = (tid & 15) * 8, vst0 = v_st(sr, sc), vst1 = v_st(32 + sr, sc);
    const int rr = tid >> 3, rc = (tid & 7) * 8;
    const int vb0 = (int)(uintptr_t)V_lds + v_rd_base(lane);
    struct { bf16x8 vs0, vs1, ks0, ks1, rs; } sr_[2];
#define SLOAD(i, k0) do { sr_[i].vs0 = *reinterpret_cast<const bf16x8*>(&Vh[(long)((k0) + sr) * LDV + sc]); sr_[i].vs1 = *reinterpret_cast<const bf16x8*>(&Vh[(long)((k0) + 32 + sr) * LDV + sc]); \
    sr_[i].ks0 = *reinterpret_cast<const bf16x8*>(&Kh[(long)((k0) + sr) * LDK + sc]); sr_[i].ks1 = *reinterpret_cast<const bf16x8*>(&Kh[(long)((k0) + 32 + sr) * LDK + sc]); \
    if constexpr (DQK == 192) sr_[i].rs = *reinterpret_cast<const bf16x8*>(&Rh[(long)((k0) + rr) * 64 + rc]); } while (0)
#define SWRITE(b, i) do { *(LAS bf16x8*)(V_lds + (b) * SHM_T + vst0) = sr_[i].vs0; *(LAS bf16x8*)(V_lds + (b) * SHM_T + vst1) = sr_[i].vs1; const int kc = sc * 2; \
    *(LAS bf16x8*)(K_lds + (b) * SHM_T + KSWZ(sr, kc)) = sr_[i].ks0; *(LAS bf16x8*)(K_lds + (b) * SHM_T + KSWZ(32 + sr, kc)) = sr_[i].ks1; \
    if constexpr (DQK == 192) *(LAS bf16x8*)(R_lds + (b) * SHM_T + KSWZ(rr, rc * 2)) = sr_[i].rs; } while (0)
#define SWAIT() do { if constexpr (DQK == 192) asm volatile("s_waitcnt vmcnt(5)" ::: "memory"); else asm volatile("s_waitcnt vmcnt(4)" ::: "memory"); } while (0)
#define RESC(a) do { if (__any((a) < 1.f)) { if (hi == 0) al_l[r32] = (a); asm volatile("s_waitcnt lgkmcnt(0)" ::: "memory"); \
    _Pragma("unroll") for (int d = 0; d < 4; ++d) _Pragma("unroll") for (int r = 0; r < 16; ++r) o[d][r] *= al_l[crow(r, hi)]; } } while (0)
    f32x16 pA0, pA1, pB0, pB1; float mnA, mnB, alA, alB; bf16x8 pa0, pa1, pa2, pa3; const int NT = seq / KVBLK;
    constexpr int SE = 0, SO = 1;
    SLOAD(SE, 0); asm volatile("s_waitcnt vmcnt(0)" ::: "memory"); SWRITE(0, SE); __syncthreads();
    qkt<DQK>(pA0, pA1, K_lds, R_lds, qr, r32, hi); partialSM<DQK>(pA0, pA1, m_reg, mnA, alA);
    SLOAD(SO, KVBLK); if (2 < NT) SLOAD(SE, 2 * KVBLK);
    SWAIT(); SWRITE(1, SO); __syncthreads();
    for (int j = 1; j + 1 < NT; j += 2) {
        SBAR(); qkt<DQK>(pB0, pB1, K_lds + SHM_T, R_lds + SHM_T, qr, r32, hi);
        finishSM(pA0, pA1, alA, l_reg, pa0, pa1, pa2, pa3); SBAR();
        SLOAD(SO, (j + 2) * KVBLK); SBAR();
        pv_d0(o, vb0, pa0, pa1, pa2, pa3); partialSM<DQK>(pB0, pB1, m_reg, mnB, alB);
        __syncthreads(); SWAIT(); SWRITE(0, SE);
        RESC(alB); __syncthreads();
        SBAR(); qkt<DQK>(pA0, pA1, K_lds, R_lds, qr, r32, hi);
        finishSM(pB0, pB1, alB, l_reg, pa0, pa1, pa2, pa3); SBAR();
        if (j + 3 < NT) SLOAD(SE, (j + 3) * KVBLK); SBAR();
        pv_d0(o, vb0 + SHM_T, pa0, pa1, pa2, pa3); partialSM<DQK>(pA0, pA1, m_reg, mnA, alA);
        __syncthreads(); SWAIT(); SWRITE(1, SO);
        RESC(alA); __syncthreads();
    }
    SBAR(); qkt<DQK>(pB0, pB1, K_lds + SHM_T, R_lds + SHM_T, qr, r32, hi);
    finishSM(pA0, pA1, alA, l_reg, pa0, pa1, pa2, pa3); SBAR();
    pv_d0(o, vb0, pa0, pa1, pa2, pa3); partialSM<DQK>(pB0, pB1, m_reg, mnB, alB);
    __syncthreads(); RESC(alB);
    finishSM(pB0, pB1, alB, l_reg, pa0, pa1, pa2, pa3); SBAR();
    pv_d0(o, vb0 + SHM_T, pa0, pa1, pa2, pa3);
    if (hi == 0) li_l[r32] = l_reg; asm volatile("s_waitcnt lgkmcnt(0)" ::: "memory");
    float rli[16];
#pragma unroll
    for (int r = 0; r < 16; ++r) rli[r] = __builtin_amdgcn_rcpf(li_l[crow(r, hi)]);
    bf16_t* Ow = Ob + (long)(wid * QBLK) * LDO;
#pragma unroll
    for (int r = 0; r < 16; ++r) { const int orow = crow(r, hi);
#pragma unroll
        for (int d0 = 0; d0 < 4; ++d0) Ow[(long)orow * LDO + d0 * 32 + r32] = (bf16_t)(cvt_pk_bf16(o[d0][r] * rli[r], 0.f) & 0xffffu); }
    __syncthreads();
#undef SLOAD
#undef SWRITE
#undef SWAIT
#undef RESC
}
template <int DQK, int LDQ, int LDK, int LDV, int LDO>
__device__ __forceinline__ void attn_simple(const bf16_t* __restrict__ Qb, const bf16_t* __restrict__ Kh, const bf16_t* __restrict__ Rh, const bf16_t* __restrict__ Vh,
                                            bf16_t* __restrict__ Ob, int seq, LAS char* lds, const int tid) {
    constexpr int ND = DQK / 16;
    const int wid = tid >> 6, lane = tid & 63, r32 = lane & 31, hi = lane >> 5;
    LAS char* V_lds = lds; LAS char* K_lds = lds + 2 * SHM_T; LAS char* R_lds = lds + 4 * SHM_T;
    LAS float* wsl = (LAS float*)(lds + 4 * SHM_T + (DQK == 192 ? 2 * SHM_T : 0)) + wid * 64; LAS float* li_l = wsl; LAS float* al_l = wsl + 32;
    float m_reg = -1e30f, l_reg = 0; f32x16 o[4] = {}; bf16x8 qr[ND];
    const bf16_t* Qw = Qb + (long)(wid * QBLK + r32) * LDQ + hi * 8;
#pragma unroll
    for (int d0 = 0; d0 < ND; ++d0) qr[d0] = *reinterpret_cast<const bf16x8*>(Qw + d0 * 16);
    const int sr = tid >> 4, sc = (tid & 15) * 8, vst0 = v_st(sr, sc), vst1 = v_st(32 + sr, sc);
    const int rr = tid >> 3, rc = (tid & 7) * 8;
    const int vb0 = (int)(uintptr_t)V_lds + v_rd_base(lane);
    bf16x8 vs0, vs1, ks0, ks1, rs;
#define SLOAD(k0) do { vs0 = *reinterpret_cast<const bf16x8*>(&Vh[(long)((k0) + sr) * LDV + sc]); vs1 = *reinterpret_cast<const bf16x8*>(&Vh[(long)((k0) + 32 + sr) * LDV + sc]); \
    ks0 = *reinterpret_cast<const bf16x8*>(&Kh[(long)((k0) + sr) * LDK + sc]); ks1 = *reinterpret_cast<const bf16x8*>(&Kh[(long)((k0) + 32 + sr) * LDK + sc]); \
    if constexpr (DQK == 192) rs = *reinterpret_cast<const bf16x8*>(&Rh[(long)((k0) + rr) * 64 + rc]); } while (0)
#define SWRITE(b) do { *(LAS bf16x8*)(V_lds + (b) * SHM_T + vst0) = vs0; *(LAS bf16x8*)(V_lds + (b) * SHM_T + vst1) = vs1; const int kc = sc * 2; \
    *(LAS bf16x8*)(K_lds + (b) * SHM_T + KSWZ(sr, kc)) = ks0; *(LAS bf16x8*)(K_lds + (b) * SHM_T + KSWZ(32 + sr, kc)) = ks1; \
    if constexpr (DQK == 192) *(LAS bf16x8*)(R_lds + (b) * SHM_T + KSWZ(rr, rc * 2)) = rs; } while (0)
    const int NT = seq / KVBLK;
    SLOAD(0); asm volatile("s_waitcnt vmcnt(0)" ::: "memory"); SWRITE(0); __syncthreads();
    if (1 < NT) SLOAD(KVBLK);
    for (int j = 0; j < NT; ++j) {
        const int b = j & 1;
        f32x16 p0, p1; float mn, alpha; bf16x8 pa0, pa1, pa2, pa3;
        qkt<DQK>(p0, p1, K_lds + b * SHM_T, R_lds + b * SHM_T, qr, r32, hi);
        partialSM<DQK>(p0, p1, m_reg, mn, alpha);
        if (__any(alpha < 1.f)) { if (hi == 0) al_l[r32] = alpha; asm volatile("s_waitcnt lgkmcnt(0)" ::: "memory");
#pragma unroll
            for (int d = 0; d < 4; ++d)
#pragma unroll
                for (int r = 0; r < 16; ++r) o[d][r] *= al_l[crow(r, hi)]; }
        finishSM(p0, p1, alpha, l_reg, pa0, pa1, pa2, pa3);
        if (j + 1 < NT) SWRITE(b ^ 1);
        if (j + 2 < NT) SLOAD((j + 2) * KVBLK);
        pv_d0(o, vb0 + b * SHM_T, pa0, pa1, pa2, pa3);
        __syncthreads();
    }
    if (hi == 0) li_l[r32] = l_reg; asm volatile("s_waitcnt lgkmcnt(0)" ::: "memory");
    float rli[16];
#pragma unroll
    for (int r = 0; r < 16; ++r) rli[r] = __builtin_amdgcn_rcpf(li_l[crow(r, hi)]);
    bf16_t* Ow = Ob + (long)(wid * QBLK) * LDO;
#pragma unroll
    for (int r = 0; r < 16; ++r) { const int orow = crow(r, hi);
#pragma unroll
        for (int d0 = 0; d0 < 4; ++d0) Ow[(long)orow * LDO + d0 * 32 + r32] = (bf16_t)(cvt_pk_bf16(o[d0][r] * rli[r], 0.f) & 0xffffu); }
    __syncthreads();
#undef SLOAD
#undef SWRITE
}
#define RSWZ(row, colB) ((row) * 128 + ((colB) ^ ((((row) >> 1) & 7) << 4)))
template <int DQK>
__device__ __forceinline__ void qkt_dma(f32x16& p0, f32x16& p1, const LAS char* Ks, const LAS char* Rs, const bf16x8* qr, int r32, int hi) {
    p0 = f32x16{}; p1 = f32x16{};
#pragma unroll
    for (int d0 = 0; d0 < 8; ++d0) { const int cb = (d0 * 16 + hi * 8) * 2;
        const bf16x8 b0 = *reinterpret_cast<const LAS bf16x8*>(Ks + KSWZ(r32, cb));
        const bf16x8 b1 = *reinterpret_cast<const LAS bf16x8*>(Ks + KSWZ(32 + r32, cb));
        p0 = __builtin_amdgcn_mfma_f32_32x32x16_bf16(b0, qr[d0], p0, 0, 0, 0);
        p1 = __builtin_amdgcn_mfma_f32_32x32x16_bf16(b1, qr[d0], p1, 0, 0, 0); }
    if constexpr (DQK == 192) {
#pragma unroll
        for (int d0 = 0; d0 < 4; ++d0) { const int cb = (d0 * 16 + hi * 8) * 2;
            const bf16x8 b0 = *reinterpret_cast<const LAS bf16x8*>(Rs + RSWZ(r32, cb));
            const bf16x8 b1 = *reinterpret_cast<const LAS bf16x8*>(Rs + RSWZ(32 + r32, cb));
            p0 = __builtin_amdgcn_mfma_f32_32x32x16_bf16(b0, qr[8 + d0], p0, 0, 0, 0);
            p1 = __builtin_amdgcn_mfma_f32_32x32x16_bf16(b1, qr[8 + d0], p1, 0, 0, 0); }
    }
}
template <int DQK, int LDQ, int LDK, int LDV, int LDO>
__device__ __forceinline__ void attn_dma(const bf16_t* __restrict__ Qb, const bf16_t* __restrict__ Kh, const bf16_t* __restrict__ Rh, const bf16_t* __restrict__ Vh,
                                         bf16_t* __restrict__ Ob, int seq, LAS char* lds, LAS float* wscr, const int tid) {
    constexpr int ND = DQK / 16, KOFF = 0, VOFF = 3 * SHM_T, ROFF = 6 * SHM_T;
    const int wid = __builtin_amdgcn_readfirstlane(tid >> 6), lane = tid & 63, r32 = lane & 31, hi = lane >> 5;
    LAS float* li_l = wscr + wid * 64; LAS float* al_l = li_l + 32;
    float m_reg = -1e30f, l_reg = 0; f32x16 o[4] = {}; bf16x8 qr[ND];
    const bf16_t* Qw = Qb + (long)(wid * QBLK + r32) * LDQ + hi * 8;
#pragma unroll
    for (int d0 = 0; d0 < ND; ++d0) qr[d0] = *reinterpret_cast<const bf16x8*>(Qw + d0 * 16);
    unsigned voK[2], voV[2], voR;
#pragma unroll
    for (int i = 0; i < 2; ++i) { const int B = i * 8192 + wid * 1024 + lane * 16;
        { const int row = B >> 8, colB = (B & 255) ^ ((row & 7) << 4); voK[i] = (unsigned)(row * LDK * 2 + colB); }
        { const int sub = B >> 9, kk = (sub >> 2) * 8 + ((B & 511) >> 6), c = (sub & 3) * 32 + ((B & 63) >> 1); const int k = (kk & ~0xC) | ((kk & 4) << 1) | ((kk & 8) >> 1);
          voV[i] = (unsigned)((k * LDV + c) * 2); } }
    { const int B = wid * 1024 + lane * 16, row = B >> 7, colB = (B & 127) ^ (((row >> 1) & 7) << 4); voR = (unsigned)(row * 128 + colB); }
    const int vb0 = (int)(uintptr_t)lds + VOFF + v_rd_base(lane);
    const int NT = seq / KVBLK;
#define GLDS(gp, lp) __builtin_amdgcn_global_load_lds((const unsigned*)(gp), (LAS unsigned*)(lp), 16, 0, 0)
#define ISSUE(t, b) do { const char* kg_ = (const char*)Kh + (size_t)(t) * (KVBLK * LDK * 2); const char* vg_ = (const char*)Vh + (size_t)(t) * (KVBLK * LDV * 2); \
    LAS char* kl_ = lds + KOFF + (b) * SHM_T + wid * 1024; LAS char* vl_ = lds + VOFF + (b) * SHM_T + wid * 1024; \
    GLDS(kg_ + voK[0], kl_); GLDS(kg_ + voK[1], kl_ + 8192); GLDS(vg_ + voV[0], vl_); GLDS(vg_ + voV[1], vl_ + 8192); \
    if constexpr (DQK == 192) GLDS((const char*)Rh + (size_t)(t) * (KVBLK * 128) + voR, lds + ROFF + (b) * 8192 + wid * 1024); } while (0)
#define WAITV(n) asm volatile("s_waitcnt vmcnt(" #n ")" ::: "memory")
#define BARX() do { asm volatile("s_waitcnt lgkmcnt(0)" ::: "memory"); __builtin_amdgcn_s_barrier(); asm volatile("" ::: "memory"); SBAR(); } while (0)
#define RESC(a) do { if (__any((a) < 1.f)) { if (hi == 0) al_l[r32] = (a); asm volatile("s_waitcnt lgkmcnt(0)" ::: "memory"); \
    _Pragma("unroll") for (int d = 0; d < 4; ++d) _Pragma("unroll") for (int r = 0; r < 16; ++r) o[d][r] *= al_l[crow(r, hi)]; } } while (0)
    f32x16 pA0, pA1, pB0, pB1; float mnA, mnB, alA, alB; bf16x8 pa0, pa1, pa2, pa3;
    ISSUE(0, 0); ISSUE(1, 1); if (2 < NT) ISSUE(2, 2);
    if (2 < NT) { if constexpr (DQK == 192) WAITV(10); else WAITV(8); } else { if constexpr (DQK == 192) WAITV(5); else WAITV(4); }
    BARX();
    qkt_dma<DQK>(pA0, pA1, lds + KOFF, lds + ROFF, qr, r32, hi); partialSM<DQK>(pA0, pA1, m_reg, mnA, alA);
    if (2 < NT) { if constexpr (DQK == 192) WAITV(5); else WAITV(4); } else WAITV(0);
    BARX();
    int bp = 0, bc = 1;
#define STEP(j, C0, C1, mnC, alC, P0, P1, alP) do { \
    SBAR(); qkt_dma<DQK>(C0, C1, lds + KOFF + bc * SHM_T, lds + ROFF + bc * 8192, qr, r32, hi); \
    finishSM(P0, P1, alP, l_reg, pa0, pa1, pa2, pa3); SBAR(); \
    pv_d0(o, vb0 + bp * SHM_T, pa0, pa1, pa2, pa3); partialSM<DQK>(C0, C1, m_reg, mnC, alC); \
    WAITV(0); BARX(); \
    if ((j) + 2 < NT) ISSUE((j) + 2, bp); \
    RESC(alC); \
    bp = bc; bc = (bc == 2) ? 0 : bc + 1; } while (0)
    for (int j = 1; j + 1 < NT; j += 2) {
        STEP(j, pB0, pB1, mnB, alB, pA0, pA1, alA);
        STEP(j + 1, pA0, pA1, mnA, alA, pB0, pB1, alB);
    }
    STEP(NT - 1, pB0, pB1, mnB, alB, pA0, pA1, alA);
    finishSM(pB0, pB1, alB, l_reg, pa0, pa1, pa2, pa3); SBAR();
    pv_d0(o, vb0 + bp * SHM_T, pa0, pa1, pa2, pa3);
    if (hi == 0) li_l[r32] = l_reg; asm volatile("s_waitcnt lgkmcnt(0)" ::: "memory");
    float rli[16];
#pragma unroll
    for (int r = 0; r < 16; ++r) rli[r] = __builtin_amdgcn_rcpf(li_l[crow(r, hi)]);
    bf16_t* Ow = Ob + (long)(wid * QBLK) * LDO;
#pragma unroll
    for (int r = 0; r < 16; ++r) { const int orow = crow(r, hi);
#pragma unroll
        for (int d0 = 0; d0 < 4; ++d0) Ow[(long)orow * LDO + d0 * 32 + r32] = (bf16_t)(cvt_pk_bf16(o[d0][r] * rli[r], 0.f) & 0xffffu); }
    BARX();
#undef GLDS
#undef ISSUE
#undef WAITV
#undef BARX
#undef RESC
#undef STEP
}
}

struct Params {
    const float* in[32];
    float* out; unsigned char* ws;
    int ph_lo, ph_hi;
};
enum { I_XP = 0, I_XS, I_C, I_CAK, I_CAV, I_SRF, I_SRB, I_CCKV, I_CKR, I_CCTX, I_WMOD, I_BMOD, I_GPMIX, I_GPOMIX, I_GPMLP, I_GPOMLP, I_WIN, I_AQN, I_AKN, I_RDF, I_RDB, I_RGN,
       I_MQN, I_MKVN, I_WUQ, I_WUKV, I_WBA, I_WBB, I_WBC, I_WOUT, I_WUP, I_WDN };
constexpr size_t O_YP = 0, O_YS = 8388608, O_NAK = 25165824, O_NAV = O_NAK + 4194304, O_NRF = O_NAV + 4194304, O_NRB = O_NRF + 8388608, O_NCKV = O_NRB + 8388608, O_NKR = O_NCKV + 4194304, O_END = O_NKR + 1048576;

typedef const __attribute__((address_space(4))) Params CParams;
struct Ctx {
    LAS unsigned char* lds; int tid, lane, wave, bid, G;
    CParams* p;
};

struct TItem { const float* W; bf16_t* WT; int K, N, ldw, shift_from, shift; };
__device__ __forceinline__ void ti_load(f32x4 (&v)[8], const TItem& t, int item, int lane) {
    const int nblk = t.N / 32, kb = item / nblk, nb = item - kb * nblk, k0 = 64 * kb, n0 = 32 * nb;
    const float* p = t.W + (size_t)(k0 + (lane >> 3)) * t.N + n0 + (lane & 7) * 4;
#pragma unroll
    for (int i = 0; i < 8; ++i) v[i] = *(const f32x4*)(p + (size_t)(8 * i) * t.N);
}
__device__ __forceinline__ void ti_store(const f32x4 (&v)[8], const TItem& t, int item, int lane, LAS float* scr) {
    const int nblk = t.N / 32, kb = item / nblk, nb = item - kb * nblk, k0 = 64 * kb, n0 = 32 * nb;
#pragma unroll
    for (int i = 0; i < 8; ++i) { LAS float* s = scr + (8 * i + (lane >> 3)) * 33 + (lane & 7) * 4; s[0] = v[i][0]; s[1] = v[i][1]; s[2] = v[i][2]; s[3] = v[i][3]; }
    LDS_WAIT(); asm volatile("" ::: "memory");
    const int c = lane & 7; const int r0 = n0 + (n0 >= t.shift_from ? t.shift : 0);
#pragma unroll
    for (int j = 0; j < 4; ++j) { const int n = (lane >> 3) + 8 * j; const LAS float* s = scr + (8 * c) * 33 + n;
        u32x4 o; o.x = cvt_pk_bf16(s[0 * 33], s[1 * 33]); o.y = cvt_pk_bf16(s[2 * 33], s[3 * 33]); o.z = cvt_pk_bf16(s[4 * 33], s[5 * 33]); o.w = cvt_pk_bf16(s[6 * 33], s[7 * 33]);
        *(u32x4*)(t.WT + (size_t)(r0 + n) * t.ldw + k0 + 8 * c) = o; }
    LDS_WAIT(); asm volatile("" ::: "memory");
}
__device__ __forceinline__ TItem ti_decode(CParams& P, unsigned char* ws, int l, int& r) {
    constexpr int I_IN = 32 * 362, I_UQ = 8 * 48, I_UKV = 4 * 64, I_BR = 16 * 64, I_OUT = 32 * 64, I_UP = 32 * 256;
    if (r < I_IN) return TItem{P.in[I_WIN] + (size_t)l * 2048 * 11584, (bf16_t*)(ws + WS_WIN + l * SZ_WIN), 2048, 11584, LDH, 5440, 192}; r -= I_IN;
    if (r < I_UQ) return TItem{P.in[I_WUQ] + (size_t)l * 512 * 1536, (bf16_t*)(ws + WS_WUQ + l * SZ_WUQ), 512, 1536, 512, 1 << 30, 0}; r -= I_UQ;
    if (r < I_UKV) return TItem{P.in[I_WUKV] + (size_t)l * 256 * 2048, (bf16_t*)(ws + WS_WUKV + l * SZ_WUKV), 256, 2048, 256, 1 << 30, 0}; r -= I_UKV;
    if (r < 3 * I_BR) { const int z = r / I_BR; r -= z * I_BR; return TItem{P.in[I_WBA + z] + (size_t)l * 1024 * 2048, (bf16_t*)(ws + WS_WBR + (l * 3 + z) * SZ_WBR1), 1024, 2048, LDO, 1 << 30, 0}; } r -= 3 * I_BR;
    if (r < I_OUT) return TItem{P.in[I_WOUT] + (size_t)l * 2048 * 2048, (bf16_t*)(ws + WS_WOUT + l * SZ_WOUT), 2048, 2048, LDH, 1 << 30, 0}; r -= I_OUT;
    if (r < I_UP) return TItem{P.in[I_WUP] + (size_t)l * 2048 * 8192, (bf16_t*)(ws + WS_WUP + l * SZ_WUP), 2048, 8192, LDH, 1 << 30, 0}; r -= I_UP;
    return TItem{P.in[I_WDN] + (size_t)l * 8192 * 2048, (bf16_t*)(ws + WS_WDN + l * SZ_WDN), 8192, 2048, LDU, 1 << 30, 0};
}
__device__ __forceinline__ void convert_layer(const Ctx& F, const int l, const int b0, const int nb, const bool do_mod, const int it_lo, const int it_hi) {
    CParams& P = *F.p; unsigned char* ws = P.ws; const int bi = F.bid - b0;
    if (do_mod) {
        LAS float* sv = (LAS float*)F.lds;
        LAS float* red = (LAS float*)(F.lds + 32768);
        for (int i = F.tid; i < 3 * 2048; i += NTHR) { const int v = i >> 11, k = i & 2047; const float x = (v == 0) ? P.in[I_CCTX][k] : P.in[I_C][(v - 1) * 2048 + k]; sv[i] = siluf_(x); }
        __syncthreads();
        float* MOD = (float*)(ws + WS_MOD);
        const int c4 = F.tid & 15, kq = F.tid >> 4;
        for (int cg = bi; cg < 192; cg += nb) {
            const float* w = P.in[I_WMOD] + (size_t)l * 2048 * 12288 + cg * 64 + c4 * 4;
            f32x4 a0 = {0, 0, 0, 0}, a1 = a0, a2 = a0;
#pragma unroll 8
            for (int kk = 0; kk < 64; ++kk) { const int k = kq + 32 * kk; const f32x4 wv = *(const f32x4*)(w + (size_t)k * 12288);
                a0 += wv * sv[k]; a1 += wv * sv[2048 + k]; a2 += wv * sv[4096 + k]; }
#pragma unroll
            for (int j = 0; j < 4; ++j) { red[(kq * 3 + 0) * 64 + c4 * 4 + j] = a0[j]; red[(kq * 3 + 1) * 64 + c4 * 4 + j] = a1[j]; red[(kq * 3 + 2) * 64 + c4 * 4 + j] = a2[j]; }
            __syncthreads();
            if (F.tid < 192) { const int v = F.tid >> 6, col = F.tid & 63; float s = 0.f;
#pragma unroll 8
                for (int q = 0; q < 32; ++q) s += red[(q * 3 + v) * 64 + col];
                MOD[((size_t)l * 3 + v) * 12288 + cg * 64 + col] = s + P.in[I_BMOD][(size_t)l * 12288 + cg * 64 + col]; }
            __syncthreads();
        }
    }
    {
        LAS float* scr = (LAS float*)(F.lds + F.wave * 16384);
        const int gw = bi * NWAVES + F.wave, NGW = nb * NWAVES;
        const int PER_L = it_hi;
        f32x4 va[8], vb[8], vc[8];
#define TI_LOAD(buf, itx) do { if ((itx) < PER_L) { int r_ = (itx); const TItem t_ = ti_decode(P, ws, l, r_); ti_load(buf, t_, r_, F.lane); } } while (0)
#define TI_STORE(buf, itx) do { if ((itx) < PER_L) { int r_ = (itx); const TItem t_ = ti_decode(P, ws, l, r_); ti_store(buf, t_, r_, F.lane, scr); } } while (0)
        TI_LOAD(va, it_lo + gw); TI_LOAD(vb, it_lo + gw + NGW);
        for (int it = it_lo + gw; it < PER_L; it += 3 * NGW) {
            TI_LOAD(vc, it + 2 * NGW); TI_STORE(va, it);
            TI_LOAD(va, it + 3 * NGW); TI_STORE(vb, it + NGW);
            TI_LOAD(vb, it + 4 * NGW); TI_STORE(vc, it + 2 * NGW);
        }
#undef TI_LOAD
#undef TI_STORE
    }
}

struct NRow { f32x4 x[8]; u32x2 pa[8], pb[8]; };
__device__ __forceinline__ void nrow_load(NRow& R, int r, int lane, const float* xin_ctx, const float* xin_lat, const bf16_t* o0, const bf16_t* o1) {
    const float* xr = r < NCTX ? xin_ctx + (size_t)r * DM : xin_lat + (size_t)(r - NCTX) * DM;
#pragma unroll
    for (int j = 0; j < 8; ++j) R.x[j] = *(const f32x4*)(xr + (lane + 64 * j) * 4);
    if (o0) {
#pragma unroll
        for (int j = 0; j < 8; ++j) { R.pa[j] = *(const u32x2*)(o0 + (size_t)r * DM + (lane + 64 * j) * 4); R.pb[j] = *(const u32x2*)(o1 + (size_t)r * DM + (lane + 64 * j) * 4); }
    }
}
__device__ __forceinline__ void norm_phase(const Ctx& F, const float* xin_ctx, const float* xin_lat, const bf16_t* o0, const bf16_t* o1, float* X, bf16_t* H,
                                           const float* modA, int gate_off, const float* gA, const float* modB, int scale_off, int shift_off, const float* gB) {
    const int gw = F.bid * NWAVES + F.wave, NGW = F.G * NWAVES;
    NRow cur, nxt;
    if (gw < NTOK) nrow_load(cur, gw, F.lane, xin_ctx, xin_lat, o0, o1);
    for (int r = gw; r < NTOK; r += NGW) {
        if (r + NGW < NTOK) nrow_load(nxt, r + NGW, F.lane, xin_ctx, xin_lat, o0, o1);
        const int v = r < NCTX ? 0 : 1 + ((r - NCTX) >> 12);
        f32x4 x[8];
#pragma unroll
        for (int j = 0; j < 8; ++j) x[j] = cur.x[j];
        if (o0) {
            f32x4 o[8]; float ss = 0.f;
#pragma unroll
            for (int j = 0; j < 8; ++j) { const u32x2 pa = cur.pa[j], pb = cur.pb[j];
                o[j] = (f32x4){bf_lo(pa.x) + bf_lo(pb.x), bf_hi(pa.x) + bf_hi(pb.x), bf_lo(pa.y) + bf_lo(pb.y), bf_hi(pa.y) + bf_hi(pb.y)};
                ss += (o[j][0] * o[j][0] + o[j][1] * o[j][1]) + (o[j][2] * o[j][2] + o[j][3] * o[j][3]); }
            const float rs = 1.0f / sqrtf(wave_sum(ss) * (1.0f / DM) + EPS);
#pragma unroll
            for (int j = 0; j < 8; ++j) { const int c = (F.lane + 64 * j) * 4; const f32x4 ga = *(const f32x4*)(gA + c), gt = *(const f32x4*)(modA + (size_t)v * 12288 + gate_off + c);
                x[j] += gt * (o[j] * rs * ga); }
        }
        if (X) {
#pragma unroll
            for (int j = 0; j < 8; ++j) *(f32x4*)(X + (size_t)r * DM + (F.lane + 64 * j) * 4) = x[j]; }
        if (gB) {
            float ss = 0.f;
#pragma unroll
            for (int j = 0; j < 8; ++j) ss += (x[j][0] * x[j][0] + x[j][1] * x[j][1]) + (x[j][2] * x[j][2] + x[j][3] * x[j][3]);
            const float rs = 1.0f / sqrtf(wave_sum(ss) * (1.0f / DM) + EPS);
#pragma unroll
            for (int j = 0; j < 8; ++j) { const int c = (F.lane + 64 * j) * 4; const f32x4 gb = *(const f32x4*)(gB + c);
                const f32x4 sc = *(const f32x4*)(modB + (size_t)v * 12288 + scale_off + c), sh = *(const f32x4*)(modB + (size_t)v * 12288 + shift_off + c);
                const f32x4 h = (x[j] * rs * gb) * (sc + 1.0f) + sh;
                u32x2 w; w.x = cvt_pk_bf16(h[0], h[1]); w.y = cvt_pk_bf16(h[2], h[3]);
                *(u32x2*)(H + (size_t)r * LDH + c) = w; }
        }
        cur = nxt;
    }
}

struct RopeCS { float c0, s0, c1, s1; };
__device__ __forceinline__ RopeCS rope_cs128(int lane, int prow, int pcol) {
    const int i0 = (2 * lane) & 31; const float pos = (float)((lane >> 5) ? pcol : prow);
    const float r0 = pos * __builtin_amdgcn_exp2f(-(float)i0 * (13.287712379549449f / 32.0f)) * 0.15915494309189535f;
    const float r1 = pos * __builtin_amdgcn_exp2f(-(float)(i0 + 1) * (13.287712379549449f / 32.0f)) * 0.15915494309189535f;
    RopeCS t; t.c0 = __builtin_amdgcn_cosf(r0); t.s0 = __builtin_amdgcn_sinf(r0); t.c1 = __builtin_amdgcn_cosf(r1); t.s1 = __builtin_amdgcn_sinf(r1);
    if ((lane & 16) == 0) { t.s0 = -t.s0; t.s1 = -t.s1; }
    return t;
}
__device__ __forceinline__ RopeCS rope_cs64(int g, int prow, int pcol) {
    const int i0 = (2 * g) & 15; const float pos = (float)((g >> 4) ? pcol : prow);
    const float r0 = pos * __builtin_amdgcn_exp2f(-(float)i0 * (13.287712379549449f / 16.0f)) * 0.15915494309189535f;
    const float r1 = pos * __builtin_amdgcn_exp2f(-(float)(i0 + 1) * (13.287712379549449f / 16.0f)) * 0.15915494309189535f;
    RopeCS t; t.c0 = __builtin_amdgcn_cosf(r0); t.s0 = __builtin_amdgcn_sinf(r0); t.c1 = __builtin_amdgcn_cosf(r1); t.s1 = __builtin_amdgcn_sinf(r1);
    if ((g & 8) == 0) { t.s0 = -t.s0; t.s1 = -t.s1; }
    return t;
}
__device__ __forceinline__ void rope128(float& y0, float& y1, const RopeCS& t) { const float p0 = swz_xor<16>(y0), p1 = swz_xor<16>(y1); y0 = y0 * t.c0 + p0 * t.s0; y1 = y1 * t.c1 + p1 * t.s1; }
__device__ __forceinline__ void rope64(float& y0, float& y1, const RopeCS& t) { const float p0 = swz_xor<8>(y0), p1 = swz_xor<8>(y1); y0 = y0 * t.c0 + p0 * t.s0; y1 = y1 * t.c1 + p1 * t.s1; }
struct PPRow { unsigned uq[10], uv[2], ub[8], ukr; u32x4 ucq; u32x2 ukv; };
__device__ __forceinline__ void pp_load(PPRow& R, const unsigned* P32, int lane) {
#pragma unroll
    for (int hd = 0; hd < 10; ++hd) R.uq[hd] = P32[hd * 64 + lane];
#pragma unroll
    for (int j = 0; j < 2; ++j) R.uv[j] = P32[C_AV / 2 + j * 64 + lane];
#pragma unroll
    for (int hd = 0; hd < 8; ++hd) R.ub[hd] = P32[C_BQ / 2 + hd * 64 + lane];
    R.ucq = *(const u32x4*)(P32 + C_CQL / 2 + 4 * lane); R.ukv = *(const u32x2*)(P32 + C_CKV / 2 + 2 * lane); R.ukr = P32[C_CKR / 2 + (lane & 31)];
}
template <bool DRY>
__device__ __forceinline__ void phase_postproj(const Ctx& F, int l) {
    CParams& P = *F.p; unsigned char* ws = P.ws;
    bf16_t* PROJ = (bf16_t*)(ws + WS_PROJ); bf16_t* KA = (bf16_t*)(ws + WS_KA); bf16_t* VA = (bf16_t*)(ws + WS_VA); bf16_t* CKV = (bf16_t*)(ws + WS_CKV); bf16_t* KR = (bf16_t*)(ws + WS_KROPE);
    const int gw = F.bid * NWAVES + F.wave, NGW = F.G * NWAVES, lane = F.lane;
    const f32x2 qn = *(const f32x2*)(P.in[I_AQN] + l * 128 + 2 * lane), kn = *(const f32x2*)(P.in[I_AKN] + l * 128 + 2 * lane);
    const f32x4 mq0 = *(const f32x4*)(P.in[I_MQN] + l * 512 + 8 * lane), mq1 = *(const f32x4*)(P.in[I_MQN] + l * 512 + 8 * lane + 4), mkv = *(const f32x4*)(P.in[I_MKVN] + l * 256 + 4 * lane);
    PPRow cur, nxt;
    if (gw < NTOK) pp_load(cur, (const unsigned*)(PROJ + (size_t)gw * LDP), lane);
    for (int r = gw; r < NTOK; r += NGW) {
        if (r + NGW < NTOK) pp_load(nxt, (const unsigned*)(PROJ + (size_t)(r + NGW) * LDP), lane);
        const bool lat = r >= NCTX; const int lr = r - NCTX, b = lr >> 12, n = lr & 4095, prow = n >> 6, pcol = n & 63;
        const int arow = lat ? NCTX + b * KVL + n : r;
        const int cb = r >> 8, cs = r & 255;
        unsigned* P32 = DRY ? (unsigned*)((bf16_t*)(ws + WS_PART) + (size_t)r * 5632) : (unsigned*)(PROJ + (size_t)r * LDP);
        RopeCS t128, t64;
        if (lat) { t128 = rope_cs128(lane, prow, pcol); t64 = rope_cs64(lane & 31, prow, pcol); }
        float y0[10], y1[10], ss[10];
#pragma unroll
        for (int hd = 0; hd < 10; ++hd) { y0[hd] = bf_lo(cur.uq[hd]); y1[hd] = bf_hi(cur.uq[hd]); ss[hd] = y0[hd] * y0[hd] + y1[hd] * y1[hd]; }
#pragma unroll
        for (int hd = 0; hd < 10; ++hd) ss[hd] = wave_sum(ss[hd]);
#pragma unroll
        for (int hd = 0; hd < 10; ++hd) {
            const float rs = 1.0f / sqrtf(ss[hd] * (1.0f / 128.0f) + EPS); const f32x2 gn = hd < 8 ? qn : kn;
            float a0 = y0[hd] * rs * gn[0], a1 = y1[hd] * rs * gn[1];
            if (lat) rope128(a0, a1, t128);
            if (hd < 8) P32[hd * 64 + lane] = cvt_pk_bf16(a0, a1);
            else { const int kvh = hd - 8; ((unsigned*)(KA + (size_t)arow * 256))[kvh * 64 + lane] = cvt_pk_bf16(a0, a1);
                if (!lat) *(f32x2*)(P.out + O_NAK + (((size_t)cb * 4 + l) * 256 + cs) * 256 + kvh * 128 + 2 * lane) = (f32x2){a0, a1}; }
        }
#pragma unroll
        for (int j = 0; j < 2; ++j) { const unsigned u = cur.uv[j]; ((unsigned*)(VA + (size_t)arow * 256))[j * 64 + lane] = u;
            if (!lat) *(f32x2*)(P.out + O_NAV + (((size_t)cb * 4 + l) * 256 + cs) * 256 + j * 128 + 2 * lane) = (f32x2){bf_lo(u), bf_hi(u)}; }
#pragma unroll
        for (int hd = 0; hd < 8; ++hd) {
            if (!lat && hd < 4) continue;
            float a0 = bf_lo(cur.ub[hd]), a1 = bf_hi(cur.ub[hd]);
            if (lat) rope128(a0, a1, t128);
            if (hd >= 4) { a0 *= 0.08838834764831845f; a1 *= 0.08838834764831845f; }
            P32[C_BQ / 2 + hd * 64 + lane] = cvt_pk_bf16(a0, a1);
        }
        { u32x4 u = cur.ucq;
          float y[8] = {bf_lo(u.x), bf_hi(u.x), bf_lo(u.y), bf_hi(u.y), bf_lo(u.z), bf_hi(u.z), bf_lo(u.w), bf_hi(u.w)}; float s2 = 0.f;
#pragma unroll
          for (int i = 0; i < 8; ++i) s2 += y[i] * y[i];
          const float rs = 1.0f / sqrtf(wave_sum(s2) * (1.0f / 512.0f) + EPS);
          u.x = cvt_pk_bf16(y[0] * rs * mq0[0], y[1] * rs * mq0[1]); u.y = cvt_pk_bf16(y[2] * rs * mq0[2], y[3] * rs * mq0[3]);
          u.z = cvt_pk_bf16(y[4] * rs * mq1[0], y[5] * rs * mq1[1]); u.w = cvt_pk_bf16(y[6] * rs * mq1[2], y[7] * rs * mq1[3]);
          *(u32x4*)(P32 + C_CQL / 2 + 4 * lane) = u; }
        { const u32x2 u = cur.ukv;
          float y[4] = {bf_lo(u.x), bf_hi(u.x), bf_lo(u.y), bf_hi(u.y)};
          const float rs = 1.0f / sqrtf(wave_sum((y[0] * y[0] + y[1] * y[1]) + (y[2] * y[2] + y[3] * y[3])) * (1.0f / 256.0f) + EPS);
#pragma unroll
          for (int i = 0; i < 4; ++i) y[i] *= rs * mkv[i];
          u32x2 w; w.x = cvt_pk_bf16(y[0], y[1]); w.y = cvt_pk_bf16(y[2], y[3]);
          *(u32x2*)(CKV + (size_t)arow * 256 + 4 * lane) = w;
          if (!lat) *(f32x4*)(P.out + O_NCKV + (((size_t)cb * 4 + l) * 256 + cs) * 256 + 4 * lane) = (f32x4){y[0], y[1], y[2], y[3]}; }
        { float a0 = bf_lo(cur.ukr), a1 = bf_hi(cur.ukr);
          if (lat) rope64(a0, a1, t64);
          if (lane < 32) { ((unsigned*)(KR + (size_t)arow * 64))[lane] = cvt_pk_bf16(a0, a1);
              if (!lat) *(f32x2*)(P.out + O_NKR + (((size_t)cb * 4 + l) * 256 + cs) * 64 + 2 * lane) = (f32x2){a0, a1}; } }
        cur = nxt;
    }
    for (int r = gw; r < 1024; r += NGW) {
        const int b = r >> 9, j = r & 511; const size_t arow = NCTX + (size_t)b * KVL + 4096 + j; const size_t src = ((size_t)b * 4 + l) * 512 + j;
        { const f32x4 k = *(const f32x4*)(P.in[I_CAK] + src * 256 + 4 * lane), v = *(const f32x4*)(P.in[I_CAV] + src * 256 + 4 * lane), c = *(const f32x4*)(P.in[I_CCKV] + src * 256 + 4 * lane);
          u32x2 w; w.x = cvt_pk_bf16(k[0], k[1]); w.y = cvt_pk_bf16(k[2], k[3]); *(u32x2*)(KA + arow * 256 + 4 * lane) = w;
          w.x = cvt_pk_bf16(v[0], v[1]); w.y = cvt_pk_bf16(v[2], v[3]); *(u32x2*)(VA + arow * 256 + 4 * lane) = w;
          w.x = cvt_pk_bf16(c[0], c[1]); w.y = cvt_pk_bf16(c[2], c[3]); *(u32x2*)(CKV + arow * 256 + 4 * lane) = w; }
        if (lane < 16) { const f32x4 k = *(const f32x4*)(P.in[I_CKR] + src * 64 + 4 * lane); u32x2 w; w.x = cvt_pk_bf16(k[0], k[1]); w.y = cvt_pk_bf16(k[2], k[3]); *(u32x2*)(KR + arow * 64 + 4 * lane) = w; }
    }
}

__device__ __forceinline__ float log_sigmoid_(float x) { return -__logf(1.0f + __expf(-x)); }
template <int SCALE_MODE>
__device__ __forceinline__ void stage_vtile(LAS char* dst, const bf16_t* src, int ld, int tid, float lg2, int jbase) {
#pragma unroll
    for (int i = 0; i < 2; ++i) { const int p = tid + 512 * i, k = p >> 4, c8 = (p & 15) * 8;
        u32x4 u = *(const u32x4*)(src + (size_t)k * ld + c8);
        if (SCALE_MODE != 0) { const float jj = (float)(jbase + k); const float f = __builtin_amdgcn_exp2f(lg2 * (SCALE_MODE == 1 ? (127.0f - jj) : jj));
            u.x = cvt_pk_bf16(bf_lo(u.x) * f, bf_hi(u.x) * f); u.y = cvt_pk_bf16(bf_lo(u.y) * f, bf_hi(u.y) * f); u.z = cvt_pk_bf16(bf_lo(u.z) * f, bf_hi(u.z) * f); u.w = cvt_pk_bf16(bf_lo(u.w) * f, bf_hi(u.w) * f); }
        *(LAS u32x4*)(dst + att::v_st(k, c8)) = u; }
}
__device__ __forceinline__ void ret_kv_unit(const Ctx& F, int l, int u) {
    CParams& P = *F.p; unsigned char* ws = P.ws;
    const int c = u >> 2, h = u & 3, row0 = c * 128, tid = F.tid, lane = F.lane, w = F.wave;
    const bf16_t* PROJ = (const bf16_t*)(ws + WS_PROJ);
    const float lgf2 = log_sigmoid_(P.in[I_RDF][l * 4 + h]) * 1.4426950408889634f, lgb2 = log_sigmoid_(P.in[I_RDB][l * 4 + h]) * 1.4426950408889634f;
    LAS char* lds = (LAS char*)F.lds;
#pragma nounroll
    for (int jt = 0; jt < 2; ++jt) {
        const bf16_t* ksrc = PROJ + (size_t)(row0 + jt * 64) * LDP + C_BK + h * 128;
        stage_vtile<1>(lds + jt * 16384, ksrc, LDP, tid, lgf2, jt * 64);
        stage_vtile<2>(lds + 32768 + jt * 16384, ksrc, LDP, tid, lgb2, jt * 64);
#pragma nounroll
        for (int eh = 0; eh < 2; ++eh) stage_vtile<0>(lds + 65536 + (jt * 2 + eh) * 16384, PROJ + (size_t)(row0 + jt * 64) * LDP + C_BV + h * 256 + eh * 128, LDP, tid, 0.f, 0);
    }
    __syncthreads();
    const int dblk = w & 3, eh = w >> 2;
    f32x16 accF[4] = {}, accB[4] = {};
#pragma nounroll
    for (int jt = 0; jt < 2; ++jt) {
        const int vbF = (int)(uintptr_t)lds + jt * 16384 + att::v_rd_base(lane) + dblk * 512, vbB = 32768 + vbF, vbV = 65536 + (jt * 2 + eh) * 16384 + att::v_rd_base(lane);
#define KVSTEP(KS) do { \
        const s16x4 fl = att::tr_read<att::v_rd_off(0, KS, 0)>(vbF), fh = att::tr_read<att::v_rd_off(0, KS, 1)>(vbF), bl = att::tr_read<att::v_rd_off(0, KS, 0)>(vbB), bh = att::tr_read<att::v_rd_off(0, KS, 1)>(vbB); \
        const s16x4 v0l = att::tr_read<att::v_rd_off(0, KS, 0)>(vbV), v0h = att::tr_read<att::v_rd_off(0, KS, 1)>(vbV), v1l = att::tr_read<att::v_rd_off(1, KS, 0)>(vbV), v1h = att::tr_read<att::v_rd_off(1, KS, 1)>(vbV); \
        const s16x4 v2l = att::tr_read<att::v_rd_off(2, KS, 0)>(vbV), v2h = att::tr_read<att::v_rd_off(2, KS, 1)>(vbV), v3l = att::tr_read<att::v_rd_off(3, KS, 0)>(vbV), v3h = att::tr_read<att::v_rd_off(3, KS, 1)>(vbV); \
        asm volatile("s_waitcnt lgkmcnt(0)" ::: "memory"); SBAR(); \
        const bf16x8 af = PKLH(fl, fh), ab = PKLH(bl, bh), b0 = PKLH(v0l, v0h), b1 = PKLH(v1l, v1h), b2 = PKLH(v2l, v2h), b3 = PKLH(v3l, v3h); \
        accF[0] = __builtin_amdgcn_mfma_f32_32x32x16_bf16(af, b0, accF[0], 0, 0, 0); accB[0] = __builtin_amdgcn_mfma_f32_32x32x16_bf16(ab, b0, accB[0], 0, 0, 0); \
        accF[1] = __builtin_amdgcn_mfma_f32_32x32x16_bf16(af, b1, accF[1], 0, 0, 0); accB[1] = __builtin_amdgcn_mfma_f32_32x32x16_bf16(ab, b1, accB[1], 0, 0, 0); \
        accF[2] = __builtin_amdgcn_mfma_f32_32x32x16_bf16(af, b2, accF[2], 0, 0, 0); accB[2] = __builtin_amdgcn_mfma_f32_32x32x16_bf16(ab, b2, accB[2], 0, 0, 0); \
        accF[3] = __builtin_amdgcn_mfma_f32_32x32x16_bf16(af, b3, accF[3], 0, 0, 0); accB[3] = __builtin_amdgcn_mfma_f32_32x32x16_bf16(ab, b3, accB[3], 0, 0, 0); } while (0)
        KVSTEP(0); KVSTEP(1); KVSTEP(2); KVSTEP(3);
#undef KVSTEP
    }
    float* RKV = (float*)(ws + WS_RKV) + ((size_t)(c * 4 + h) * 2) * RET_ST;
    const int r32 = lane & 31, hi = lane >> 5;
#pragma unroll
    for (int r = 0; r < 16; ++r) { const int d = dblk * 32 + att::crow(r, hi);
#pragma unroll
        for (int eb = 0; eb < 4; ++eb) { const int e = eh * 128 + eb * 32 + r32; RKV[(size_t)d * 256 + e] = accF[eb][r]; RKV[RET_ST + (size_t)d * 256 + e] = accB[eb][r]; } }
    __syncthreads();
}
__device__ __forceinline__ void phase_scan(const Ctx& F, int l, bool do_rope) {
    CParams& P = *F.p; unsigned char* ws = P.ws;
    float* RKV = (float*)(ws + WS_RKV); bf16_t* RS = (bf16_t*)(ws + WS_RS);
    for (int it = F.bid; it < 2304; it += F.G) {
        const bool lat = it < 256; const int q = lat ? it : it - 256; const int combo = q >> 4, slab = q & 15;
        const int dir = combo & 1, h = (combo >> 1) & 3, sb = combo >> 3; const size_t e0 = (size_t)slab * 2048 + F.tid * 4;
        const float cd = __expf(128.0f * log_sigmoid_(P.in[dir ? I_RDB : I_RDF][l * 4 + h]));
        if (lat) {
            f32x4 s = *(const f32x4*)(P.in[dir ? I_SRB : I_SRF] + (((size_t)sb * 4 + l) * 4 + h) * RET_ST + e0);
#pragma nounroll
            for (int t0 = 0; t0 < 32; t0 += 8) { f32x4 kv[8];
#pragma unroll
                for (int q = 0; q < 8; ++q) { const int n = dir ? 31 - (t0 + q) : (t0 + q); kv[q] = *(const f32x4*)(RKV + ((size_t)((32 + sb * 32 + n) * 4 + h) * 2 + dir) * RET_ST + e0); }
#pragma unroll
                for (int q = 0; q < 8; ++q) { const int n = dir ? 31 - (t0 + q) : (t0 + q); const size_t base = ((size_t)((32 + sb * 32 + n) * 4 + h) * 2 + dir) * RET_ST + e0;
                    u32x2 w; w.x = cvt_pk_bf16(s[0], s[1]); w.y = cvt_pk_bf16(s[2], s[3]); *(u32x2*)(RS + base) = w;
                    s = s * cd + kv[q]; } }
        } else {
            f32x4 s = {0.f, 0.f, 0.f, 0.f};
#pragma unroll
            for (int t = 0; t < 2; ++t) { const int n = dir ? 1 - t : t; const size_t base = ((size_t)((sb * 2 + n) * 4 + h) * 2 + dir) * RET_ST + e0;
                u32x2 w; w.x = cvt_pk_bf16(s[0], s[1]); w.y = cvt_pk_bf16(s[2], s[3]); *(u32x2*)(RS + base) = w;
                s = s * cd + *(const f32x4*)(RKV + base); }
            *(f32x4*)(P.out + (dir ? O_NRB : O_NRF) + (((size_t)sb * 4 + l) * 4 + h) * RET_ST + e0) = s;
        }
    }
    bf16_t* CQ = (bf16_t*)(ws + WS_CQ);
    const int gw = F.bid * NWAVES + F.wave, NGW = F.G * NWAVES, lane = F.lane;
    if (do_rope) for (int r = NCTX + gw; r < NTOK; r += NGW) {
        const int n = (r - NCTX) & 4095, prow = n >> 6, pcol = n & 63; const RopeCS t64 = rope_cs64(lane & 31, prow, pcol);
        unsigned uu[4];
#pragma unroll
        for (int j = 0; j < 4; ++j) uu[j] = *((const unsigned*)(CQ + (size_t)r * LDCQ + ((lane >> 5) + 2 * j) * 192 + 128) + (lane & 31));
#pragma unroll
        for (int j = 0; j < 4; ++j) { float y0 = bf_lo(uu[j]), y1 = bf_hi(uu[j]); rope64(y0, y1, t64); *((unsigned*)(CQ + (size_t)r * LDCQ + ((lane >> 5) + 2 * j) * 192 + 128) + (lane & 31)) = cvt_pk_bf16(y0, y1); }
    }
}
__device__ __forceinline__ void ret_out_unit(const Ctx& F, int l, int u) {
    CParams& P = *F.p; unsigned char* ws = P.ws;
    const int c = u >> 2, h = u & 3, row0 = c * 128, tid = F.tid, lane = F.lane, w = F.wave, r32 = lane & 31, hi = lane >> 5;
    const bf16_t* PROJ = (const bf16_t*)(ws + WS_PROJ); const bf16_t* RS = (const bf16_t*)(ws + WS_RS) + ((size_t)(c * 4 + h) * 2) * RET_ST;
    const float lgf2 = log_sigmoid_(P.in[I_RDF][l * 4 + h]) * 1.4426950408889634f, lgb2 = log_sigmoid_(P.in[I_RDB][l * 4 + h]) * 1.4426950408889634f;
    LAS char* lds = (LAS char*)F.lds;
    const int qblk = w & 3, eh = w >> 2, qi = qblk * 32 + r32;
    const int ldsb = (int)(uintptr_t)lds;
    const bf16_t* Qw = PROJ + (size_t)(row0 + qi) * LDP + C_BQ + h * 128 + hi * 8;
#pragma nounroll
    for (int jt = 0; jt < 2; ++jt) {
        const int sr = tid >> 4, sc = (tid & 15) * 8;
        const bf16_t* ksrc = PROJ + (size_t)(row0 + jt * 64) * LDP + C_BK + h * 128;
        *(LAS bf16x8*)(lds + jt * 16384 + KSWZ(sr, sc * 2)) = *reinterpret_cast<const bf16x8*>(ksrc + (size_t)sr * LDP + sc);
        *(LAS bf16x8*)(lds + jt * 16384 + KSWZ(32 + sr, sc * 2)) = *reinterpret_cast<const bf16x8*>(ksrc + (size_t)(32 + sr) * LDP + sc);
#pragma nounroll
        for (int e2 = 0; e2 < 2; ++e2) stage_vtile<0>(lds + 32768 + (jt * 2 + e2) * 16384, PROJ + (size_t)(row0 + jt * 64) * LDP + C_BV + h * 256 + e2 * 128, LDP, tid, 0.f, 0);
    }
    __syncthreads();
    f32x16 o[4] = {};
    {
        bf16x8 qr[8];
#pragma unroll
        for (int d0 = 0; d0 < 8; ++d0) qr[d0] = *reinterpret_cast<const bf16x8*>(Qw + d0 * 16);
#pragma nounroll
        for (int jt = 0; jt < 2; ++jt) {
            f32x16 p0, p1; att::qkt<128>(p0, p1, lds + jt * 16384, lds, qr, r32, hi);
#pragma unroll
            for (int r = 0; r < 16; ++r) {
                const int j0 = jt * 64 + att::crow(r, hi), j1 = j0 + 32; const int d0 = qi - j0, d1 = qi - j1;
                const float w0 = d0 > 0 ? __builtin_amdgcn_exp2f(lgf2 * (float)d0) : (d0 < 0 ? __builtin_amdgcn_exp2f(lgb2 * (float)(-d0)) : 2.0f);
                const float w1 = d1 > 0 ? __builtin_amdgcn_exp2f(lgf2 * (float)d1) : (d1 < 0 ? __builtin_amdgcn_exp2f(lgb2 * (float)(-d1)) : 2.0f);
                p0[r] *= w0; p1[r] *= w1; }
            bf16x8 pa0, pa1, pa2, pa3; att::p_to_frags(p0, p1, pa0, pa1, pa2, pa3);
            att::pv_d0(o, ldsb + 32768 + (jt * 2 + eh) * 16384 + att::v_rd_base(lane), pa0, pa1, pa2, pa3);
        }
    }
    __syncthreads();
#pragma nounroll
    for (int t = 0; t < 8; ++t) stage_vtile<0>(lds + t * 16384, RS + (size_t)(t >> 2) * RET_ST + (size_t)(((t >> 1) & 1) * 64) * 256 + (t & 1) * 128, 256, tid, 0.f, 0);
    __syncthreads();
    {
        const float ff = __builtin_amdgcn_exp2f(lgf2 * (float)(qi + 1)), fb = __builtin_amdgcn_exp2f(lgb2 * (float)(128 - qi));
#pragma nounroll
        for (int sd = 0; sd < 4; ++sd) { const float f = (sd >> 1) ? fb : ff; const int dt = sd & 1; bf16x8 pa[4];
#pragma unroll
            for (int k = 0; k < 4; ++k) { const u32x4 q4 = *reinterpret_cast<const u32x4*>(Qw + (dt * 4 + k) * 16); u32x4 s4;
                s4.x = cvt_pk_bf16(bf_lo(q4.x) * f, bf_hi(q4.x) * f); s4.y = cvt_pk_bf16(bf_lo(q4.y) * f, bf_hi(q4.y) * f); s4.z = cvt_pk_bf16(bf_lo(q4.z) * f, bf_hi(q4.z) * f); s4.w = cvt_pk_bf16(bf_lo(q4.w) * f, bf_hi(q4.w) * f);
                pa[k] = *reinterpret_cast<const bf16x8*>(&s4); }
            att::pv_d0(o, ldsb + (sd * 2 + eh) * 16384 + att::v_rd_base(lane), pa[0], pa[1], pa[2], pa[3]); }
    }
    LAS float* rsum = (LAS float*)(F.lds + LDS_RS_OFF);
    float ss[16];
#pragma unroll
    for (int r = 0; r < 16; ++r) { float s = 0.f;
#pragma unroll
        for (int d0 = 0; d0 < 4; ++d0) s += o[d0][r] * o[d0][r];
        s += swz_xor<1>(s); s += swz_xor<2>(s); s += swz_xor<4>(s); s += swz_xor<8>(s); s += swz_xor<16>(s); ss[r] = s; }
    if (r32 == 0) {
#pragma unroll
        for (int r = 0; r < 16; ++r) rsum[eh * 128 + qblk * 32 + att::crow(r, hi)] = ss[r]; }
    __syncthreads();
    const float* gn = P.in[I_RGN] + l * 1024 + h * 256; bf16_t* OB = (bf16_t*)(ws + WS_OABC + SZ_O1);
#pragma unroll
    for (int r = 0; r < 16; ++r) { const int i = qblk * 32 + att::crow(r, hi);
        const float rs = 1.0f / sqrtf((rsum[i] + rsum[128 + i]) * (1.0f / 256.0f) + EPS);
#pragma unroll
        for (int d0 = 0; d0 < 4; ++d0) { const int e = eh * 128 + d0 * 32 + r32;
            const float g = __uint_as_float((unsigned)PROJ[(size_t)(row0 + i) * LDP + C_BG + h * 256 + e] << 16);
            OB[(size_t)(row0 + i) * LDO + h * 256 + e] = (bf16_t)(cvt_pk_bf16(o[d0][r] * rs * gn[e] * siluf_(g), 0.f) & 0xffffu); } }
    __syncthreads();
}

constexpr int CONV_PER_L = 32 * 362 + 8 * 48 + 4 * 64 + 3 * 16 * 64 + 32 * 64 + 32 * 256 + 128 * 64, CONV_SPLIT = (CONV_PER_L * 42) / 100, CONV_SPLIT2 = (CONV_PER_L * 64) / 100;
constexpr int NPH_L = 11, NPH = 2 + DEPTH * NPH_L;
__global__ void __launch_bounds__(NTHR, 2) mega(Params prm) {
    extern __shared__ __attribute__((aligned(16))) unsigned char lds_raw[];
    Ctx F; F.lds = (LAS unsigned char*)lds_raw; F.tid = threadIdx.x; F.lane = F.tid & 63; F.wave = __builtin_amdgcn_readfirstlane(F.tid >> 6); F.bid = blockIdx.x; F.G = gridDim.x; F.p = (CParams*)__builtin_amdgcn_kernarg_segment_ptr();
    unsigned char* ws = F.p->ws;
    for (int u = F.tid; u < 128; u += NTHR) ((LAS unsigned*)(F.lds + LDSCTL_OFF))[u] = 0u;
    __syncthreads();
    const int lo = F.p->ph_lo, hi = F.p->ph_hi; const bool multi = (hi - lo) > 1;
    XcdBarrier bar; bar.bar = (unsigned*)(ws + WS_CTL); bar.x = 0; bar.st = nullptr;
    if (multi) bar = xcd_barrier_post((unsigned*)(ws + WS_CTL), (volatile LAS unsigned*)(F.lds + LDSCTL_OFF + 32));
#ifndef SUB_MASK
#define SUB_MASK 15
#endif
#ifndef PH_MASK
#define PH_MASK 0xFFFF
#endif
#ifndef DUP_MASK
#define DUP_MASK 0
#endif
#define REPS(bit) ((DUP_MASK & (bit)) ? 2 : 1)
#define IN(k) (lo <= (k) && (k) < hi)
#define RELANE() do { int l_; asm volatile("v_mbcnt_lo_u32_b32 %0, -1, 0\n\tv_mbcnt_hi_u32_b32 %0, -1, %0" : "=v"(l_)); F.lane = l_; F.tid = F.wave * 64 + l_; } while (0)
#define FRESH() do { int l_; asm volatile("v_mbcnt_lo_u32_b32 %0, -1, 0\n\tv_mbcnt_hi_u32_b32 %0, -1, %0" : "=v"(l_)); F.lane = l_; F.tid = F.wave * 64 + l_; CParams* kp_ = (CParams*)__builtin_amdgcn_kernarg_segment_ptr(); asm volatile("" : "+s"(kp_)); F.p = kp_; } while (0)
#define SEAM(k) do { if (IN(k) && IN((k) + 1)) xcd_barrier(bar, F.tid == 0); } while (0)
    float* X = F.p->out;
    const float* MOD = (const float*)(ws + WS_MOD);
    bf16_t* H = (bf16_t*)(ws + WS_H); bf16_t* PROJ = (bf16_t*)(ws + WS_PROJ);
    float* PART = (float*)(ws + WS_PART);

    if ((PH_MASK & 1) && IN(0)) _Pragma("nounroll") for (int rp = 0; rp < REPS(1); ++rp) { FRESH(); convert_layer(F, 0, 0, F.G, true, 0, CONV_PER_L);
        _Pragma("nounroll") for (int l2 = 1; l2 < DEPTH; ++l2) { FRESH(); convert_layer(F, l2, 0, F.G, false, CONV_SPLIT2, CONV_PER_L); }
        SEAM(0); }
    if ((PH_MASK & 2) && IN(1)) { FRESH(); norm_phase(F, F.p->in[I_XP], F.p->in[I_XS], nullptr, nullptr, nullptr, H, nullptr, 0, nullptr, MOD, 2048, 0, F.p->in[I_GPMIX]); SEAM(1); }

    for (int l = 0; l < DEPTH; ++l) {
        const int pb = 2 + l * NPH_L; const float* MODL = MOD + (size_t)l * 3 * 12288;
        if ((PH_MASK & 4) && IN(pb + 0)) _Pragma("nounroll") for (int rp = 0; rp < REPS(4); ++rp) { FRESH();
            pg8::EpiBf16<0> E{PROJ, LDP, 0};
            pg8::gemm_phase<pg8::EpiBf16<0>, NTOK, NPROJ, LDH, LDH, DM, 1, false, 0, 0>(F.lds, F.tid, H, ws + WS_WIN + l * SZ_WIN, F.G, F.bid, E);
            if (l + 1 < DEPTH && rp == 0) { constexpr int NU = (NTOK / 256) * (NPROJ / 256); const int first = NU % F.G;
                if (first > 0 && F.bid >= first) { FRESH(); convert_layer(F, l + 1, first, F.G - first, false, CONV_SPLIT, CONV_SPLIT2); } }
            SEAM(pb + 0);
        }
        if ((PH_MASK & 8) && IN(pb + 1)) _Pragma("nounroll") for (int rp = 0; rp < REPS(8); ++rp) { FRESH(); if (REPS(8) == 2 && rp == 0) phase_postproj<true>(F, l); else phase_postproj<false>(F, l); SEAM(pb + 1); }
        if ((PH_MASK & 16) && IN(pb + 2)) _Pragma("nounroll") for (int rp = 0; rp < REPS(16); ++rp) { FRESH();
            if (SUB_MASK & 1) { pg8::EpiBf16<0> E{(bf16_t*)(ws + WS_CQ), LDCQ, 0};
              pg8::gemm_phase<pg8::EpiBf16<0>, NTOK, 1536, LDP, 512, 512, 1, false, 0, 0>(F.lds, F.tid, PROJ + C_CQL, ws + WS_WUQ + l * SZ_WUQ, F.G, F.bid, E); }
            if (SUB_MASK & 2) { FRESH(); pg8::EpiBf16<0> E{(bf16_t*)(ws + WS_KVUP), LDKV, 0};
              pg8::gemm_phase<pg8::EpiBf16<0>, NALL, 2048, 256, 256, 256, 1, false, 0, 0>(F.lds, F.tid, ws + WS_CKV, ws + WS_WUKV + l * SZ_WUKV, F.G, F.G - 1 - F.bid, E); }
            if (SUB_MASK & 4) { FRESH(); for (int u = F.bid; u < 384; u += F.G) { RELANE(); ret_kv_unit(F, l, u); } }
            FRESH();
            if (SUB_MASK & 8) for (int u = F.bid; u < 384; u += F.G) {
                RELANE(); int row0, kv0, seq, h;
                if (u < 256) { const int uu = (F.G == 256) ? ((u & 7) * 32 + (u >> 3)) : u; const int b = uu >> 7; h = (uu >> 4) & 7; row0 = NCTX + b * 4096 + (uu & 15) * 256; kv0 = NCTX + b * KVL; seq = KVL; }
                else { const int s = (u - 256) >> 3; h = (u - 256) & 7; row0 = s * 256; kv0 = s * 256; seq = 256; }
                att::attn_dma<128, LDP, 256, 256, LDO>(PROJ + (size_t)row0 * LDP + C_AQ + h * 128, (const bf16_t*)(ws + WS_KA) + (size_t)kv0 * 256 + (h >> 2) * 128, nullptr,
                    (const bf16_t*)(ws + WS_VA) + (size_t)kv0 * 256 + (h >> 2) * 128, (bf16_t*)(ws + WS_OABC) + (size_t)row0 * LDO + h * 128, seq, (LAS char*)F.lds, (LAS float*)(F.lds + LDS_WSCR_OFF), F.tid);
            }
            SEAM(pb + 2);
        }
        if ((PH_MASK & 32) && IN(pb + 3)) _Pragma("nounroll") for (int rp = 0; rp < REPS(32); ++rp) { FRESH(); phase_scan(F, l, rp == 0); SEAM(pb + 3); }
        if ((PH_MASK & 64) && IN(pb + 4)) _Pragma("nounroll") for (int rp = 0; rp < REPS(64); ++rp) { FRESH();
            FRESH();
            if (SUB_MASK & 2) for (int u = F.bid; u < 384; u += F.G) {
                RELANE(); int row0, kv0, seq, h;
                if (u < 256) { const int uu = (F.G == 256) ? ((u & 7) * 32 + (u >> 3)) : u; const int b = uu >> 7; h = (uu >> 4) & 7; row0 = NCTX + b * 4096 + (uu & 15) * 256; kv0 = NCTX + b * KVL; seq = KVL; }
                else { const int s = (u - 256) >> 3; h = (u - 256) & 7; row0 = s * 256; kv0 = s * 256; seq = 256; }
                att::attn_dma<192, LDCQ, LDKV, LDKV, LDO>((const bf16_t*)(ws + WS_CQ) + (size_t)row0 * LDCQ + h * 192, (const bf16_t*)(ws + WS_KVUP) + (size_t)kv0 * LDKV + h * 256,
                    (const bf16_t*)(ws + WS_KROPE) + (size_t)kv0 * 64, (const bf16_t*)(ws + WS_KVUP) + (size_t)kv0 * LDKV + h * 256 + 128,
                    (bf16_t*)(ws + WS_OABC + 2 * SZ_O1) + (size_t)row0 * LDO + h * 128, seq, (LAS char*)F.lds, (LAS float*)(F.lds + LDS_WSCR_OFF), F.tid);
            }
            FRESH();
            if (SUB_MASK & 4) for (int u = (F.bid + F.G / 2) % F.G; u < 384; u += F.G) { RELANE(); ret_out_unit(F, l, u); }
            SEAM(pb + 4);
        }
        if ((PH_MASK & 128) && IN(pb + 5)) _Pragma("nounroll") for (int rp = 0; rp < REPS(128); ++rp) { FRESH();
            pg8::EpiBranch E{PROJ + C_GATE, LDP, (bf16_t*)(ws + WS_MERGED)};
            pg8::gemm_phase<pg8::EpiBranch, NTOK, DM, LDO, LDO, 1024, 3, true, SZ_O1, SZ_WBR1>(F.lds, F.tid, ws + WS_OABC, ws + WS_WBR + (size_t)l * 3 * SZ_WBR1, F.G, F.bid, E);
            if (l + 1 < DEPTH && rp == 0) { FRESH(); const int first = (F.G > 192 && F.G < 384) ? 384 - F.G : 0; if (F.bid >= first) convert_layer(F, l + 1, first, F.G - first, true, 0, CONV_SPLIT); }
            SEAM(pb + 5);
        }
        if ((PH_MASK & 256) && IN(pb + 6)) _Pragma("nounroll") for (int rp = 0; rp < REPS(256); ++rp) { FRESH();
            pg8::EpiBf16<0> E{(bf16_t*)PART, DM, (size_t)NTOK * DM};
            pg8::gemm_phase<pg8::EpiBf16<0>, NTOK, DM, LDH, LDH, 1024, 2, false, 2048, 2048>(F.lds, F.tid, ws + WS_MERGED, ws + WS_WOUT + l * SZ_WOUT, F.G, F.bid, E);
            SEAM(pb + 6);
        }
        if ((PH_MASK & 512) && IN(pb + 7)) _Pragma("nounroll") for (int rp = 0; rp < REPS(512); ++rp) { FRESH();
            norm_phase(F, l == 0 ? F.p->in[I_XP] : X, l == 0 ? F.p->in[I_XS] : X + (size_t)NCTX * DM, (const bf16_t*)PART, (const bf16_t*)PART + (size_t)NTOK * DM, (REPS(512) == 2 && rp == 0) ? (float*)PROJ : X, (REPS(512) == 2 && rp == 0) ? (bf16_t*)(ws + WS_PROJ + SZ_PART1) : H, MODL, 4096, F.p->in[I_GPOMIX] + l * DM, MODL, 8192, 6144, F.p->in[I_GPMLP] + l * DM);
            SEAM(pb + 7);
        }
        if ((PH_MASK & 1024) && IN(pb + 8)) _Pragma("nounroll") for (int rp = 0; rp < REPS(1024); ++rp) { FRESH();
            pg8::EpiBf16<1> E{PROJ, LDU, 0};
            pg8::gemm_phase<pg8::EpiBf16<1>, NTOK, DFF, LDH, LDH, DM, 1, false, 0, 0>(F.lds, F.tid, H, ws + WS_WUP + l * SZ_WUP, F.G, F.bid, E);
            SEAM(pb + 8);
        }
        if ((PH_MASK & 2048) && IN(pb + 9)) _Pragma("nounroll") for (int rp = 0; rp < REPS(2048); ++rp) { FRESH();
            pg8::EpiBf16<0> E{(bf16_t*)PART, DM, (size_t)NTOK * DM};
            pg8::gemm_phase<pg8::EpiBf16<0>, NTOK, DM, LDU, LDU, 4096, 2, false, 8192, 8192>(F.lds, F.tid, PROJ, ws + WS_WDN + l * SZ_WDN, F.G, F.bid, E);
            SEAM(pb + 9);
        }
        if ((PH_MASK & 4096) && IN(pb + 10)) _Pragma("nounroll") for (int rp = 0; rp < REPS(4096); ++rp) { FRESH();
            const bool more = (l + 1 < DEPTH);
            norm_phase(F, X, X + (size_t)NCTX * DM, (const bf16_t*)PART, (const bf16_t*)PART + (size_t)NTOK * DM, (REPS(4096) == 2 && rp == 0) ? (float*)PROJ : X, (REPS(4096) == 2 && rp == 0) ? (bf16_t*)(ws + WS_PROJ + SZ_PART1) : H, MODL, 10240, F.p->in[I_GPOMLP] + l * DM,
                       MODL + 3 * 12288, 2048, 0, more ? F.p->in[I_GPMIX] + (l + 1) * DM : nullptr);
            SEAM(pb + 10);
        }
    }
#undef IN
#undef SEAM
}

#ifndef MK_MULTI
#define MK_MULTI 0
#endif
extern "C" void kernel_launch(void* const* d_in, const int* in_sizes, int n_in, void* d_out, int out_size, void* d_ws, size_t ws_size, hipStream_t stream) {
    static int grid = 0;
    if (grid == 0) {
        if (n_in != 32 || out_size != (int)O_END || ws_size < WS_END) { fprintf(stderr, "kernel_launch: unexpected shapes: n_in %d out %d ws %zu (need %zu)\n", n_in, out_size, ws_size, (size_t)WS_END); grid = -1; return; }
        int dev = 0, cus = 0, per_cu = 0;
        if (hipGetDevice(&dev) != hipSuccess || hipDeviceGetAttribute(&cus, hipDeviceAttributeMultiprocessorCount, dev) != hipSuccess) { grid = -1; return; }
        if (hipFuncSetAttribute((const void*)mega, hipFuncAttributeMaxDynamicSharedMemorySize, LDS_BYTES) != hipSuccess) { fprintf(stderr, "kernel_launch: hipFuncSetAttribute failed\n"); grid = -1; return; }
        if (hipOccupancyMaxActiveBlocksPerMultiprocessor(&per_cu, (const void*)mega, NTHR, LDS_BYTES) != hipSuccess || per_cu < 1) fprintf(stderr, "kernel_launch: occupancy query says %d\n", per_cu);
        (void)hipGetLastError();
        grid = cus;
    }
    if (grid < 0) return;
    (void)hipMemsetAsync((char*)d_ws + WS_CTL, 0, CTL_BYTES, stream);
    Params p{};
    for (int i = 0; i < 32; ++i) p.in[i] = (const float*)d_in[i];
    p.out = (float*)d_out; p.ws = (unsigned char*)d_ws;
#if MK_MULTI
    for (int k = 0; k < NPH; ++k) { p.ph_lo = k; p.ph_hi = k + 1; hipLaunchKernelGGL(mega, dim3(grid), dim3(NTHR), LDS_BYTES, stream, p); }
#else
    p.ph_lo = 0; p.ph_hi = NPH;
    hipLaunchKernelGGL(mega, dim3(grid), dim3(NTHR), LDS_BYTES, stream, p);
#endif
    const hipError_t le = hipPeekAtLastError();
    if (le != hipSuccess) fprintf(stderr, "kernel_launch: launch failed: %s\n", hipGetErrorName(le));
}
```

```cpp
#include <hip/hip_runtime.h>
#include <cstdio>
#include <cstdint>

#define LAS __attribute__((address_space(3)))
#define GAS __attribute__((address_space(1)))
typedef unsigned short bf16_t;
typedef short bf16x8 __attribute__((ext_vector_type(8)));
typedef short s16x4 __attribute__((ext_vector_type(4)));
typedef float f32x4 __attribute__((ext_vector_type(4)));
typedef float f32x2 __attribute__((ext_vector_type(2)));
typedef float f32x16 __attribute__((ext_vector_type(16)));
typedef unsigned u32x4 __attribute__((ext_vector_type(4)));
typedef unsigned u32x2 __attribute__((ext_vector_type(2)));

constexpr int DM = 2048, NCTX = 4096, NLAT = 8192, NTOK = 12288, DEPTH = 4, DFF = 8192;
constexpr int NPROJ = 11776;
constexpr int PADE = 64;
constexpr int LDP = NPROJ + PADE, LDH = DM + PADE, LDU = DFF + PADE, LDO = 1024 + PADE, LDCQ = 1536 + PADE, LDKV = 2048 + PADE;
constexpr int C_AQ = 0, C_AK = 1024, C_AV = 1280, C_BQ = 1536, C_BK = 2048, C_BV = 2560, C_BG = 3584, C_CQL = 4608, C_CKV = 5120, C_CKR = 5376, C_GATE = 5632;
constexpr int NALL = 13312;
constexpr int KVL = 4608;
constexpr float EPS = 1e-6f;
constexpr int NWAVES = 8, NTHR = 512;

constexpr size_t WS_CTL = 0, CTL_BYTES = 1u << 20;
constexpr size_t WS_MOD = CTL_BYTES;
constexpr size_t WS_WIN = 2u << 20;
constexpr size_t SZ_WIN = (size_t)NPROJ * LDH * 2;
constexpr size_t WS_WUQ = WS_WIN + 4 * SZ_WIN;
constexpr size_t SZ_WUQ = (size_t)1536 * 512 * 2;
constexpr size_t WS_WUKV = WS_WUQ + 4 * SZ_WUQ;
constexpr size_t SZ_WUKV = (size_t)2048 * 256 * 2;
constexpr size_t WS_WBR = WS_WUKV + 4 * SZ_WUKV;
constexpr size_t SZ_WBR1 = (size_t)2048 * LDO * 2;
constexpr size_t WS_WOUT = WS_WBR + 12 * SZ_WBR1;
constexpr size_t SZ_WOUT = (size_t)2048 * LDH * 2;
constexpr size_t WS_WUP = WS_WOUT + 4 * SZ_WOUT;
constexpr size_t SZ_WUP = (size_t)8192 * LDH * 2, SZ_WDN = (size_t)2048 * LDU * 2;
constexpr size_t WS_WDN = WS_WUP + 4 * SZ_WUP;
constexpr size_t WS_H = WS_WDN + 4 * SZ_WDN;
constexpr size_t WS_PROJ = WS_H + (size_t)NTOK * LDH * 2;
constexpr size_t WS_KA = WS_PROJ + (size_t)NTOK * LDP * 2;
constexpr size_t WS_VA = WS_KA + (size_t)NALL * 256 * 2;
constexpr size_t WS_CKV = WS_VA + (size_t)NALL * 256 * 2;
constexpr size_t WS_KROPE = WS_CKV + (size_t)NALL * 256 * 2;
constexpr size_t WS_CQ = WS_KROPE + (size_t)NALL * 64 * 2;
constexpr size_t WS_KVUP = WS_CQ + (size_t)NTOK * LDCQ * 2;
constexpr size_t WS_OABC = WS_KVUP + (size_t)NALL * LDKV * 2;
constexpr size_t SZ_O1 = (size_t)NTOK * LDO * 2;
constexpr size_t WS_MERGED = WS_OABC + 3 * SZ_O1;
constexpr size_t WS_PART = WS_MERGED + (size_t)NTOK * LDH * 2;
constexpr size_t SZ_PART1 = (size_t)NTOK * DM * 4;
constexpr size_t WS_END = WS_PART + 2 * SZ_PART1;
constexpr size_t RET_ST = 32768;
constexpr size_t WS_RKV = WS_PART;
constexpr size_t WS_RS = WS_PART + (size_t)96 * 4 * 2 * RET_ST * 4;
static_assert(WS_RS + (size_t)96 * 4 * 2 * RET_ST * 2 <= WS_END, "ws map");

constexpr int LDS_BYTES = 147456;
constexpr int LDSCTL_OFF = 131072;
constexpr int LDS_RS_OFF = 131072 + 1024;
constexpr int LDS_WSCR_OFF = 131072 + 2048;

__device__ __forceinline__ unsigned cvt_pk_bf16(float lo, float hi) { unsigned r; asm volatile("v_cvt_pk_bf16_f32 %0, %1, %2" : "=v"(r) : "v"(lo), "v"(hi)); return r; }
__device__ __forceinline__ float bf_lo(unsigned u) { return __uint_as_float(u << 16); }
__device__ __forceinline__ float bf_hi(unsigned u) { return __uint_as_float(u & 0xffff0000u); }
template <int X> __device__ __forceinline__ float swz_xor(float v) { return __int_as_float(__builtin_amdgcn_ds_swizzle(__float_as_int(v), 0x1f | (X << 10))); }
__device__ __forceinline__ float wave_sum(float v) {
    v += swz_xor<1>(v); v += swz_xor<2>(v); v += swz_xor<4>(v); v += swz_xor<8>(v); v += swz_xor<16>(v);
    auto rr = __builtin_amdgcn_permlane32_swap(__float_as_uint(v), __float_as_uint(v), false, false);
    return __uint_as_float(rr[0]) + __uint_as_float(rr[1]);
}
__device__ __forceinline__ float fast_exp(float x) { return __builtin_amdgcn_exp2f(x * 1.4426950408889634f); }
__device__ __forceinline__ float sigmoidf_(float x) { return __builtin_amdgcn_rcpf(1.0f + fast_exp(-x)); }
__device__ __forceinline__ float siluf_(float x) { return x * sigmoidf_(x); }
#define LDS_WAIT() asm volatile("s_waitcnt lgkmcnt(0)" ::: "memory")
#define VM_WAIT() asm volatile("s_waitcnt vmcnt(0)" ::: "memory")

#define XB_TMO      128
#define XB_XCNT(j)  (256  + 64 * (j))
#define XB_XSUB(j)  (1280 + 64 * (j))
#define XB_XGEN(j)  (2304 + 64 * (j))
#define XB_TOP      3328
#define XB_TOPGEN   3392
#define XCD_BAR_WORDS 3456
#define XB_SPIN_CAP (1u << 22)
__device__ __forceinline__ unsigned xb_ld(unsigned* p)              { return __hip_atomic_load(p, __ATOMIC_RELAXED, __HIP_MEMORY_SCOPE_AGENT); }
__device__ __forceinline__ unsigned xb_add(unsigned* p, unsigned v) { return __hip_atomic_fetch_add(p, v, __ATOMIC_RELAXED, __HIP_MEMORY_SCOPE_AGENT); }
__device__ __forceinline__ unsigned xb_xcc_id() { return (unsigned)__builtin_amdgcn_s_getreg((3 << 11) | 20) & 0xFu; }
#define XB_SPIN(cond, bar) do { unsigned _sp = 0; while (cond) { __builtin_amdgcn_s_sleep(1); \
    if ((++_sp & 255u) == 0u) { if (xb_ld(&(bar)[XB_TMO])) break; if (_sp > XB_SPIN_CAP) { atomicAdd(&(bar)[XB_TMO], 1u); break; } } } } while (0)
struct XcdBarrier { unsigned* bar; unsigned x; volatile LAS unsigned* st; };
__device__ __forceinline__ XcdBarrier xcd_barrier_post(unsigned* bar, volatile LAS unsigned* st) {
    XcdBarrier b; b.bar = bar; b.x = xb_xcc_id(); b.st = st;
    if (threadIdx.x == 0) (void)xb_add(&bar[XB_XCNT(b.x)], 1u);
    return b;
}
__device__ __forceinline__ void xcd_barrier_complete(unsigned* bar, unsigned x, unsigned& nloc, unsigned& nx) {
    const unsigned G = gridDim.x * gridDim.y * gridDim.z;
    unsigned sum, cnt, mine, sp = 0u;
    for (;;) {
        sum = 0u; cnt = 0u; mine = 0u;
#pragma unroll
        for (unsigned j = 0; j < 16; ++j) { const unsigned c = xb_ld(&bar[XB_XCNT(j)]); sum += c; cnt += (c > 0u) ? 1u : 0u; mine = (j == x) ? c : mine; }
        if (sum == G) break;
        __builtin_amdgcn_s_sleep(1);
        if ((++sp & 255u) == 0u) { if (xb_ld(&bar[XB_TMO])) break; if (sp > XB_SPIN_CAP) { atomicAdd(&bar[XB_TMO], 1u); break; } }
    }
    nloc = mine > 0u ? mine : 1u; nx = cnt > 0u ? cnt : 1u;
}
__device__ __forceinline__ void xcd_barrier(const XcdBarrier& b, const bool leader) {
    asm volatile("s_waitcnt vmcnt(0)" ::: "memory");
    __syncthreads();
    if (leader) {
        unsigned* bar = b.bar;
        __builtin_amdgcn_s_waitcnt(0);
        unsigned nloc = b.st[0], nx = b.st[1];
        if (nloc == 0u) { xcd_barrier_complete(bar, b.x, nloc, nx); b.st[0] = nloc; b.st[1] = nx; }
        const unsigned old = xb_add(&bar[XB_XSUB(b.x)], 1u);
        const unsigned gen = old / nloc;
        if (old + 1u == (gen + 1u) * nloc) {
            __builtin_amdgcn_fence(__ATOMIC_RELEASE, "agent");
            asm volatile("s_waitcnt vmcnt(0)" ::: "memory");
            const unsigned og = xb_add(&bar[XB_TOP], 1u);
            const unsigned tg = og / nx;
            if (og + 1u == (tg + 1u) * nx) xb_add(&bar[XB_TOPGEN], 1u);
            else XB_SPIN(xb_ld(&bar[XB_TOPGEN]) == tg, bar);
            __builtin_amdgcn_fence(__ATOMIC_ACQUIRE, "agent");
            xb_add(&bar[XB_XGEN(b.x)], 1u);
            asm volatile("s_waitcnt vmcnt(0)" ::: "memory");
        } else {
            XB_SPIN(xb_ld(&bar[XB_XGEN(b.x)]) == gen, bar);
            __builtin_amdgcn_fence(__ATOMIC_ACQUIRE, "agent");
            asm volatile("s_waitcnt vmcnt(0)" ::: "memory");
        }
    }
    __syncthreads();
}

namespace pg8 {
constexpr int BM = 256, BK = 64, HALF = 128, HTB = HALF * BK * 2, STAGE_BYTES = 8 * HTB, NXCD = 8, WGM = 8;
__host__ __device__ __forceinline__ int lds_byte(int r, int c) { const int st = (r >> 4) * 2 + (c >> 5), rr = r & 15, cc = c & 31, ob = rr * 64 + cc * 2; return st * 1024 + (ob ^ (((ob >> 9) & 1) << 5)); }
__host__ __device__ __forceinline__ void stage_rc(int b, int& R, int& C) { const int st = b / 1024, sb = b % 1024, swz = sb ^ (((sb >> 9) & 1) << 5); R = (st >> 1) * 16 + swz / 64; C = (st & 1) * 32 + (swz % 64) / 2; }
__host__ __device__ __forceinline__ int perm32(int rho) { const int n = rho >> 4, i = rho & 15; return 8 * (i >> 2) + 4 * n + (i & 3); }

struct Unit { int pm, pn, z; };
template <int M, int N, int NZ, bool ZINNER>
__device__ __forceinline__ bool next_unit(int k, int G, int c, Unit& u) {
    constexpr int nM = M / BM, nN = N / BM, nNx = ZINNER ? nN : nN * NZ, nwg = nM * nNx;
    int i, z;
    if (ZINNER) { i = k / NZ; z = k - i * NZ; } else { i = k; z = 0; }
    const int L = i * G + c; if (L >= nwg) return false;
    int wgid = L; { constexpr int q = nwg / NXCD, r = nwg % NXCD; const int xcd = wgid % NXCD, off = wgid / NXCD; wgid = (xcd < r ? xcd * (q + 1) : r * (q + 1) + (xcd - r) * q) + off; }
    constexpr int nig = WGM * nNx; const int gid = wgid / nig, fm = gid * WGM, gsz = (nM - fm) < WGM ? (nM - fm) : WGM;
    u.pm = fm + ((wgid % nig) % gsz); const int pnx = (wgid % nig) / gsz;
    if (ZINNER) { u.pn = pnx; u.z = z; } else { u.z = pnx / nN; u.pn = pnx - u.z * nN; }
    return true;
}

template <int ACT  > struct EpiBf16 {
    static constexpr bool PERM = true, KEEP = false;
    bf16_t* O; int ldc; size_t zstride;
    __device__ __forceinline__ void operator()(f32x4 (&acc)[2][2][4][2], const Unit& u, int wr, int wc, int fr, int fq) const {
        const int row0 = u.pm * BM + wr * 64 + fr; const int col0 = u.pn * BM + wc * 32 + 8 * fq; bf16_t* Oz = O + (size_t)u.z * zstride;
#pragma unroll
        for (int ai = 0; ai < 2; ++ai)
#pragma unroll
            for (int m = 0; m < 4; ++m) { bf16_t* rowp = Oz + (size_t)(row0 + ai * HALF + m * 16) * ldc + col0;
#pragma unroll
                for (int bj = 0; bj < 2; ++bj) { f32x4 v0 = acc[ai][bj][m][0], v1 = acc[ai][bj][m][1];
                    if (ACT == 1) {
#pragma unroll
                        for (int j = 0; j < 4; ++j) { const float a = fmaxf(v0[j], 0.f), b = fmaxf(v1[j], 0.f); v0[j] = a * a; v1[j] = b * b; } }
                    u32x4 w; w.x = cvt_pk_bf16(v0[0], v0[1]); w.y = cvt_pk_bf16(v0[2], v0[3]); w.z = cvt_pk_bf16(v1[0], v1[1]); w.w = cvt_pk_bf16(v1[2], v1[3]);
                    *(u32x4*)(rowp + bj * HALF) = w; } }
    }
};
struct EpiF32Z {
    static constexpr bool PERM = false, KEEP = false;
    float* C; int ldc; size_t zstride;
    __device__ __forceinline__ void operator()(f32x4 (&acc)[2][2][4][2], const Unit& u, int wr, int wc, int fr, int fq) const {
        const int row0 = u.pm * BM + wr * 64 + fr, col0 = u.pn * BM + wc * 32 + 4 * fq; float* Cz = C + (size_t)u.z * zstride;
#pragma unroll
        for (int ai = 0; ai < 2; ++ai)
#pragma unroll
            for (int m = 0; m < 4; ++m) { float* rowp = Cz + (size_t)(row0 + ai * HALF + m * 16) * ldc + col0;
#pragma unroll
                for (int bj = 0; bj < 2; ++bj)
#pragma unroll
                    for (int n = 0; n < 2; ++n) *(f32x4*)(rowp + bj * HALF + n * 16) = acc[ai][bj][m][n]; }
    }
};
struct EpiBranch {
    static constexpr bool PERM = true, KEEP = true;
    const bf16_t* gates; int ldg;
    bf16_t* O;
    __device__ __forceinline__ void operator()(f32x4 (&acc)[2][2][4][2], const Unit& u, int wr, int wc, int fr, int fq) const {
        const int row0 = u.pm * BM + wr * 64 + fr; const int col0 = u.pn * BM + wc * 32 + 8 * fq; const bool last = (u.z == 2);
        u32x4 gA[2], nA[2], gB[2], nB[2];
#define EB_LOAD(G, N, k) do { _Pragma("unroll") for (int bj = 0; bj < 2; ++bj) { const size_t row = (size_t)(row0 + ((k) >> 2) * HALF + ((k) & 3) * 16); const int col = col0 + bj * HALF; \
            G[bj] = *(const u32x4*)(gates + row * ldg + (size_t)u.z * 2048 + col); if (!last) N[bj] = *(const u32x4*)(gates + row * ldg + (size_t)(u.z + 1) * 2048 + col); } } while (0)
#define EB_EVAL(G, N, k) do { _Pragma("unroll") for (int bj = 0; bj < 2; ++bj) { constexpr int ai = (k) >> 2, m = (k) & 3; const size_t row = (size_t)(row0 + ai * HALF + m * 16); const int col = col0 + bj * HALF; \
            const u32x4 gg = G[bj]; f32x4 v0 = acc[ai][bj][m][0], v1 = acc[ai][bj][m][1]; \
            float f[8] = {sigmoidf_(bf_lo(gg.x)), sigmoidf_(bf_hi(gg.x)), sigmoidf_(bf_lo(gg.y)), sigmoidf_(bf_hi(gg.y)), sigmoidf_(bf_lo(gg.z)), sigmoidf_(bf_hi(gg.z)), sigmoidf_(bf_lo(gg.w)), sigmoidf_(bf_hi(gg.w))}; \
            if (!last) { const u32x4 nn = N[bj];     \
                f[0] *= 1.0f + fast_exp(fminf(-bf_lo(nn.x), 40.f)); f[1] *= 1.0f + fast_exp(fminf(-bf_hi(nn.x), 40.f)); f[2] *= 1.0f + fast_exp(fminf(-bf_lo(nn.y), 40.f)); f[3] *= 1.0f + fast_exp(fminf(-bf_hi(nn.y), 40.f)); \
                f[4] *= 1.0f + fast_exp(fminf(-bf_lo(nn.z), 40.f)); f[5] *= 1.0f + fast_exp(fminf(-bf_hi(nn.z), 40.f)); f[6] *= 1.0f + fast_exp(fminf(-bf_lo(nn.w), 40.f)); f[7] *= 1.0f + fast_exp(fminf(-bf_hi(nn.w), 40.f)); } \
            v0[0] *= f[0]; v0[1] *= f[1]; v0[2] *= f[2]; v0[3] *= f[3]; v1[0] *= f[4]; v1[1] *= f[5]; v1[2] *= f[6]; v1[3] *= f[7]; \
            if (!last) { acc[ai][bj][m][0] = v0; acc[ai][bj][m][1] = v1; } \
            else { u32x4 w; w.x = cvt_pk_bf16(v0[0], v0[1]); w.y = cvt_pk_bf16(v0[2], v0[3]); w.z = cvt_pk_bf16(v1[0], v1[1]); w.w = cvt_pk_bf16(v1[2], v1[3]); \
                *(u32x4*)(O + row * LDH + col) = w; } } } while (0)
        EB_LOAD(gA, nA, 0); EB_LOAD(gB, nB, 1);
        EB_EVAL(gA, nA, 0); EB_LOAD(gA, nA, 2); EB_EVAL(gB, nB, 1); EB_LOAD(gB, nB, 3);
        EB_EVAL(gA, nA, 2); EB_LOAD(gA, nA, 4); EB_EVAL(gB, nB, 3); EB_LOAD(gB, nB, 5);
        EB_EVAL(gA, nA, 4); EB_LOAD(gA, nA, 6); EB_EVAL(gB, nB, 5); EB_LOAD(gB, nB, 7);
        EB_EVAL(gA, nA, 6); EB_EVAL(gB, nB, 7);
#undef EB_LOAD
#undef EB_EVAL
    }
};

template <class Epi, int M, int N, int LDA, int LDB, int KU, int NZ, bool ZINNER, size_t AZS, size_t BZS, bool ALIGN_EPI = true>
__device__ __forceinline__ void gemm_phase(LAS unsigned char* lds, const int tid, const void* Aptr, const void* Bptr, int G, int c, const Epi& E) {
    const char* const Abase = (const char*)Aptr; const char* const Bbase = (const char*)Bptr;
    const int wid = __builtin_amdgcn_readfirstlane(tid >> 6), lane = tid & 63, wr = wid >> 2, wc = wid & 3, fr = lane & 15, fq = lane >> 4;
    constexpr int nt = KU / BK;
    unsigned voffA[2], voffB[2];
#pragma unroll
    for (int i = 0; i < 2; ++i) { int R, C; stage_rc(tid * 16 + i * 8192, R, C); const int Rb = Epi::PERM ? ((R & ~31) + perm32(R & 31)) : R;
        voffA[i] = (unsigned)(R * LDA + C) * 2u; voffB[i] = (unsigned)(Rb * LDB + C) * 2u; }
    constexpr size_t kstep = (size_t)(BK * 2);
    constexpr size_t hstepA = (size_t)HALF * LDA * 2, hstepB = (size_t)HALF * LDB * 2;
    constexpr size_t tstepA = 2 * hstepA, tstepB = 2 * hstepB;
    const unsigned ldsw = (unsigned)wid * 1024u;
    const int aoff = lds_byte(wr * 64 + fr, fq * 8), boff = lds_byte(wc * 32 + fr, fq * 8);
#define PG8_SA(b, h) (((b) * 2 + (h)) * HTB)
#define PG8_SB(b, h) ((4 + (b) * 2 + (h)) * HTB)
#define PG8_STAGE(bufoff, gbase, voff) do { _Pragma("unroll") for (int _i = 0; _i < 2; ++_i) \
        __builtin_amdgcn_global_load_lds((const unsigned*)((const char*)(gbase) + (voff)[_i]), (LAS unsigned*)(lds + (bufoff) + ldsw + _i * 8192), 16, 0, 0); } while (0)
#define PG8_LDA(dst, b, h) do { _Pragma("unroll") for (int m = 0; m < 4; ++m) _Pragma("unroll") for (int k = 0; k < 2; ++k) dst[m][k] = *(const LAS bf16x8*)(lds + PG8_SA(b, h) + aoff + m * 2048 + k * 1024); } while (0)
#define PG8_LDB(dst, b, h) do { _Pragma("unroll") for (int n = 0; n < 2; ++n) _Pragma("unroll") for (int k = 0; k < 2; ++k) dst[n][k] = *(const LAS bf16x8*)(lds + PG8_SB(b, h) + boff + n * 2048 + k * 1024); } while (0)
#define PG8_MMA(ai, bj, At, Bt) do { __builtin_amdgcn_s_setprio(1); _Pragma("unroll") for (int m = 0; m < 4; ++m) _Pragma("unroll") for (int n = 0; n < 2; ++n) _Pragma("unroll") for (int k = 0; k < 2; ++k) \
        acc[ai][bj][m][n] = __builtin_amdgcn_mfma_f32_16x16x32_bf16(Bt[n][k], At[m][k], acc[ai][bj][m][n], 0, 0, 0); __builtin_amdgcn_s_setprio(0); } while (0)
#define PG8_WAIT_V(n) asm volatile("s_waitcnt vmcnt(" #n ")" ::: "memory")
#define PG8_WAIT_L(n) asm volatile("s_waitcnt lgkmcnt(" #n ")" ::: "memory")
#define PG8_BAR __builtin_amdgcn_s_barrier()
#define PG8_SCHED __builtin_amdgcn_sched_barrier(0)
    Unit cur, nxt; int ui = 0;
    if (!next_unit<M, N, NZ, ZINNER>(0, G, c, cur)) return;
    f32x4 acc[2][2][4][2];
#pragma unroll
    for (int a = 0; a < 2; ++a)
#pragma unroll
        for (int b = 0; b < 2; ++b)
#pragma unroll
            for (int m = 0; m < 4; ++m)
#pragma unroll
                for (int n = 0; n < 2; ++n) acc[a][b][m][n] = (f32x4){0.f, 0.f, 0.f, 0.f};
    bf16x8 At[4][2], B0[2][2], B1[2][2];
    const char* cA = Abase + (size_t)cur.z * AZS + (size_t)cur.pm * tstepA; const char* cB = Bbase + (size_t)cur.z * BZS + (size_t)cur.pn * tstepB;
    PG8_STAGE(PG8_SB(0, 0), cB, voffB); PG8_STAGE(PG8_SB(0, 1), cB + hstepB, voffB); PG8_STAGE(PG8_SA(0, 0), cA, voffA); PG8_STAGE(PG8_SA(0, 1), cA + hstepA, voffA);
    if (wr == 1) PG8_BAR;
    PG8_WAIT_V(2); PG8_BAR;
    PG8_STAGE(PG8_SB(1, 0), cB + kstep, voffB); PG8_STAGE(PG8_SA(1, 0), cA + kstep, voffA); PG8_STAGE(PG8_SB(1, 1), cB + hstepB + kstep, voffB);
    PG8_WAIT_V(6); PG8_BAR;
    for (;;) {
        const bool has_next = next_unit<M, N, NZ, ZINNER>(ui + 1, G, c, nxt);
        const char* nA = has_next ? Abase + (size_t)nxt.z * AZS + (size_t)nxt.pm * tstepA : cA; const char* nB = has_next ? Bbase + (size_t)nxt.z * BZS + (size_t)nxt.pn * tstepB : cB;
#pragma nounroll
        for (int t = 0; t < nt; t += 2) {
            const bool last = (t == nt - 2);
            const char* a1 = cA + (size_t)(t + 1) * kstep;
            const char* a2 = last ? nA : cA + (size_t)(t + 2) * kstep; const char* b2 = last ? nB : cB + (size_t)(t + 2) * kstep;
            const char* a3 = a2 + kstep; const char* b3 = b2 + kstep;
            PG8_LDB(B0, 0, 0); PG8_LDB(B1, 0, 1); PG8_SCHED; PG8_LDA(At, 0, 0); PG8_STAGE(PG8_SA(1, 1), a1 + hstepA, voffA);
            PG8_WAIT_V(8); PG8_WAIT_L(0); PG8_BAR; PG8_MMA(0, 0, At, B0); PG8_MMA(0, 1, At, B1); PG8_BAR; PG8_SCHED;
            PG8_LDA(At, 0, 1); PG8_STAGE(PG8_SB(0, 0), b2, voffB); PG8_STAGE(PG8_SB(0, 1), b2 + hstepB, voffB); PG8_STAGE(PG8_SA(0, 0), a2, voffA);
            PG8_WAIT_V(8); PG8_WAIT_L(0); PG8_BAR; PG8_MMA(1, 0, At, B0); PG8_MMA(1, 1, At, B1); PG8_BAR; PG8_SCHED;
            PG8_LDB(B0, 1, 0); PG8_LDB(B1, 1, 1); PG8_SCHED; PG8_LDA(At, 1, 0); PG8_STAGE(PG8_SA(0, 1), a2 + hstepA, voffA);
            PG8_WAIT_V(8); PG8_WAIT_L(0); PG8_BAR; PG8_MMA(0, 0, At, B0); PG8_MMA(0, 1, At, B1); PG8_BAR; PG8_SCHED;
            PG8_LDA(At, 1, 1); PG8_STAGE(PG8_SB(1, 0), b3, voffB); PG8_STAGE(PG8_SB(1, 1), b3 + hstepB, voffB); PG8_STAGE(PG8_SA(1, 0), a3, voffA);
            PG8_WAIT_V(8); PG8_WAIT_L(0); PG8_BAR; PG8_MMA(1, 0, At, B0); PG8_MMA(1, 1, At, B1); PG8_BAR; PG8_SCHED;
        }
        if constexpr (ALIGN_EPI) { if (wr == 0) PG8_BAR; }
        E(acc, cur, wr, wc, fr, fq);
        if (!has_next) break;
        if (!(Epi::KEEP && cur.z + 1 < NZ)) {
#pragma unroll
        for (int a = 0; a < 2; ++a)
#pragma unroll
            for (int b = 0; b < 2; ++b)
#pragma unroll
                for (int m = 0; m < 4; ++m)
#pragma unroll
                    for (int n = 0; n < 2; ++n) acc[a][b][m][n] = (f32x4){0.f, 0.f, 0.f, 0.f};
        }
        cur = nxt; cA = nA; cB = nB; ++ui;
        if constexpr (ALIGN_EPI) { if (wr == 1) PG8_BAR; }
    }
    PG8_WAIT_V(0);
    if constexpr (!ALIGN_EPI) { if (wr == 0) PG8_BAR; }
    PG8_BAR;
#undef PG8_SA
#undef PG8_SB
#undef PG8_STAGE
#undef PG8_LDA
#undef PG8_LDB
#undef PG8_MMA
#undef PG8_WAIT_V
#undef PG8_WAIT_L
#undef PG8_BAR
#undef PG8_SCHED
}
}

namespace att {
constexpr int NW = 8, QBLK = 32, KVBLK = 64;
constexpr int SHM_T = KVBLK * 128 * 2;
#define KSWZ(row, colB) ((row) * 256 + ((colB) ^ (((row) & 7) << 4)))
#define SBAR() __builtin_amdgcn_sched_barrier(0)
__device__ __forceinline__ int crow(int r, int hi) { return (r & 3) + 8 * (r >> 2) + 4 * hi; }
__device__ __forceinline__ int v_st(int k, int c) { const int kk = (k & ~0xC) | ((k & 4) << 1) | ((k & 8) >> 1); return ((kk >> 3) * 4 + (c >> 5)) * 512 + ((kk & 7) * 32 + (c & 31)) * 2; }
__device__ __forceinline__ int v_rd_base(int lane) { return ((lane & 3) << 3) | (((lane >> 2) & 3) << 6) | (((lane >> 4) & 1) << 5) | (((lane >> 5) & 1) << 8); }
constexpr int v_rd_off(int d0, int ks, int half) { return d0 * 512 + ks * 4096 + half * 2048; }
template <int OFF> __device__ __forceinline__ s16x4 tr_read(int vb) {
    s16x4 r; asm volatile("ds_read_b64_tr_b16 %0, %1 offset:%2" : "=&v"(r) : "v"(vb), "i"(OFF) : "memory"); return r;
}
#define PKLH(L, H) (bf16x8){L[0], L[1], L[2], L[3], H[0], H[1], H[2], H[3]}
template <int D0> __device__ __forceinline__ void pv_one(f32x16& od, int vb, bf16x8 pa0, bf16x8 pa1, bf16x8 pa2, bf16x8 pa3) {
    const s16x4 l0 = tr_read<v_rd_off(D0, 0, 0)>(vb), h0 = tr_read<v_rd_off(D0, 0, 1)>(vb), l1 = tr_read<v_rd_off(D0, 1, 0)>(vb), h1 = tr_read<v_rd_off(D0, 1, 1)>(vb);
    const s16x4 l2 = tr_read<v_rd_off(D0, 2, 0)>(vb), h2 = tr_read<v_rd_off(D0, 2, 1)>(vb), l3 = tr_read<v_rd_off(D0, 3, 0)>(vb), h3 = tr_read<v_rd_off(D0, 3, 1)>(vb);
    asm volatile("s_waitcnt lgkmcnt(0)" ::: "memory"); SBAR();
    od = __builtin_amdgcn_mfma_f32_32x32x16_bf16(pa0, PKLH(l0, h0), od, 0, 0, 0);
    od = __builtin_amdgcn_mfma_f32_32x32x16_bf16(pa1, PKLH(l1, h1), od, 0, 0, 0);
    od = __builtin_amdgcn_mfma_f32_32x32x16_bf16(pa2, PKLH(l2, h2), od, 0, 0, 0);
    od = __builtin_amdgcn_mfma_f32_32x32x16_bf16(pa3, PKLH(l3, h3), od, 0, 0, 0);
}
__device__ __forceinline__ void pv_d0(f32x16* o, int vb, bf16x8 pa0, bf16x8 pa1, bf16x8 pa2, bf16x8 pa3) {
    pv_one<0>(o[0], vb, pa0, pa1, pa2, pa3); pv_one<1>(o[1], vb, pa0, pa1, pa2, pa3); pv_one<2>(o[2], vb, pa0, pa1, pa2, pa3); pv_one<3>(o[3], vb, pa0, pa1, pa2, pa3);
}
__device__ __forceinline__ void p_to_frags(const f32x16& p0, const f32x16& p1, bf16x8& pa0, bf16x8& pa1, bf16x8& pa2, bf16x8& pa3) {
#define PK4(P, BASE, OUT) do { unsigned a0 = cvt_pk_bf16(P[BASE + 0], P[BASE + 1]), a1 = cvt_pk_bf16(P[BASE + 2], P[BASE + 3]);   \
    unsigned b0 = cvt_pk_bf16(P[BASE + 4], P[BASE + 5]), b1 = cvt_pk_bf16(P[BASE + 6], P[BASE + 7]);                              \
    auto r0 = __builtin_amdgcn_permlane32_swap(a0, b0, false, false); auto r1 = __builtin_amdgcn_permlane32_swap(a1, b1, false, false); \
    u32x4 w = {r0[0], r1[0], r0[1], r1[1]}; OUT = *reinterpret_cast<bf16x8*>(&w); } while (0)
    PK4(p0, 0, pa0); PK4(p0, 8, pa1); PK4(p1, 0, pa2); PK4(p1, 8, pa3);
#undef PK4
}
template <int DQK> struct Cfg { static constexpr float SCALE = DQK == 128 ? 0.088388347648318440f : 0.072168783648703220f; static constexpr float THR = 8.f; };
template <int DQK>
__device__ __forceinline__ void partialSM(f32x16& p0, f32x16& p1, float& m_reg, float& mn, float& alpha) {
    constexpr float SCALE = Cfg<DQK>::SCALE, THR = Cfg<DQK>::THR;
    constexpr float C = SCALE * 1.4426950408889634f;
    float pmax = p0[0];
#pragma unroll
    for (int r = 1; r < 16; ++r) pmax = fmaxf(pmax, p0[r]);
#pragma unroll
    for (int r = 0; r < 16; ++r) pmax = fmaxf(pmax, p1[r]);
    { auto rr = __builtin_amdgcn_permlane32_swap(__float_as_uint(pmax), __float_as_uint(pmax), false, false);
      pmax = fmaxf(__uint_as_float(rr[0]), __uint_as_float(rr[1])); }
    if (__builtin_expect(__all(pmax - m_reg <= THR / SCALE), 1)) { mn = m_reg; alpha = 1.f; }
    else { mn = fmaxf(m_reg, pmax); alpha = __builtin_amdgcn_exp2f((m_reg - mn) * C); m_reg = mn; }
    float mnC = -mn * C;
#pragma unroll
    for (int r = 0; r < 16; ++r) p0[r] = fmaf(p0[r], C, mnC);
#pragma unroll
    for (int r = 0; r < 16; ++r) p1[r] = fmaf(p1[r], C, mnC);
#pragma unroll
    for (int r = 0; r < 16; ++r) p0[r] = __builtin_amdgcn_exp2f(p0[r]);
}
__device__ __forceinline__ void finishSM(f32x16& p0, f32x16& p1, float alpha, float& l_reg, bf16x8& pa0, bf16x8& pa1, bf16x8& pa2, bf16x8& pa3) {
#pragma unroll
    for (int r = 0; r < 16; ++r) p1[r] = __builtin_amdgcn_exp2f(p1[r]);
    float ps = 0;
#pragma unroll
    for (int r = 0; r < 16; ++r) ps += p0[r];
#pragma unroll
    for (int r = 0; r < 16; ++r) ps += p1[r];
    { auto rr = __builtin_amdgcn_permlane32_swap(__float_as_uint(ps), __float_as_uint(ps), false, false);
      ps = __uint_as_float(rr[0]) + __uint_as_float(rr[1]); }
    l_reg = l_reg * alpha + ps;
    p_to_frags(p0, p1, pa0, pa1, pa2, pa3);
}
template <int DQK>
__device__ __forceinline__ void qkt(f32x16& p0, f32x16& p1, const LAS char* Ks, const LAS char* Rs, const bf16x8* qr, int r32, int hi) {
    p0 = f32x16{}; p1 = f32x16{};
#pragma unroll
    for (int d0 = 0; d0 < 8; ++d0) { const int cb = (d0 * 16 + hi * 8) * 2;
        const bf16x8 b0 = *reinterpret_cast<const LAS bf16x8*>(Ks + KSWZ(r32, cb));
        const bf16x8 b1 = *reinterpret_cast<const LAS bf16x8*>(Ks + KSWZ(32 + r32, cb));
        p0 = __builtin_amdgcn_mfma_f32_32x32x16_bf16(b0, qr[d0], p0, 0, 0, 0);
        p1 = __builtin_amdgcn_mfma_f32_32x32x16_bf16(b1, qr[d0], p1, 0, 0, 0); }
    if constexpr (DQK == 192) {
#pragma unroll
        for (int d0 = 0; d0 < 4; ++d0) { const int cb = (d0 * 16 + hi * 8) * 2;
            const bf16x8 b0 = *reinterpret_cast<const LAS bf16x8*>(Rs + KSWZ(r32, cb));
            const bf16x8 b1 = *reinterpret_cast<const LAS bf16x8*>(Rs + KSWZ(32 + r32, cb));
            p0 = __builtin_amdgcn_mfma_f32_32x32x16_bf16(b0, qr[8 + d0], p0, 0, 0, 0);
            p1 = __builtin_amdgcn_mfma_f32_32x32x16_bf16(b1, qr[8 + d0], p1, 0, 0, 0); }
    }
}
template <int DQK> constexpr int attn_lds_bytes() { return 4 * SHM_T + (DQK == 192 ? 2 * SHM_T : 0) + NW * 64 * 4; }

template <int DQK, int LDQ, int LDK, int LDV, int LDO>
__device__ __forceinline__ void attn_body(const bf16_t* __restrict__ Qb, const bf16_t* __restrict__ Kh, const bf16_t* __restrict__ Rh, const bf16_t* __restrict__ Vh,
                                          bf16_t* __restrict__ Ob, int seq, LAS char* lds, const int tid) {
    constexpr int ND = DQK / 16;
    const int wid = tid >> 6, lane = tid & 63, r32 = lane & 31, hi = lane >> 5;
    LAS char* V_lds = lds; LAS char* K_lds = lds + 2 * SHM_T; LAS char* R_lds = lds + 4 * SHM_T;
    LAS float* wsl = (LAS float*)(lds + 4 * SHM_T + (DQK == 192 ? 2 * SHM_T : 0)) + wid * 64; LAS float* li_l = wsl; LAS float* al_l = wsl + 32;
    float m_reg = -1e30f, l_reg = 0; f32x16 o[4] = {}; bf16x8 qr[ND];
    const bf16_t* Qw = Qb + (long)(wid * QBLK + r32) * LDQ + hi * 8;
#pragma unroll
    for (int d0 = 0; d0 < ND; ++d0) qr[d0] = *reinterpret_cast<const bf16x8*>(Qw + d0 * 16);
    const int sr = tid >> 4, sc = (tid & 15) * 8, vst0 = v_st(sr, sc), vst1 = v_st(32 + sr, sc);
    const int rr = tid >> 3, rc = (tid & 7) * 8;
    const int vb0 = (int)(uintptr_t)V_lds + v_rd_base(lane);
    struct { bf16x8 vs0, vs1, ks0, ks1, rs; } sr_[2];
#define SLOAD(i, k0) do { sr_[i].vs0 = *reinterpret_cast<const bf16x8*>(&Vh[(long)((k0) + sr) * LDV + sc]); sr_[i].vs1 = *reinterpret_cast<const bf16x8*>(&Vh[(long)((k0) + 32 + sr) * LDV + sc]); \
    sr_[i].ks0 = *reinterpret_cast<const bf16x8*>(&Kh[(long)((k0) + sr) * LDK + sc]); sr_[i].ks1 = *reinterpret_cast<const bf16x8*>(&Kh[(long)((k0) + 32 + sr) * LDK + sc]); \
    if constexpr (DQK == 192) sr_[i].rs = *reinterpret_cast<const bf16x8*>(&Rh[(long)((k0) + rr) * 64 + rc]); } while (0)
#define SWRITE(b, i) do { *(LAS bf16x8*)(V_lds + (b) * SHM_T + vst0) = sr_[i].vs0; *(LAS bf16x8*)(V_lds + (b) * SHM_T + vst1) = sr_[i].vs1; const int kc = sc * 2; \
    *(LAS bf16x8*)(K_lds + (b) * SHM_T + KSWZ(sr, kc)) = sr_[i].ks0; *(LAS bf16x8*)(K_lds + (b) * SHM_T + KSWZ(32 + sr, kc)) = sr_[i].ks1; \
    if constexpr (DQK == 192) *(LAS bf16x8*)(R_lds + (b) * SHM_T + KSWZ(rr, rc * 2)) = sr_[i].rs; } while (0)
#define SWAIT() do { if constexpr (DQK == 192) asm volatile("s_waitcnt vmcnt(5)" ::: "memory"); else asm volatile("s_waitcnt vmcnt(4)" ::: "memory"); } while (0)
#define RESC(a) do { if (__any((a) < 1.f)) { if (hi == 0) al_l[r32] = (a); asm volatile("s_waitcnt lgkmcnt(0)" ::: "memory"); \
    _Pragma("unroll") for (int d = 0; d < 4; ++d) _Pragma("unroll") for (int r = 0; r < 16; ++r) o[d][r] *= al_l[crow(r, hi)]; } } while (0)
    f32x16 pA0, pA1, pB0, pB1; float mnA, mnB, alA, alB; bf16x8 pa0, pa1, pa2, pa3; const int NT = seq / KVBLK;
    constexpr int SE = 0, SO = 1;
    SLOAD(SE, 0); asm volatile("s_waitcnt vmcnt(0)" ::: "memory"); SWRITE(0, SE); __syncthreads();
    qkt<DQK>(pA0, pA1, K_lds, R_lds, qr, r32, hi); partialSM<DQK>(pA0, pA1, m_reg, mnA, alA);
    SLOAD(SO, KVBLK); if (2 < NT) SLOAD(SE, 2 * KVBLK);
    SWAIT(); SWRITE(1, SO); __syncthreads();
    for (int j = 1; j + 1 < NT; j += 2) {
        SBAR(); qkt<DQK>(pB0, pB1, K_lds + SHM_T, R_lds + SHM_T, qr, r32, hi);
        finishSM(pA0, pA1, alA, l_reg, pa0, pa1, pa2, pa3); SBAR();
        SLOAD(SO, (j + 2) * KVBLK); SBAR();
        pv_d0(o, vb0, pa0, pa1, pa2, pa3); partialSM<DQK>(pB0, pB1, m_reg, mnB, alB);
        __syncthreads(); SWAIT(); SWRITE(0, SE);
        RESC(alB); __syncthreads();
        SBAR(); qkt<DQK>(pA0, pA1, K_lds, R_lds, qr, r32, hi);
        finishSM(pB0, pB1, alB, l_reg, pa0, pa1, pa2, pa3); SBAR();
        if (j + 3 < NT) SLOAD(SE, (j + 3) * KVBLK); SBAR();
        pv_d0(o, vb0 + SHM_T, pa0, pa1, pa2, pa3); partialSM<DQK>(pA0, pA1, m_reg, mnA, alA);
        __syncthreads(); SWAIT(); SWRITE(1, SO);
        RESC(alA); __syncthreads();
    }
    SBAR(); qkt<DQK>(pB0, pB1, K_lds + SHM_T, R_lds + SHM_T, qr, r32, hi);
    finishSM(pA0, pA1, alA, l_reg, pa0, pa1, pa2, pa3); SBAR();
    pv_d0(o, vb0, pa0, pa1, pa2, pa3); partialSM<DQK>(pB0, pB1, m_reg, mnB, alB);
    __syncthreads(); RESC(alB);
    finishSM(pB0, pB1, alB, l_reg, pa0, pa1, pa2, pa3); SBAR();
    pv_d0(o, vb0 + SHM_T, pa0, pa1, pa2, pa3);
    if (hi == 0) li_l[r32] = l_reg; asm volatile("s_waitcnt lgkmcnt(0)" ::: "memory");
    float rli[16];
#pragma unroll
    for (int r = 0; r < 16; ++r) rli[r] = __builtin_amdgcn_rcpf(li_l[crow(r, hi)]);
    bf16_t* Ow = Ob + (long)(wid * QBLK) * LDO;
#pragma unroll
    for (int r = 0; r < 16; ++r) { const int orow = crow(r, hi);
#pragma unroll
        for (int d0 = 0; d0 < 4; ++d0) Ow[(long)orow * LDO + d0 * 32 + r32] = (bf16_t)(cvt_pk_bf16(o[d0][r] * rli[r], 0.f) & 0xffffu); }
    __syncthreads();
#undef SLOAD
#undef SWRITE
#undef SWAIT
#undef RESC
}
template <int DQK, int LDQ, int LDK, int LDV, int LDO>
__device__ __forceinline__ void attn_simple(const bf16_t* __restrict__ Qb, const bf16_t* __restrict__ Kh, const bf16_t* __restrict__ Rh, const bf16_t* __restrict__ Vh,
                                            bf16_t* __restrict__ Ob, int seq, LAS char* lds, const int tid) {
    constexpr int ND = DQK / 16;
    const int wid = tid >> 6, lane = tid & 63, r32 = lane & 31, hi = lane >> 5;
    LAS char* V_lds = lds; LAS char* K_lds = lds + 2 * SHM_T; LAS char* R_lds = lds + 4 * SHM_T;
    LAS float* wsl = (LAS float*)(lds + 4 * SHM_T + (DQK == 192 ? 2 * SHM_T : 0)) + wid * 64; LAS float* li_l = wsl; LAS float* al_l = wsl + 32;
    float m_reg = -1e30f, l_reg = 0; f32x16 o[4] = {}; bf16x8 qr[ND];
    const bf16_t* Qw = Qb + (long)(wid * QBLK + r32) * LDQ + hi * 8;
#pragma unroll
    for (int d0 = 0; d0 < ND; ++d0) qr[d0] = *reinterpret_cast<const bf16x8*>(Qw + d0 * 16);
    const int sr = tid >> 4, sc = (tid & 15) * 8, vst0 = v_st(sr, sc), vst1 = v_st(32 + sr, sc);
    const int rr = tid >> 3, rc = (tid & 7) * 8;
    const int vb0 = (int)(uintptr_t)V_lds + v_rd_base(lane);
    bf16x8 vs0, vs1, ks0, ks1, rs;
#define SLOAD(k0) do { vs0 = *reinterpret_cast<const bf16x8*>(&Vh[(long)((k0) + sr) * LDV + sc]); vs1 = *reinterpret_cast<const bf16x8*>(&Vh[(long)((k0) + 32 + sr) * LDV + sc]); \
    ks0 = *reinterpret_cast<const bf16x8*>(&Kh[(long)((k0) + sr) * LDK + sc]); ks1 = *reinterpret_cast<const bf16x8*>(&Kh[(long)((k0) + 32 + sr) * LDK + sc]); \
    if constexpr (DQK == 192) rs = *reinterpret_cast<const bf16x8*>(&Rh[(long)((k0) + rr) * 64 + rc]); } while (0)
#define SWRITE(b) do { *(LAS bf16x8*)(V_lds + (b) * SHM_T + vst0) = vs0; *(LAS bf16x8*)(V_lds + (b) * SHM_T + vst1) = vs1; const int kc = sc * 2; \
    *(LAS bf16x8*)(K_lds + (b) * SHM_T + KSWZ(sr, kc)) = ks0; *(LAS bf16x8*)(K_lds + (b) * SHM_T + KSWZ(32 + sr, kc)) = ks1; \
    if constexpr (DQK == 192) *(LAS bf16x8*)(R_lds + (b) * SHM_T + KSWZ(rr, rc * 2)) = rs; } while (0)
    const int NT = seq / KVBLK;
    SLOAD(0); asm volatile("s_waitcnt vmcnt(0)" ::: "memory"); SWRITE(0); __syncthreads();
    if (1 < NT) SLOAD(KVBLK);
    for (int j = 0; j < NT; ++j) {
        const int b = j & 1;
        f32x16 p0, p1; float mn, alpha; bf16x8 pa0, pa1, pa2, pa3;
        qkt<DQK>(p0, p1, K_lds + b * SHM_T, R_lds + b * SHM_T, qr, r32, hi);
        partialSM<DQK>(p0, p1, m_reg, mn, alpha);
        if (__any(alpha < 1.f)) { if (hi == 0) al_l[r32] = alpha; asm volatile("s_waitcnt lgkmcnt(0)" ::: "memory");
#pragma unroll
            for (int d = 0; d < 4; ++d)
#pragma unroll
                for (int r = 0; r < 16; ++r) o[d][r] *= al_l[crow(r, hi)]; }
        finishSM(p0, p1, alpha, l_reg, pa0, pa1, pa2, pa3);
        if (j + 1 < NT) SWRITE(b ^ 1);
        if (j + 2 < NT) SLOAD((j + 2) * KVBLK);
        pv_d0(o, vb0 + b * SHM_T, pa0, pa1, pa2, pa3);
        __syncthreads();
    }
    if (hi == 0) li_l[r32] = l_reg; asm volatile("s_waitcnt lgkmcnt(0)" ::: "memory");
    float rli[16];
#pragma unroll
    for (int r = 0; r < 16; ++r) rli[r] = __builtin_amdgcn_rcpf(li_l[crow(r, hi)]);
    bf16_t* Ow = Ob + (long)(wid * QBLK) * LDO;
#pragma unroll
    for (int r = 0; r < 16; ++r) { const int orow = crow(r, hi);
#pragma unroll
        for (int d0 = 0; d0 < 4; ++d0) Ow[(long)orow * LDO + d0 * 32 + r32] = (bf16_t)(cvt_pk_bf16(o[d0][r] * rli[r], 0.f) & 0xffffu); }
    __syncthreads();
#undef SLOAD
#undef SWRITE
}
#define RSWZ(row, colB) ((row) * 128 + ((colB) ^ ((((row) >> 1) & 7) << 4)))
template <int DQK>
__device__ __forceinline__ void qkt_dma(f32x16& p0, f32x16& p1, const LAS char* Ks, const LAS char* Rs, const bf16x8* qr, int r32, int hi) {
    p0 = f32x16{}; p1 = f32x16{};
#pragma unroll
    for (int d0 = 0; d0 < 8; ++d0) { const int cb = (d0 * 16 + hi * 8) * 2;
        const bf16x8 b0 = *reinterpret_cast<const LAS bf16x8*>(Ks + KSWZ(r32, cb));
        const bf16x8 b1 = *reinterpret_cast<const LAS bf16x8*>(Ks + KSWZ(32 + r32, cb));
        p0 = __builtin_amdgcn_mfma_f32_32x32x16_bf16(b0, qr[d0], p0, 0, 0, 0);
        p1 = __builtin_amdgcn_mfma_f32_32x32x16_bf16(b1, qr[d0], p1, 0, 0, 0); }
    if constexpr (DQK == 192) {
#pragma unroll
        for (int d0 = 0; d0 < 4; ++d0) { const int cb = (d0 * 16 + hi * 8) * 2;
            const bf16x8 b0 = *reinterpret_cast<const LAS bf16x8*>(Rs + RSWZ(r32, cb));
            const bf16x8 b1 = *reinterpret_cast<const LAS bf16x8*>(Rs + RSWZ(32 + r32, cb));
            p0 = __builtin_amdgcn_mfma_f32_32x32x16_bf16(b0, qr[8 + d0], p0, 0, 0, 0);
            p1 = __builtin_amdgcn_mfma_f32_32x32x16_bf16(b1, qr[8 + d0], p1, 0, 0, 0); }
    }
}
template <int DQK, int LDQ, int LDK, int LDV, int LDO>
__device__ __forceinline__ void attn_dma(const bf16_t* __restrict__ Qb, const bf16_t* __restrict__ Kh, const bf16_t* __restrict__ Rh, const bf16_t* __restrict__ Vh,
                                         bf16_t* __restrict__ Ob, int seq, LAS char* lds, LAS float* wscr, const int tid) {
    constexpr int ND = DQK / 16, KOFF = 0, VOFF = 3 * SHM_T, ROFF = 6 * SHM_T;
    const int wid = __builtin_amdgcn_readfirstlane(tid >> 6), lane = tid & 63, r32 = lane & 31, hi = lane >> 5;
    LAS float* li_l = wscr + wid * 64; LAS float* al_l = li_l + 32;
    float m_reg = -1e30f, l_reg = 0; f32x16 o[4] = {}; bf16x8 qr[ND];
    const bf16_t* Qw = Qb + (long)(wid * QBLK + r32) * LDQ + hi * 8;
#pragma unroll
    for (int d0 = 0; d0 < ND; ++d0) qr[d0] = *reinterpret_cast<const bf16x8*>(Qw + d0 * 16);
    unsigned voK[2], voV[2], voR;
#pragma unroll
    for (int i = 0; i < 2; ++i) { const int B = i * 8192 + wid * 1024 + lane * 16;
        { const int row = B >> 8, colB = (B & 255) ^ ((row & 7) << 4); voK[i] = (unsigned)(row * LDK * 2 + colB); }
        { const int sub = B >> 9, kk = (sub >> 2) * 8 + ((B & 511) >> 6), c = (sub & 3) * 32 + ((B & 63) >> 1); const int k = (kk & ~0xC) | ((kk & 4) << 1) | ((kk & 8) >> 1);
          voV[i] = (unsigned)((k * LDV + c) * 2); } }
    { const int B = wid * 1024 + lane * 16, row = B >> 7, colB = (B & 127) ^ (((row >> 1) & 7) << 4); voR = (unsigned)(row * 128 + colB); }
    const int vb0 = (int)(uintptr_t)lds + VOFF + v_rd_base(lane);
    const int NT = seq / KVBLK;
#define GLDS(gp, lp) __builtin_amdgcn_global_load_lds((const unsigned*)(gp), (LAS unsigned*)(lp), 16, 0, 0)
#define ISSUE(t, b) do { const char* kg_ = (const char*)Kh + (size_t)(t) * (KVBLK * LDK * 2); const char* vg_ = (const char*)Vh + (size_t)(t) * (KVBLK * LDV * 2); \
    LAS char* kl_ = lds + KOFF + (b) * SHM_T + wid * 1024; LAS char* vl_ = lds + VOFF + (b) * SHM_T + wid * 1024; \
    GLDS(kg_ + voK[0], kl_); GLDS(kg_ + voK[1], kl_ + 8192); GLDS(vg_ + voV[0], vl_); GLDS(vg_ + voV[1], vl_ + 8192); \
    if constexpr (DQK == 192) GLDS((const char*)Rh + (size_t)(t) * (KVBLK * 128) + voR, lds + ROFF + (b) * 8192 + wid * 1024); } while (0)
#define WAITV(n) asm volatile("s_waitcnt vmcnt(" #n ")" ::: "memory")
#define BARX() do { asm volatile("s_waitcnt lgkmcnt(0)" ::: "memory"); __builtin_amdgcn_s_barrier(); asm volatile("" ::: "memory"); SBAR(); } while (0)
#define RESC(a) do { if (__any((a) < 1.f)) { if (hi == 0) al_l[r32] = (a); asm volatile("s_waitcnt lgkmcnt(0)" ::: "memory"); \
    _Pragma("unroll") for (int d = 0; d < 4; ++d) _Pragma("unroll") for (int r = 0; r < 16; ++r) o[d][r] *= al_l[crow(r, hi)]; } } while (0)
    f32x16 pA0, pA1, pB0, pB1; float mnA, mnB, alA, alB; bf16x8 pa0, pa1, pa2, pa3;
    ISSUE(0, 0); ISSUE(1, 1); if (2 < NT) ISSUE(2, 2);
    if (2 < NT) { if constexpr (DQK == 192) WAITV(10); else WAITV(8); } else { if constexpr (DQK == 192) WAITV(5); else WAITV(4); }
    BARX();
    qkt_dma<DQK>(pA0, pA1, lds + KOFF, lds + ROFF, qr, r32, hi); partialSM<DQK>(pA0, pA1, m_reg, mnA, alA);
    if (2 < NT) { if constexpr (DQK == 192) WAITV(5); else WAITV(4); } else WAITV(0);
    BARX();
    int bp = 0, bc = 1;
#define STEP(j, C0, C1, mnC, alC, P0, P1, alP) do { \
    SBAR(); qkt_dma<DQK>(C0, C1, lds + KOFF + bc * SHM_T, lds + ROFF + bc * 8192, qr, r32, hi); \
    finishSM(P0, P1, alP, l_reg, pa0, pa1, pa2, pa3); SBAR(); \
    pv_d0(o, vb0 + bp * SHM_T, pa0, pa1, pa2, pa3); partialSM<DQK>(C0, C1, m_reg, mnC, alC); \
    WAITV(0); BARX(); \
    if ((j) + 2 < NT) ISSUE((j) + 2, bp); \
    RESC(alC); \
    bp = bc; bc = (bc == 2) ? 0 : bc + 1; } while (0)
    for (int j = 1; j + 1 < NT; j += 2) {
        STEP(j, pB0, pB1, mnB, alB, pA0, pA1, alA);
        STEP(j + 1, pA0, pA1, mnA, alA, pB0, pB1, alB);
    }
    STEP(NT - 1, pB0, pB1, mnB, alB, pA0, pA1, alA);
    finishSM(pB0, pB1, alB, l_reg, pa0, pa1, pa2, pa3); SBAR();
    pv_d0(o, vb0 + bp * SHM_T, pa0, pa1, pa2, pa3);
    if (hi == 0) li_l[r32] = l_reg; asm volatile("s_waitcnt lgkmcnt(0)" ::: "memory");
    float rli[16];
#pragma unroll
    for (int r = 0; r < 16; ++r) rli[r] = __builtin_amdgcn_rcpf(li_l[crow(r, hi)]);
    bf16_t* Ow = Ob + (long)(wid * QBLK) * LDO;
#pragma unroll
    for (int r = 0; r < 16; ++r) { const int orow = crow(r, hi);
#pragma unroll
        for (int d0 = 0; d0 < 4; ++d0) Ow[(long)orow * LDO + d0 * 32 + r32] = (bf16_t)(cvt_pk_bf16(o[d0][r] * rli[r], 0.f) & 0xffffu); }
    BARX();
#undef GLDS
#undef ISSUE
#undef WAITV
#undef BARX
#undef RESC
#undef STEP
}
}

struct Params {
    const float* in[32];
    float* out; unsigned char* ws;
    int ph_lo, ph_hi;
};
enum { I_XP = 0, I_XS, I_C, I_CAK, I_CAV, I_SRF, I_SRB, I_CCKV, I_CKR, I_CCTX, I_WMOD, I_BMOD, I_GPMIX, I_GPOMIX, I_GPMLP, I_GPOMLP, I_WIN, I_AQN, I_AKN, I_RDF, I_RDB, I_RGN,
       I_MQN, I_MKVN, I_WUQ, I_WUKV, I_WBA, I_WBB, I_WBC, I_WOUT, I_WUP, I_WDN };
constexpr size_t O_YP = 0, O_YS = 8388608, O_NAK = 25165824, O_NAV = O_NAK + 4194304, O_NRF = O_NAV + 4194304, O_NRB = O_NRF + 8388608, O_NCKV = O_NRB + 8388608, O_NKR = O_NCKV + 4194304, O_END = O_NKR + 1048576;

typedef const __attribute__((address_space(4))) Params CParams;
struct Ctx {
    LAS unsigned char* lds; int tid, lane, wave, bid, G;
    CParams* p;
};

struct TItem { const float* W; bf16_t* WT; int K, N, ldw, shift_from, shift; };
__device__ __forceinline__ void ti_load(f32x4 (&v)[8], const TItem& t, int item, int lane) {
    const int nblk = t.N / 32, kb = item / nblk, nb = item - kb * nblk, k0 = 64 * kb, n0 = 32 * nb;
    const float* p = t.W + (size_t)(k0 + (lane >> 3)) * t.N + n0 + (lane & 7) * 4;
#pragma unroll
    for (int i = 0; i < 8; ++i) v[i] = *(const f32x4*)(p + (size_t)(8 * i) * t.N);
}
__device__ __forceinline__ void ti_store(const f32x4 (&v)[8], const TItem& t, int item, int lane, LAS float* scr) {
    const int nblk = t.N / 32, kb = item / nblk, nb = item - kb * nblk, k0 = 64 * kb, n0 = 32 * nb;
#pragma unroll
    for (int i = 0; i < 8; ++i) { LAS float* s = scr + (8 * i + (lane >> 3)) * 33 + (lane & 7) * 4; s[0] = v[i][0]; s[1] = v[i][1]; s[2] = v[i][2]; s[3] = v[i][3]; }
    LDS_WAIT(); asm volatile("" ::: "memory");
    const int c = lane & 7; const int r0 = n0 + (n0 >= t.shift_from ? t.shift : 0);
#pragma unroll
    for (int j = 0; j < 4; ++j) { const int n = (lane >> 3) + 8 * j; const LAS float* s = scr + (8 * c) * 33 + n;
        u32x4 o; o.x = cvt_pk_bf16(s[0 * 33], s[1 * 33]); o.y = cvt_pk_bf16(s[2 * 33], s[3 * 33]); o.z = cvt_pk_bf16(s[4 * 33], s[5 * 33]); o.w = cvt_pk_bf16(s[6 * 33], s[7 * 33]);
        *(u32x4*)(t.WT + (size_t)(r0 + n) * t.ldw + k0 + 8 * c) = o; }
    LDS_WAIT(); asm volatile("" ::: "memory");
}
__device__ __forceinline__ TItem ti_decode(CParams& P, unsigned char* ws, int l, int& r) {
    constexpr int I_IN = 32 * 362, I_UQ = 8 * 48, I_UKV = 4 * 64, I_BR = 16 * 64, I_OUT = 32 * 64, I_UP = 32 * 256;
    if (r < I_IN) return TItem{P.in[I_WIN] + (size_t)l * 2048 * 11584, (bf16_t*)(ws + WS_WIN + l * SZ_WIN), 2048, 11584, LDH, 5440, 192}; r -= I_IN;
    if (r < I_UQ) return TItem{P.in[I_WUQ] + (size_t)l * 512 * 1536, (bf16_t*)(ws + WS_WUQ + l * SZ_WUQ), 512, 1536, 512, 1 << 30, 0}; r -= I_UQ;
    if (r < I_UKV) return TItem{P.in[I_WUKV] + (size_t)l * 256 * 2048, (bf16_t*)(ws + WS_WUKV + l * SZ_WUKV), 256, 2048, 256, 1 << 30, 0}; r -= I_UKV;
    if (r < 3 * I_BR) { const int z = r / I_BR; r -= z * I_BR; return TItem{P.in[I_WBA + z] + (size_t)l * 1024 * 2048, (bf16_t*)(ws + WS_WBR + (l * 3 + z) * SZ_WBR1), 1024, 2048, LDO, 1 << 30, 0}; } r -= 3 * I_BR;
    if (r < I_OUT) return TItem{P.in[I_WOUT] + (size_t)l * 2048 * 2048, (bf16_t*)(ws + WS_WOUT + l * SZ_WOUT), 2048, 2048, LDH, 1 << 30, 0}; r -= I_OUT;
    if (r < I_UP) return TItem{P.in[I_WUP] + (size_t)l * 2048 * 8192, (bf16_t*)(ws + WS_WUP + l * SZ_WUP), 2048, 8192, LDH, 1 << 30, 0}; r -= I_UP;
    return TItem{P.in[I_WDN] + (size_t)l * 8192 * 2048, (bf16_t*)(ws + WS_WDN + l * SZ_WDN), 8192, 2048, LDU, 1 << 30, 0};
}
__device__ __forceinline__ void convert_layer(const Ctx& F, const int l, const int b0, const int nb, const bool do_mod, const int it_lo, const int it_hi) {
    CParams& P = *F.p; unsigned char* ws = P.ws; const int bi = F.bid - b0;
    if (do_mod) {
        LAS float* sv = (LAS float*)F.lds;
        LAS float* red = (LAS float*)(F.lds + 32768);
        for (int i = F.tid; i < 3 * 2048; i += NTHR) { const int v = i >> 11, k = i & 2047; const float x = (v == 0) ? P.in[I_CCTX][k] : P.in[I_C][(v - 1) * 2048 + k]; sv[i] = siluf_(x); }
        __syncthreads();
        float* MOD = (float*)(ws + WS_MOD);
        const int c4 = F.tid & 15, kq = F.tid >> 4;
        for (int cg = bi; cg < 192; cg += nb) {
            const float* w = P.in[I_WMOD] + (size_t)l * 2048 * 12288 + cg * 64 + c4 * 4;
            f32x4 a0 = {0, 0, 0, 0}, a1 = a0, a2 = a0;
#pragma unroll 8
            for (int kk = 0; kk < 64; ++kk) { const int k = kq + 32 * kk; const f32x4 wv = *(const f32x4*)(w + (size_t)k * 12288);
                a0 += wv * sv[k]; a1 += wv * sv[2048 + k]; a2 += wv * sv[4096 + k]; }
#pragma unroll
            for (int j = 0; j < 4; ++j) { red[(kq * 3 + 0) * 64 + c4 * 4 + j] = a0[j]; red[(kq * 3 + 1) * 64 + c4 * 4 + j] = a1[j]; red[(kq * 3 + 2) * 64 + c4 * 4 + j] = a2[j]; }
            __syncthreads();
            if (F.tid < 192) { const int v = F.tid >> 6, col = F.tid & 63; float s = 0.f;
#pragma unroll 8
                for (int q = 0; q < 32; ++q) s += red[(q * 3 + v) * 64 + col];
                MOD[((size_t)l * 3 + v) * 12288 + cg * 64 + col] = s + P.in[I_BMOD][(size_t)l * 12288 + cg * 64 + col]; }
            __syncthreads();
        }
    }
    {
        LAS float* scr = (LAS float*)(F.lds + F.wave * 16384);
        const int gw = bi * NWAVES + F.wave, NGW = nb * NWAVES;
        const int PER_L = it_hi;
        f32x4 va[8], vb[8], vc[8];
#define TI_LOAD(buf, itx) do { if ((itx) < PER_L) { int r_ = (itx); const TItem t_ = ti_decode(P, ws, l, r_); ti_load(buf, t_, r_, F.lane); } } while (0)
#define TI_STORE(buf, itx) do { if ((itx) < PER_L) { int r_ = (itx); const TItem t_ = ti_decode(P, ws, l, r_); ti_store(buf, t_, r_, F.lane, scr); } } while (0)
        TI_LOAD(va, it_lo + gw); TI_LOAD(vb, it_lo + gw + NGW);
        for (int it = it_lo + gw; it < PER_L; it += 3 * NGW) {
            TI_LOAD(vc, it + 2 * NGW); TI_STORE(va, it);
            TI_LOAD(va, it + 3 * NGW); TI_STORE(vb, it + NGW);
            TI_LOAD(vb, it + 4 * NGW); TI_STORE(vc, it + 2 * NGW);
        }
#undef TI_LOAD
#undef TI_STORE
    }
}

struct NRow { f32x4 x[8]; u32x2 pa[8], pb[8]; };
__device__ __forceinline__ void nrow_load(NRow& R, int r, int lane, const float* xin_ctx, const float* xin_lat, const bf16_t* o0, const bf16_t* o1) {
    const float* xr = r < NCTX ? xin_ctx + (size_t)r * DM : xin_lat + (size_t)(r - NCTX) * DM;
#pragma unroll
    for (int j = 0; j < 8; ++j) R.x[j] = *(const f32x4*)(xr + (lane + 64 * j) * 4);
    if (o0) {
#pragma unroll
        for (int j = 0; j < 8; ++j) { R.pa[j] = *(const u32x2*)(o0 + (size_t)r * DM + (lane + 64 * j) * 4); R.pb[j] = *(const u32x2*)(o1 + (size_t)r * DM + (lane + 64 * j) * 4); }
    }
}
__device__ __forceinline__ void norm_phase(const Ctx& F, const float* xin_ctx, const float* xin_lat, const bf16_t* o0, const bf16_t* o1, float* X, bf16_t* H,
                                           const float* modA, int gate_off, const float* gA, const float* modB, int scale_off, int shift_off, const float* gB) {
    const int gw = F.bid * NWAVES + F.wave, NGW = F.G * NWAVES;
    NRow cur, nxt;
    if (gw < NTOK) nrow_load(cur, gw, F.lane, xin_ctx, xin_lat, o0, o1);
    for (int r = gw; r < NTOK; r += NGW) {
        if (r + NGW < NTOK) nrow_load(nxt, r + NGW, F.lane, xin_ctx, xin_lat, o0, o1);
        const int v = r < NCTX ? 0 : 1 + ((r - NCTX) >> 12);
        f32x4 x[8];
#pragma unroll
        for (int j = 0; j < 8; ++j) x[j] = cur.x[j];
        if (o0) {
            f32x4 o[8]; float ss = 0.f;
#pragma unroll
            for (int j = 0; j < 8; ++j) { const u32x2 pa = cur.pa[j], pb = cur.pb[j];
                o[j] = (f32x4){bf_lo(pa.x) + bf_lo(pb.x), bf_hi(pa.x) + bf_hi(pb.x), bf_lo(pa.y) + bf_lo(pb.y), bf_hi(pa.y) + bf_hi(pb.y)};
                ss += (o[j][0] * o[j][0] + o[j][1] * o[j][1]) + (o[j][2] * o[j][2] + o[j][3] * o[j][3]); }
            const float rs = 1.0f / sqrtf(wave_sum(ss) * (1.0f / DM) + EPS);
#pragma unroll
            for (int j = 0; j < 8; ++j) { const int c = (F.lane + 64 * j) * 4; const f32x4 ga = *(const f32x4*)(gA + c), gt = *(const f32x4*)(modA + (size_t)v * 12288 + gate_off + c);
                x[j] += gt * (o[j] * rs * ga); }
        }
        if (X) {
#pragma unroll
            for (int j = 0; j < 8; ++j) *(f32x4*)(X + (size_t)r * DM + (F.lane + 64 * j) * 4) = x[j]; }
        if (gB) {
            float ss = 0.f;
#pragma unroll
            for (int j = 0; j < 8; ++j) ss += (x[j][0] * x[j][0] + x[j][1] * x[j][1]) + (x[j][2] * x[j][2] + x[j][3] * x[j][3]);
            const float rs = 1.0f / sqrtf(wave_sum(ss) * (1.0f / DM) + EPS);
#pragma unroll
            for (int j = 0; j < 8; ++j) { const int c = (F.lane + 64 * j) * 4; const f32x4 gb = *(const f32x4*)(gB + c);
                const f32x4 sc = *(const f32x4*)(modB + (size_t)v * 12288 + scale_off + c), sh = *(const f32x4*)(modB + (size_t)v * 12288 + shift_off + c);
                const f32x4 h = (x[j] * rs * gb) * (sc + 1.0f) + sh;
                u32x2 w; w.x = cvt_pk_bf16(h[0], h[1]); w.y = cvt_pk_bf16(h[2], h[3]);
                *(u32x2*)(H + (size_t)r * LDH + c) = w; }
        }
        cur = nxt;
    }
}

struct RopeCS { float c0, s0, c1, s1; };
__device__ __forceinline__ RopeCS rope_cs128(int lane, int prow, int pcol) {
    const int i0 = (2 * lane) & 31; const float pos = (float)((lane >> 5) ? pcol : prow);
    const float r0 = pos * __builtin_amdgcn_exp2f(-(float)i0 * (13.287712379549449f / 32.0f)) * 0.15915494309189535f;
    const float r1 = pos * __builtin_amdgcn_exp2f(-(float)(i0 + 1) * (13.287712379549449f / 32.0f)) * 0.15915494309189535f;
    RopeCS t; t.c0 = __builtin_amdgcn_cosf(r0); t.s0 = __builtin_amdgcn_sinf(r0); t.c1 = __builtin_amdgcn_cosf(r1); t.s1 = __builtin_amdgcn_sinf(r1);
    if ((lane & 16) == 0) { t.s0 = -t.s0; t.s1 = -t.s1; }
    return t;
}
__device__ __forceinline__ RopeCS rope_cs64(int g, int prow, int pcol) {
    const int i0 = (2 * g) & 15; const float pos = (float)((g >> 4) ? pcol : prow);
    const float r0 = pos * __builtin_amdgcn_exp2f(-(float)i0 * (13.287712379549449f / 16.0f)) * 0.15915494309189535f;
    const float r1 = pos * __builtin_amdgcn_exp2f(-(float)(i0 + 1) * (13.287712379549449f / 16.0f)) * 0.15915494309189535f;
    RopeCS t; t.c0 = __builtin_amdgcn_cosf(r0); t.s0 = __builtin_amdgcn_sinf(r0); t.c1 = __builtin_amdgcn_cosf(r1); t.s1 = __builtin_amdgcn_sinf(r1);
    if ((g & 8) == 0) { t.s0 = -t.s0; t.s1 = -t.s1; }
    return t;
}
__device__ __forceinline__ void rope128(float& y0, float& y1, const RopeCS& t) { const float p0 = swz_xor<16>(y0), p1 = swz_xor<16>(y1); y0 = y0 * t.c0 + p0 * t.s0; y1 = y1 * t.c1 + p1 * t.s1; }
__device__ __forceinline__ void rope64(float& y0, float& y1, const RopeCS& t) { const float p0 = swz_xor<8>(y0), p1 = swz_xor<8>(y1); y0 = y0 * t.c0 + p0 * t.s0; y1 = y1 * t.c1 + p1 * t.s1; }
struct PPRow { unsigned uq[10], uv[2], ub[8], ukr; u32x4 ucq; u32x2 ukv; };
__device__ __forceinline__ void pp_load(PPRow& R, const unsigned* P32, int lane) {
#pragma unroll
    for (int hd = 0; hd < 10; ++hd) R.uq[hd] = P32[hd * 64 + lane];
#pragma unroll
    for (int j = 0; j < 2; ++j) R.uv[j] = P32[C_AV / 2 + j * 64 + lane];
#pragma unroll
    for (int hd = 0; hd < 8; ++hd) R.ub[hd] = P32[C_BQ / 2 + hd * 64 + lane];
    R.ucq = *(const u32x4*)(P32 + C_CQL / 2 + 4 * lane); R.ukv = *(const u32x2*)(P32 + C_CKV / 2 + 2 * lane); R.ukr = P32[C_CKR / 2 + (lane & 31)];
}
template <bool DRY>
__device__ __forceinline__ void phase_postproj(const Ctx& F, int l) {
    CParams& P = *F.p; unsigned char* ws = P.ws;
    bf16_t* PROJ = (bf16_t*)(ws + WS_PROJ); bf16_t* KA = (bf16_t*)(ws + WS_KA); bf16_t* VA = (bf16_t*)(ws + WS_VA); bf16_t* CKV = (bf16_t*)(ws + WS_CKV); bf16_t* KR = (bf16_t*)(ws + WS_KROPE);
    const int gw = F.bid * NWAVES + F.wave, NGW = F.G * NWAVES, lane = F.lane;
    const f32x2 qn = *(const f32x2*)(P.in[I_AQN] + l * 128 + 2 * lane), kn = *(const f32x2*)(P.in[I_AKN] + l * 128 + 2 * lane);
    const f32x4 mq0 = *(const f32x4*)(P.in[I_MQN] + l * 512 + 8 * lane), mq1 = *(const f32x4*)(P.in[I_MQN] + l * 512 + 8 * lane + 4), mkv = *(const f32x4*)(P.in[I_MKVN] + l * 256 + 4 * lane);
    PPRow cur, nxt;
    if (gw < NTOK) pp_load(cur, (const unsigned*)(PROJ + (size_t)gw * LDP), lane);
    for (int r = gw; r < NTOK; r += NGW) {
        if (r + NGW < NTOK) pp_load(nxt, (const unsigned*)(PROJ + (size_t)(r + NGW) * LDP), lane);
        const bool lat = r >= NCTX; const int lr = r - NCTX, b = lr >> 12, n = lr & 4095, prow = n >> 6, pcol = n & 63;
        const int arow = lat ? NCTX + b * KVL + n : r;
        const int cb = r >> 8, cs = r & 255;
        unsigned* P32 = DRY ? (unsigned*)((bf16_t*)(ws + WS_PART) + (size_t)r * 5632) : (unsigned*)(PROJ + (size_t)r * LDP);
        RopeCS t128, t64;
        if (lat) { t128 = rope_cs128(lane, prow, pcol); t64 = rope_cs64(lane & 31, prow, pcol); }
        float y0[10], y1[10], ss[10];
#pragma unroll
        for (int hd = 0; hd < 10; ++hd) { y0[hd] = bf_lo(cur.uq[hd]); y1[hd] = bf_hi(cur.uq[hd]); ss[hd] = y0[hd] * y0[hd] + y1[hd] * y1[hd]; }
#pragma unroll
        for (int hd = 0; hd < 10; ++hd) ss[hd] = wave_sum(ss[hd]);
#pragma unroll
        for (int hd = 0; hd < 10; ++hd) {
            const float rs = 1.0f / sqrtf(ss[hd] * (1.0f / 128.0f) + EPS); const f32x2 gn = hd < 8 ? qn : kn;
            float a0 = y0[hd] * rs * gn[0], a1 = y1[hd] * rs * gn[1];
            if (lat) rope128(a0, a1, t128);
            if (hd < 8) P32[hd * 64 + lane] = cvt_pk_bf16(a0, a1);
            else { const int kvh = hd - 8; ((unsigned*)(KA + (size_t)arow * 256))[kvh * 64 + lane] = cvt_pk_bf16(a0, a1);
                if (!lat) *(f32x2*)(P.out + O_NAK + (((size_t)cb * 4 + l) * 256 + cs) * 256 + kvh * 128 + 2 * lane) = (f32x2){a0, a1}; }
        }
#pragma unroll
        for (int j = 0; j < 2; ++j) { const unsigned u = cur.uv[j]; ((unsigned*)(VA + (size_t)arow * 256))[j * 64 + lane] = u;
            if (!lat) *(f32x2*)(P.out + O_NAV + (((size_t)cb * 4 + l) * 256 + cs) * 256 + j * 128 + 2 * lane) = (f32x2){bf_lo(u), bf_hi(u)}; }
#pragma unroll
        for (int hd = 0; hd < 8; ++hd) {
            if (!lat && hd < 4) continue;
            float a0 = bf_lo(cur.ub[hd]), a1 = bf_hi(cur.ub[hd]);
            if (lat) rope128(a0, a1, t128);
            if (hd >= 4) { a0 *= 0.08838834764831845f; a1 *= 0.08838834764831845f; }
            P32[C_BQ / 2 + hd * 64 + lane] = cvt_pk_bf16(a0, a1);
        }
        { u32x4 u = cur.ucq;
          float y[8] = {bf_lo(u.x), bf_hi(u.x), bf_lo(u.y), bf_hi(u.y), bf_lo(u.z), bf_hi(u.z), bf_lo(u.w), bf_hi(u.w)}; float s2 = 0.f;
#pragma unroll
          for (int i = 0; i < 8; ++i) s2 += y[i] * y[i];
          const float rs = 1.0f / sqrtf(wave_sum(s2) * (1.0f / 512.0f) + EPS);
          u.x = cvt_pk_bf16(y[0] * rs * mq0[0], y[1] * rs * mq0[1]); u.y = cvt_pk_bf16(y[2] * rs * mq0[2], y[3] * rs * mq0[3]);
          u.z = cvt_pk_bf16(y[4] * rs * mq1[0], y[5] * rs * mq1[1]); u.w = cvt_pk_bf16(y[6] * rs * mq1[2], y[7] * rs * mq1[3]);
          *(u32x4*)(P32 + C_CQL / 2 + 4 * lane) = u; }
        { const u32x2 u = cur.ukv;
          float y[4] = {bf_lo(u.x), bf_hi(u.x), bf_lo(u.y), bf_hi(u.y)};
          const float rs = 1.0f / sqrtf(wave_sum((y[0] * y[0] + y[1] * y[1]) + (y[2] * y[2] + y[3] * y[3])) * (1.0f / 256.0f) + EPS);
#pragma unroll
          for (int i = 0; i < 4; ++i) y[i] *= rs * mkv[i];
          u32x2 w; w.x = cvt_pk_bf16(y[0], y[1]); w.y = cvt_pk_bf16(y[2], y[3]);
          *(u32x2*)(CKV + (size_t)arow * 256 + 4 * lane) = w;
          if (!lat) *(f32x4*)(P.out + O_NCKV + (((size_t)cb * 4 + l) * 256 + cs) * 256 + 4 * lane) = (f32x4){y[0], y[1], y[2], y[3]}; }
        { float a0 = bf_lo(cur.ukr), a1 = bf_hi(cur.ukr);
          if (lat) rope64(a0, a1, t64);
          if (lane < 32) { ((unsigned*)(KR + (size_t)arow * 64))[lane] = cvt_pk_bf16(a0, a1);
              if (!lat) *(f32x2*)(P.out + O_NKR + (((size_t)cb * 4 + l) * 256 + cs) * 64 + 2 * lane) = (f32x2){a0, a1}; } }
        cur = nxt;
    }
    for (int r = gw; r < 1024; r += NGW) {
        const int b = r >> 9, j = r & 511; const size_t arow = NCTX + (size_t)b * KVL + 4096 + j; const size_t src = ((size_t)b * 4 + l) * 512 + j;
        { const f32x4 k = *(const f32x4*)(P.in[I_CAK] + src * 256 + 4 * lane), v = *(const f32x4*)(P.in[I_CAV] + src * 256 + 4 * lane), c = *(const f32x4*)(P.in[I_CCKV] + src * 256 + 4 * lane);
          u32x2 w; w.x = cvt_pk_bf16(k[0], k[1]); w.y = cvt_pk_bf16(k[2], k[3]); *(u32x2*)(KA + arow * 256 + 4 * lane) = w;
          w.x = cvt_pk_bf16(v[0], v[1]); w.y = cvt_pk_bf16(v[2], v[3]); *(u32x2*)(VA + arow * 256 + 4 * lane) = w;
          w.x = cvt_pk_bf16(c[0], c[1]); w.y = cvt_pk_bf16(c[2], c[3]); *(u32x2*)(CKV + arow * 256 + 4 * lane) = w; }
        if (lane < 16) { const f32x4 k = *(const f32x4*)(P.in[I_CKR] + src * 64 + 4 * lane); u32x2 w; w.x = cvt_pk_bf16(k[0], k[1]); w.y = cvt_pk_bf16(k[2], k[3]); *(u32x2*)(KR + arow * 64 + 4 * lane) = w; }
    }
}

__device__ __forceinline__ float log_sigmoid_(float x) { return -__logf(1.0f + __expf(-x)); }
template <int SCALE_MODE>
__device__ __forceinline__ void stage_vtile(LAS char* dst, const bf16_t* src, int ld, int tid, float lg2, int jbase) {
#pragma unroll
    for (int i = 0; i < 2; ++i) { const int p = tid + 512 * i, k = p >> 4, c8 = (p & 15) * 8;
        u32x4 u = *(const u32x4*)(src + (size_t)k * ld + c8);
        if (SCALE_MODE != 0) { const float jj = (float)(jbase + k); const float f = __builtin_amdgcn_exp2f(lg2 * (SCALE_MODE == 1 ? (127.0f - jj) : jj));
            u.x = cvt_pk_bf16(bf_lo(u.x) * f, bf_hi(u.x) * f); u.y = cvt_pk_bf16(bf_lo(u.y) * f, bf_hi(u.y) * f); u.z = cvt_pk_bf16(bf_lo(u.z) * f, bf_hi(u.z) * f); u.w = cvt_pk_bf16(bf_lo(u.w) * f, bf_hi(u.w) * f); }
        *(LAS u32x4*)(dst + att::v_st(k, c8)) = u; }
}
__device__ __forceinline__ void ret_kv_unit(const Ctx& F, int l, int u) {
    CParams& P = *F.p; unsigned char* ws = P.ws;
    const int c = u >> 2, h = u & 3, row0 = c * 128, tid = F.tid, lane = F.lane, w = F.wave;
    const bf16_t* PROJ = (const bf16_t*)(ws + WS_PROJ);
    const float lgf2 = log_sigmoid_(P.in[I_RDF][l * 4 + h]) * 1.4426950408889634f, lgb2 = log_sigmoid_(P.in[I_RDB][l * 4 + h]) * 1.4426950408889634f;
    LAS char* lds = (LAS char*)F.lds;
#pragma nounroll
    for (int jt = 0; jt < 2; ++jt) {
        const bf16_t* ksrc = PROJ + (size_t)(row0 + jt * 64) * LDP + C_BK + h * 128;
        stage_vtile<1>(lds + jt * 16384, ksrc, LDP, tid, lgf2, jt * 64);
        stage_vtile<2>(lds + 32768 + jt * 16384, ksrc, LDP, tid, lgb2, jt * 64);
#pragma nounroll
        for (int eh = 0; eh < 2; ++eh) stage_vtile<0>(lds + 65536 + (jt * 2 + eh) * 16384, PROJ + (size_t)(row0 + jt * 64) * LDP + C_BV + h * 256 + eh * 128, LDP, tid, 0.f, 0);
    }
    __syncthreads();
    const int dblk = w & 3, eh = w >> 2;
    f32x16 accF[4] = {}, accB[4] = {};
#pragma nounroll
    for (int jt = 0; jt < 2; ++jt) {
        const int vbF = (int)(uintptr_t)lds + jt * 16384 + att::v_rd_base(lane) + dblk * 512, vbB = 32768 + vbF, vbV = 65536 + (jt * 2 + eh) * 16384 + att::v_rd_base(lane);
#define KVSTEP(KS) do { \
        const s16x4 fl = att::tr_read<att::v_rd_off(0, KS, 0)>(vbF), fh = att::tr_read<att::v_rd_off(0, KS, 1)>(vbF), bl = att::tr_read<att::v_rd_off(0, KS, 0)>(vbB), bh = att::tr_read<att::v_rd_off(0, KS, 1)>(vbB); \
        const s16x4 v0l = att::tr_read<att::v_rd_off(0, KS, 0)>(vbV), v0h = att::tr_read<att::v_rd_off(0, KS, 1)>(vbV), v1l = att::tr_read<att::v_rd_off(1, KS, 0)>(vbV), v1h = att::tr_read<att::v_rd_off(1, KS, 1)>(vbV); \
        const s16x4 v2l = att::tr_read<att::v_rd_off(2, KS, 0)>(vbV), v2h = att::tr_read<att::v_rd_off(2, KS, 1)>(vbV), v3l = att::tr_read<att::v_rd_off(3, KS, 0)>(vbV), v3h = att::tr_read<att::v_rd_off(3, KS, 1)>(vbV); \
        asm volatile("s_waitcnt lgkmcnt(0)" ::: "memory"); SBAR(); \
        const bf16x8 af = PKLH(fl, fh), ab = PKLH(bl, bh), b0 = PKLH(v0l, v0h), b1 = PKLH(v1l, v1h), b2 = PKLH(v2l, v2h), b3 = PKLH(v3l, v3h); \
        accF[0] = __builtin_amdgcn_mfma_f32_32x32x16_bf16(af, b0, accF[0], 0, 0, 0); accB[0] = __builtin_amdgcn_mfma_f32_32x32x16_bf16(ab, b0, accB[0], 0, 0, 0); \
        accF[1] = __builtin_amdgcn_mfma_f32_32x32x16_bf16(af, b1, accF[1], 0, 0, 0); accB[1] = __builtin_amdgcn_mfma_f32_32x32x16_bf16(ab, b1, accB[1], 0, 0, 0); \
        accF[2] = __builtin_amdgcn_mfma_f32_32x32x16_bf16(af, b2, accF[2], 0, 0, 0); accB[2] = __builtin_amdgcn_mfma_f32_32x32x16_bf16(ab, b2, accB[2], 0, 0, 0); \
        accF[3] = __builtin_amdgcn_mfma_f32_32x32x16_bf16(af, b3, accF[3], 0, 0, 0); accB[3] = __builtin_amdgcn_mfma_f32_32x32x16_bf16(ab, b3, accB[3], 0, 0, 0); } while (0)
        KVSTEP(0); KVSTEP(1); KVSTEP(2); KVSTEP(3);
#undef KVSTEP
    }
    float* RKV = (float*)(ws + WS_RKV) + ((size_t)(c * 4 + h) * 2) * RET_ST;
    const int r32 = lane & 31, hi = lane >> 5;
#pragma unroll
    for (int r = 0; r < 16; ++r) { const int d = dblk * 32 + att::crow(r, hi);
#pragma unroll
        for (int eb = 0; eb < 4; ++eb) { const int e = eh * 128 + eb * 32 + r32; RKV[(size_t)d * 256 + e] = accF[eb][r]; RKV[RET_ST + (size_t)d * 256 + e] = accB[eb][r]; } }
    __syncthreads();
}
__device__ __forceinline__ void phase_scan(const Ctx& F, int l, bool do_rope) {
    CParams& P = *F.p; unsigned char* ws = P.ws;
    float* RKV = (float*)(ws + WS_RKV); bf16_t* RS = (bf16_t*)(ws + WS_RS);
    for (int it = F.bid; it < 2304; it += F.G) {
        const bool lat = it < 256; const int q = lat ? it : it - 256; const int combo = q >> 4, slab = q & 15;
        const int dir = combo & 1, h = (combo >> 1) & 3, sb = combo >> 3; const size_t e0 = (size_t)slab * 2048 + F.tid * 4;
        const float cd = __expf(128.0f * log_sigmoid_(P.in[dir ? I_RDB : I_RDF][l * 4 + h]));
        if (lat) {
            f32x4 s = *(const f32x4*)(P.in[dir ? I_SRB : I_SRF] + (((size_t)sb * 4 + l) * 4 + h) * RET_ST + e0);
#pragma nounroll
            for (int t0 = 0; t0 < 32; t0 += 8) { f32x4 kv[8];
#pragma unroll
                for (int q = 0; q < 8; ++q) { const int n = dir ? 31 - (t0 + q) : (t0 + q); kv[q] = *(const f32x4*)(RKV + ((size_t)((32 + sb * 32 + n) * 4 + h) * 2 + dir) * RET_ST + e0); }
#pragma unroll
                for (int q = 0; q < 8; ++q) { const int n = dir ? 31 - (t0 + q) : (t0 + q); const size_t base = ((size_t)((32 + sb * 32 + n) * 4 + h) * 2 + dir) * RET_ST + e0;
                    u32x2 w; w.x = cvt_pk_bf16(s[0], s[1]); w.y = cvt_pk_bf16(s[2], s[3]); *(u32x2*)(RS + base) = w;
                    s = s * cd + kv[q]; } }
        } else {
            f32x4 s = {0.f, 0.f, 0.f, 0.f};
#pragma unroll
            for (int t = 0; t < 2; ++t) { const int n = dir ? 1 - t : t; const size_t base = ((size_t)((sb * 2 + n) * 4 + h) * 2 + dir) * RET_ST + e0;
                u32x2 w; w.x = cvt_pk_bf16(s[0], s[1]); w.y = cvt_pk_bf16(s[2], s[3]); *(u32x2*)(RS + base) = w;
                s = s * cd + *(const f32x4*)(RKV + base); }
            *(f32x4*)(P.out + (dir ? O_NRB : O_NRF) + (((size_t)sb * 4 + l) * 4 + h) * RET_ST + e0) = s;
        }
    }
    bf16_t* CQ = (bf16_t*)(ws + WS_CQ);
    const int gw = F.bid * NWAVES + F.wave, NGW = F.G * NWAVES, lane = F.lane;
    if (do_rope) for (int r = NCTX + gw; r < NTOK; r += NGW) {
        const int n = (r - NCTX) & 4095, prow = n >> 6, pcol = n & 63; const RopeCS t64 = rope_cs64(lane & 31, prow, pcol);
        unsigned uu[4];
#pragma unroll
        for (int j = 0; j < 4; ++j) uu[j] = *((const unsigned*)(CQ + (size_t)r * LDCQ + ((lane >> 5) + 2 * j) * 192 + 128) + (lane & 31));
#pragma unroll
        for (int j = 0; j < 4; ++j) { float y0 = bf_lo(uu[j]), y1 = bf_hi(uu[j]); rope64(y0, y1, t64); *((unsigned*)(CQ + (size_t)r * LDCQ + ((lane >> 5) + 2 * j) * 192 + 128) + (lane & 31)) = cvt_pk_bf16(y0, y1); }
    }
}
__device__ __forceinline__ void ret_out_unit(const Ctx& F, int l, int u) {
    CParams& P = *F.p; unsigned char* ws = P.ws;
    const int c = u >> 2, h = u & 3, row0 = c * 128, tid = F.tid, lane = F.lane, w = F.wave, r32 = lane & 31, hi = lane >> 5;
    const bf16_t* PROJ = (const bf16_t*)(ws + WS_PROJ); const bf16_t* RS = (const bf16_t*)(ws + WS_RS) + ((size_t)(c * 4 + h) * 2) * RET_ST;
    const float lgf2 = log_sigmoid_(P.in[I_RDF][l * 4 + h]) * 1.4426950408889634f, lgb2 = log_sigmoid_(P.in[I_RDB][l * 4 + h]) * 1.4426950408889634f;
    LAS char* lds = (LAS char*)F.lds;
    const int qblk = w & 3, eh = w >> 2, qi = qblk * 32 + r32;
    const int ldsb = (int)(uintptr_t)lds;
    const bf16_t* Qw = PROJ + (size_t)(row0 + qi) * LDP + C_BQ + h * 128 + hi * 8;
#pragma nounroll
    for (int jt = 0; jt < 2; ++jt) {
        const int sr = tid >> 4, sc = (tid & 15) * 8;
        const bf16_t* ksrc = PROJ + (size_t)(row0 + jt * 64) * LDP + C_BK + h * 128;
        *(LAS bf16x8*)(lds + jt * 16384 + KSWZ(sr, sc * 2)) = *reinterpret_cast<const bf16x8*>(ksrc + (size_t)sr * LDP + sc);
        *(LAS bf16x8*)(lds + jt * 16384 + KSWZ(32 + sr, sc * 2)) = *reinterpret_cast<const bf16x8*>(ksrc + (size_t)(32 + sr) * LDP + sc);
#pragma nounroll
        for (int e2 = 0; e2 < 2; ++e2) stage_vtile<0>(lds + 32768 + (jt * 2 + e2) * 16384, PROJ + (size_t)(row0 + jt * 64) * LDP + C_BV + h * 256 + e2 * 128, LDP, tid, 0.f, 0);
    }
    __syncthreads();
    f32x16 o[4] = {};
    {
        bf16x8 qr[8];
#pragma unroll
        for (int d0 = 0; d0 < 8; ++d0) qr[d0] = *reinterpret_cast<const bf16x8*>(Qw + d0 * 16);
#pragma nounroll
        for (int jt = 0; jt < 2; ++jt) {
            f32x16 p0, p1; att::qkt<128>(p0, p1, lds + jt * 16384, lds, qr, r32, hi);
#pragma unroll
            for (int r = 0; r < 16; ++r) {
                const int j0 = jt * 64 + att::crow(r, hi), j1 = j0 + 32; const int d0 = qi - j0, d1 = qi - j1;
                const float w0 = d0 > 0 ? __builtin_amdgcn_exp2f(lgf2 * (float)d0) : (d0 < 0 ? __builtin_amdgcn_exp2f(lgb2 * (float)(-d0)) : 2.0f);
                const float w1 = d1 > 0 ? __builtin_amdgcn_exp2f(lgf2 * (float)d1) : (d1 < 0 ? __builtin_amdgcn_exp2f(lgb2 * (float)(-d1)) : 2.0f);
                p0[r] *= w0; p1[r] *= w1; }
            bf16x8 pa0, pa1, pa2, pa3; att::p_to_frags(p0, p1, pa0, pa1, pa2, pa3);
            att::pv_d0(o, ldsb + 32768 + (jt * 2 + eh) * 16384 + att::v_rd_base(lane), pa0, pa1, pa2, pa3);
        }
    }
    __syncthreads();
#pragma nounroll
    for (int t = 0; t < 8; ++t) stage_vtile<0>(lds + t * 16384, RS + (size_t)(t >> 2) * RET_ST + (size_t)(((t >> 1) & 1) * 64) * 256 + (t & 1) * 128, 256, tid, 0.f, 0);
    __syncthreads();
    {
        const float ff = __builtin_amdgcn_exp2f(lgf2 * (float)(qi + 1)), fb = __builtin_amdgcn_exp2f(lgb2 * (float)(128 - qi));
#pragma nounroll
        for (int sd = 0; sd < 4; ++sd) { const float f = (sd >> 1) ? fb : ff; const int dt = sd & 1; bf16x8 pa[4];
#pragma unroll
            for (int k = 0; k < 4; ++k) { const u32x4 q4 = *reinterpret_cast<const u32x4*>(Qw + (dt * 4 + k) * 16); u32x4 s4;
                s4.x = cvt_pk_bf16(bf_lo(q4.x) * f, bf_hi(q4.x) * f); s4.y = cvt_pk_bf16(bf_lo(q4.y) * f, bf_hi(q4.y) * f); s4.z = cvt_pk_bf16(bf_lo(q4.z) * f, bf_hi(q4.z) * f); s4.w = cvt_pk_bf16(bf_lo(q4.w) * f, bf_hi(q4.w) * f);
                pa[k] = *reinterpret_cast<const bf16x8*>(&s4); }
            att::pv_d0(o, ldsb + (sd * 2 + eh) * 16384 + att::v_rd_base(lane), pa[0], pa[1], pa[2], pa[3]); }
    }
    LAS float* rsum = (LAS float*)(F.lds + LDS_RS_OFF);
    float ss[16];
#pragma unroll
    for (int r = 0; r < 16; ++r) { float s = 0.f;
#pragma unroll
        for (int d0 = 0; d0 < 4; ++d0) s += o[d0][r] * o[d0][r];
        s += swz_xor<1>(s); s += swz_xor<2>(s); s += swz_xor<4>(s); s += swz_xor<8>(s); s += swz_xor<16>(s); ss[r] = s; }
    if (r32 == 0) {
#pragma unroll
        for (int r = 0; r < 16; ++r) rsum[eh * 128 + qblk * 32 + att::crow(r, hi)] = ss[r]; }
    __syncthreads();
    const float* gn = P.in[I_RGN] + l * 1024 + h * 256; bf16_t* OB = (bf16_t*)(ws + WS_OABC + SZ_O1);
#pragma unroll
    for (int r = 0; r < 16; ++r) { const int i = qblk * 32 + att::crow(r, hi);
        const float rs = 1.0f / sqrtf((rsum[i] + rsum[128 + i]) * (1.0f / 256.0f) + EPS);
#pragma unroll
        for (int d0 = 0; d0 < 4; ++d0) { const int e = eh * 128 + d0 * 32 + r32;
            const float g = __uint_as_float((unsigned)PROJ[(size_t)(row0 + i) * LDP + C_BG + h * 256 + e] << 16);
            OB[(size_t)(row0 + i) * LDO + h * 256 + e] = (bf16_t)(cvt_pk_bf16(o[d0][r] * rs * gn[e] * siluf_(g), 0.f) & 0xffffu); } }
    __syncthreads();
}

constexpr int CONV_PER_L = 32 * 362 + 8 * 48 + 4 * 64 + 3 * 16 * 64 + 32 * 64 + 32 * 256 + 128 * 64, CONV_SPLIT = (CONV_PER_L * 42) / 100, CONV_SPLIT2 = (CONV_PER_L * 64) / 100;
constexpr int NPH_L = 11, NPH = 2 + DEPTH * NPH_L;
__global__ void __launch_bounds__(NTHR, 2) mega(Params prm) {
    extern __shared__ __attribute__((aligned(16))) unsigned char lds_raw[];
    Ctx F; F.lds = (LAS unsigned char*)lds_raw; F.tid = threadIdx.x; F.lane = F.tid & 63; F.wave = __builtin_amdgcn_readfirstlane(F.tid >> 6); F.bid = blockIdx.x; F.G = gridDim.x; F.p = (CParams*)__builtin_amdgcn_kernarg_segment_ptr();
    unsigned char* ws = F.p->ws;
    for (int u = F.tid; u < 128; u += NTHR) ((LAS unsigned*)(F.lds + LDSCTL_OFF))[u] = 0u;
    __syncthreads();
    const int lo = F.p->ph_lo, hi = F.p->ph_hi; const bool multi = (hi - lo) > 1;
    XcdBarrier bar; bar.bar = (unsigned*)(ws + WS_CTL); bar.x = 0; bar.st = nullptr;
    if (multi) bar = xcd_barrier_post((unsigned*)(ws + WS_CTL), (volatile LAS unsigned*)(F.lds + LDSCTL_OFF + 32));
#ifndef SUB_MASK
#define SUB_MASK 15
#endif
#ifndef PH_MASK
#define PH_MASK 0xFFFF
#endif
#ifndef DUP_MASK
#define DUP_MASK 0
#endif
#define REPS(bit) ((DUP_MASK & (bit)) ? 2 : 1)
#define IN(k) (lo <= (k) && (k) < hi)
#define RELANE() do { int l_; asm volatile("v_mbcnt_lo_u32_b32 %0, -1, 0\n\tv_mbcnt_hi_u32_b32 %0, -1, %0" : "=v"(l_)); F.lane = l_; F.tid = F.wave * 64 + l_; } while (0)
#define FRESH() do { int l_; asm volatile("v_mbcnt_lo_u32_b32 %0, -1, 0\n\tv_mbcnt_hi_u32_b32 %0, -1, %0" : "=v"(l_)); F.lane = l_; F.tid = F.wave * 64 + l_; CParams* kp_ = (CParams*)__builtin_amdgcn_kernarg_segment_ptr(); asm volatile("" : "+s"(kp_)); F.p = kp_; } while (0)
#define SEAM(k) do { if (IN(k) && IN((k) + 1)) xcd_barrier(bar, F.tid == 0); } while (0)
    float* X = F.p->out;
    const float* MOD = (const float*)(ws + WS_MOD);
    bf16_t* H = (bf16_t*)(ws + WS_H); bf16_t* PROJ = (bf16_t*)(ws + WS_PROJ);
    float* PART = (float*)(ws + WS_PART);

    if ((PH_MASK & 1) && IN(0)) _Pragma("nounroll") for (int rp = 0; rp < REPS(1); ++rp) { FRESH(); convert_layer(F, 0, 0, F.G, true, 0, CONV_PER_L);
        _Pragma("nounroll") for (int l2 = 1; l2 < DEPTH; ++l2) { FRESH(); convert_layer(F, l2, 0, F.G, false, CONV_SPLIT2, CONV_PER_L); }
        SEAM(0); }
    if ((PH_MASK & 2) && IN(1)) { FRESH(); norm_phase(F, F.p->in[I_XP], F.p->in[I_XS], nullptr, nullptr, nullptr, H, nullptr, 0, nullptr, MOD, 2048, 0, F.p->in[I_GPMIX]); SEAM(1); }

    for (int l = 0; l < DEPTH; ++l) {
        const int pb = 2 + l * NPH_L; const float* MODL = MOD + (size_t)l * 3 * 12288;
        if ((PH_MASK & 4) && IN(pb + 0)) _Pragma("nounroll") for (int rp = 0; rp < REPS(4); ++rp) { FRESH();
            pg8::EpiBf16<0> E{PROJ, LDP, 0};
            pg8::gemm_phase<pg8::EpiBf16<0>, NTOK, NPROJ, LDH, LDH, DM, 1, false, 0, 0>(F.lds, F.tid, H, ws + WS_WIN + l * SZ_WIN, F.G, F.bid, E);
            if (l + 1 < DEPTH && rp == 0) { constexpr int NU = (NTOK / 256) * (NPROJ / 256); const int first = NU % F.G;
                if (first > 0 && F.bid >= first) { FRESH(); convert_layer(F, l + 1, first, F.G - first, false, CONV_SPLIT, CONV_SPLIT2); } }
            SEAM(pb + 0);
        }
        if ((PH_MASK & 8) && IN(pb + 1)) _Pragma("nounroll") for (int rp = 0; rp < REPS(8); ++rp) { FRESH(); if (REPS(8) == 2 && rp == 0) phase_postproj<true>(F, l); else phase_postproj<false>(F, l); SEAM(pb + 1); }
        if ((PH_MASK & 16) && IN(pb + 2)) _Pragma("nounroll") for (int rp = 0; rp < REPS(16); ++rp) { FRESH();
            if (SUB_MASK & 1) { pg8::EpiBf16<0> E{(bf16_t*)(ws + WS_CQ), LDCQ, 0};
              pg8::gemm_phase<pg8::EpiBf16<0>, NTOK, 1536, LDP, 512, 512, 1, false, 0, 0>(F.lds, F.tid, PROJ + C_CQL, ws + WS_WUQ + l * SZ_WUQ, F.G, F.bid, E); }
            if (SUB_MASK & 2) { FRESH(); pg8::EpiBf16<0> E{(bf16_t*)(ws + WS_KVUP), LDKV, 0};
              pg8::gemm_phase<pg8::EpiBf16<0>, NALL, 2048, 256, 256, 256, 1, false, 0, 0>(F.lds, F.tid, ws + WS_CKV, ws + WS_WUKV + l * SZ_WUKV, F.G, F.G - 1 - F.bid, E); }
            if (SUB_MASK & 4) { FRESH(); for (int u = (F.bid + F.G / 2) % F.G; u < 384; u += F.G) { RELANE(); ret_kv_unit(F, l, u); } }
            FRESH();
            if (SUB_MASK & 8) for (int k = 0, u = F.bid; u < 384; ++k, u = (F.G == 256) ? ((k == 1 && F.bid >= 32 && F.bid < 160) ? 256 + F.bid - 32 : 384) : u + F.G) {
                RELANE(); int row0, kv0, seq, h;
                if (u < 256) { const int uu = (F.G == 256) ? ((u & 7) * 32 + (u >> 3)) : u; const int b = uu >> 7; h = (uu >> 4) & 7; row0 = NCTX + b * 4096 + (uu & 15) * 256; kv0 = NCTX + b * KVL; seq = KVL; }
                else { const int s = (u - 256) >> 3; h = (u - 256) & 7; row0 = s * 256; kv0 = s * 256; seq = 256; }
                att::attn_dma<128, LDP, 256, 256, LDO>(PROJ + (size_t)row0 * LDP + C_AQ + h * 128, (const bf16_t*)(ws + WS_KA) + (size_t)kv0 * 256 + (h >> 2) * 128, nullptr,
                    (const bf16_t*)(ws + WS_VA) + (size_t)kv0 * 256 + (h >> 2) * 128, (bf16_t*)(ws + WS_OABC) + (size_t)row0 * LDO + h * 128, seq, (LAS char*)F.lds, (LAS float*)(F.lds + LDS_WSCR_OFF), F.tid);
            }
            SEAM(pb + 2);
        }
        if ((PH_MASK & 32) && IN(pb + 3)) _Pragma("nounroll") for (int rp = 0; rp < REPS(32); ++rp) { FRESH(); phase_scan(F, l, rp == 0); SEAM(pb + 3); }
        if ((PH_MASK & 64) && IN(pb + 4)) _Pragma("nounroll") for (int rp = 0; rp < REPS(64); ++rp) { FRESH();
            FRESH();
            if (SUB_MASK & 2) for (int u = F.bid; u < 384; u += F.G) {
                RELANE(); int row0, kv0, seq, h;
                if (u < 256) { const int uu = (F.G == 256) ? ((u & 7) * 32 + (u >> 3)) : u; const int b = uu >> 7; h = (uu >> 4) & 7; row0 = NCTX + b * 4096 + (uu & 15) * 256; kv0 = NCTX + b * KVL; seq = KVL; }
                else { const int s = (u - 256) >> 3; h = (u - 256) & 7; row0 = s * 256; kv0 = s * 256; seq = 256; }
                att::attn_dma<192, LDCQ, LDKV, LDKV, LDO>((const bf16_t*)(ws + WS_CQ) + (size_t)row0 * LDCQ + h * 192, (const bf16_t*)(ws + WS_KVUP) + (size_t)kv0 * LDKV + h * 256,
                    (const bf16_t*)(ws + WS_KROPE) + (size_t)kv0 * 64, (const bf16_t*)(ws + WS_KVUP) + (size_t)kv0 * LDKV + h * 256 + 128,
                    (bf16_t*)(ws + WS_OABC + 2 * SZ_O1) + (size_t)row0 * LDO + h * 128, seq, (LAS char*)F.lds, (LAS float*)(F.lds + LDS_WSCR_OFF), F.tid);
            }
            FRESH();
            if (SUB_MASK & 4) for (int u = (F.bid + F.G / 2) % F.G; u < 384; u += F.G) { RELANE(); ret_out_unit(F, l, u); }
            SEAM(pb + 4);
        }
        if ((PH_MASK & 128) && IN(pb + 5)) _Pragma("nounroll") for (int rp = 0; rp < REPS(128); ++rp) { FRESH();
            pg8::EpiBranch E{PROJ + C_GATE, LDP, (bf16_t*)(ws + WS_MERGED)};
            pg8::gemm_phase<pg8::EpiBranch, NTOK, DM, LDO, LDO, 1024, 3, true, SZ_O1, SZ_WBR1>(F.lds, F.tid, ws + WS_OABC, ws + WS_WBR + (size_t)l * 3 * SZ_WBR1, F.G, F.bid, E);
            if (l + 1 < DEPTH && rp == 0) { FRESH(); const int first = (F.G > 192 && F.G < 384) ? 384 - F.G : 0; if (F.bid >= first) convert_layer(F, l + 1, first, F.G - first, true, 0, CONV_SPLIT); }
            SEAM(pb + 5);
        }
        if ((PH_MASK & 256) && IN(pb + 6)) _Pragma("nounroll") for (int rp = 0; rp < REPS(256); ++rp) { FRESH();
            pg8::EpiBf16<0> E{(bf16_t*)PART, DM, (size_t)NTOK * DM};
            pg8::gemm_phase<pg8::EpiBf16<0>, NTOK, DM, LDH, LDH, 1024, 2, false, 2048, 2048>(F.lds, F.tid, ws + WS_MERGED, ws + WS_WOUT + l * SZ_WOUT, F.G, F.bid, E);
            SEAM(pb + 6);
        }
        if ((PH_MASK & 512) && IN(pb + 7)) _Pragma("nounroll") for (int rp = 0; rp < REPS(512); ++rp) { FRESH();
            norm_phase(F, l == 0 ? F.p->in[I_XP] : X, l == 0 ? F.p->in[I_XS] : X + (size_t)NCTX * DM, (const bf16_t*)PART, (const bf16_t*)PART + (size_t)NTOK * DM, (REPS(512) == 2 && rp == 0) ? (float*)PROJ : X, (REPS(512) == 2 && rp == 0) ? (bf16_t*)(ws + WS_PROJ + SZ_PART1) : H, MODL, 4096, F.p->in[I_GPOMIX] + l * DM, MODL, 8192, 6144, F.p->in[I_GPMLP] + l * DM);
            SEAM(pb + 7);
        }
        if ((PH_MASK & 1024) && IN(pb + 8)) _Pragma("nounroll") for (int rp = 0; rp < REPS(1024); ++rp) { FRESH();
            pg8::EpiBf16<1> E{PROJ, LDU, 0};
            pg8::gemm_phase<pg8::EpiBf16<1>, NTOK, DFF, LDH, LDH, DM, 1, false, 0, 0>(F.lds, F.tid, H, ws + WS_WUP + l * SZ_WUP, F.G, F.bid, E);
            SEAM(pb + 8);
        }
        if ((PH_MASK & 2048) && IN(pb + 9)) _Pragma("nounroll") for (int rp = 0; rp < REPS(2048); ++rp) { FRESH();
            pg8::EpiBf16<0> E{(bf16_t*)PART, DM, (size_t)NTOK * DM};
            pg8::gemm_phase<pg8::EpiBf16<0>, NTOK, DM, LDU, LDU, 4096, 2, false, 8192, 8192>(F.lds, F.tid, PROJ, ws + WS_WDN + l * SZ_WDN, F.G, F.bid, E);
            SEAM(pb + 9);
        }
        if ((PH_MASK & 4096) && IN(pb + 10)) _Pragma("nounroll") for (int rp = 0; rp < REPS(4096); ++rp) { FRESH();
            const bool more = (l + 1 < DEPTH);
            norm_phase(F, X, X + (size_t)NCTX * DM, (const bf16_t*)PART, (const bf16_t*)PART + (size_t)NTOK * DM, (REPS(4096) == 2 && rp == 0) ? (float*)PROJ : X, (REPS(4096) == 2 && rp == 0) ? (bf16_t*)(ws + WS_PROJ + SZ_PART1) : H, MODL, 10240, F.p->in[I_GPOMLP] + l * DM,
                       MODL + 3 * 12288, 2048, 0, more ? F.p->in[I_GPMIX] + (l + 1) * DM : nullptr);
            SEAM(pb + 10);
        }
    }
#undef IN
#undef SEAM
}

#ifndef MK_MULTI
#define MK_MULTI 0
#endif
extern "C" void kernel_launch(void* const* d_in, const int* in_sizes, int n_in, void* d_out, int out_size, void* d_ws, size_t ws_size, hipStream_t stream) {
    static int grid = 0;
    if (grid == 0) {
        if (n_in != 32 || out_size != (int)O_END || ws_size < WS_END) { fprintf(stderr, "kernel_launch: unexpected shapes: n_in %d out %d ws %zu (need %zu)\n", n_in, out_size, ws_size, (size_t)WS_END); grid = -1; return; }
        int dev = 0, cus = 0, per_cu = 0;
        if (hipGetDevice(&dev) != hipSuccess || hipDeviceGetAttribute(&cus, hipDeviceAttributeMultiprocessorCount, dev) != hipSuccess) { grid = -1; return; }
        if (hipFuncSetAttribute((const void*)mega, hipFuncAttributeMaxDynamicSharedMemorySize, LDS_BYTES) != hipSuccess) { fprintf(stderr, "kernel_launch: hipFuncSetAttribute failed\n"); grid = -1; return; }
        if (hipOccupancyMaxActiveBlocksPerMultiprocessor(&per_cu, (const void*)mega, NTHR, LDS_BYTES) != hipSuccess || per_cu < 1) fprintf(stderr, "kernel_launch: occupancy query says %d\n", per_cu);
        (void)hipGetLastError();
        grid = cus;
    }
    if (grid < 0) return;
    (void)hipMemsetAsync((char*)d_ws + WS_CTL, 0, CTL_BYTES, stream);
    Params p{};
    for (int i = 0; i < 32; ++i) p.in[i] = (const float*)d_in[i];
    p.out = (float*)d_out; p.ws = (unsigned char*)d_ws;
#if MK_MULTI
    for (int k = 0; k < NPH; ++k) { p.ph_lo = k; p.ph_hi = k + 1; hipLaunchKernelGGL(mega, dim3(grid), dim3(NTHR), LDS_BYTES, stream, p); }
#else
    p.ph_lo = 0; p.ph_hi = NPH;
    hipLaunchKernelGGL(mega, dim3(grid), dim3(NTHR), LDS_BYTES, stream, p);
#endif
    const hipError_t le = hipPeekAtLastError();
    if (le != hipSuccess) fprintf(stderr, "kernel_launch: launch failed: %s\n", hipGetErrorName(le));
}
```
